# Optimizing an MI355X kernel written in HIP

```python
import math
import jax, jax.numpy as jnp
from jax import lax
import numpy as np

D_MODEL = 1024
BATCH = 4
SEQ = 8192
DEPTH = 1
DEC_BATCH = 8
DEC_SEQ = 4096
PAST_LEN = 128

D_FF = 2816
N_HEADS_A = 8
N_KV_A = 2
HEAD_DIM_A = 64
GROUP_A = N_HEADS_A // N_KV_A
WINDOW = 128
BLOCK = 128
N_HEADS_B = 8
Q_LORA = 256
KV_LORA = 128
NOPE_B = 64
ROPE_B = 32
QK_DIM_B = NOPE_B + ROPE_B
V_DIM_B = 64
ROPE_THETA = 10000.0
EPS = 1e-6
A_Q = N_HEADS_A * HEAD_DIM_A
A_KV = N_KV_A * HEAD_DIM_A
IN_WIDTH = A_Q + 2 * A_KV + Q_LORA + KV_LORA + ROPE_B
MIX_WIDTH = N_HEADS_A * HEAD_DIM_A + N_HEADS_B * V_DIM_B
N_MOD = 9

kernel_name = "hymba_swa_mla_macaron_adaln_encoder"


def rmsnorm(x, g):
    xf = x.astype(jnp.float32)
    y = xf * lax.rsqrt(jnp.mean(xf * xf, axis=-1, keepdims=True) + EPS)
    return (y * g.astype(jnp.float32)).astype(x.dtype)


def modulate(h, shift, scale):
    return h * (1 + scale[:, None, :]) + shift[:, None, :]


def rope(x):
    S, d = x.shape[1], x.shape[-1]
    pos = jnp.arange(S, dtype=jnp.float32)
    inv = ROPE_THETA ** (-jnp.arange(0, d, 2, dtype=jnp.float32) / d)
    ang = pos[:, None] * inv[None, :]
    cos = jnp.cos(ang)[None, :, None, :]
    sin = jnp.sin(ang)[None, :, None, :]
    xf = x.astype(jnp.float32)
    x1, x2 = xf[..., : d // 2], xf[..., d // 2:]
    out = jnp.concatenate([x1 * cos - x2 * sin, x2 * cos + x1 * sin], axis=-1)
    return out.astype(x.dtype)


def swiglu(h, wg, wu, wd):
    return (jax.nn.silu(h @ wg) * (h @ wu)) @ wd


def window_attention(q, k, v, sink):
    B, S, H, d = q.shape
    nb = S // BLOCK
    qb = q.reshape(B, nb, BLOCK, N_KV_A, GROUP_A, d)
    pad = ((0, 0), (BLOCK, BLOCK), (0, 0), (0, 0))
    kp = jnp.pad(k, pad).reshape(B, nb + 2, BLOCK, N_KV_A, d)
    vp = jnp.pad(v, pad).reshape(B, nb + 2, BLOCK, N_KV_A, d)
    kw = jnp.concatenate([kp[:, :-2], kp[:, 1:-1], kp[:, 2:]], axis=2)
    vw = jnp.concatenate([vp[:, :-2], vp[:, 1:-1], vp[:, 2:]], axis=2)
    s = jnp.einsum('bnqhgd,bnjhd->bnhgqj', qb, kw).astype(jnp.float32) / math.sqrt(d)
    qi = jnp.arange(BLOCK)[:, None]
    kj = jnp.arange(3 * BLOCK)[None, :]
    band = jnp.abs(kj - BLOCK - qi) <= WINDOW
    kpos = jnp.arange(nb)[:, None] * BLOCK + jnp.arange(3 * BLOCK)[None, :] - BLOCK
    inside = (kpos >= 0) & (kpos < S)
    mask = band[None, :, :] & inside[:, None, :]
    s = jnp.where(mask[None, :, None, None, :, :], s, -1e30)
    sk = sink.astype(jnp.float32).reshape(N_KV_A, GROUP_A)[None, None, :, :, None, None]
    m = jnp.maximum(jnp.max(s, axis=-1, keepdims=True), sk)
    p = jnp.exp(s - m)
    p = p / (jnp.sum(p, axis=-1, keepdims=True) + jnp.exp(sk - m))
    o = jnp.einsum('bnhgqj,bnjhd->bnqhgd', p.astype(v.dtype), vw)
    return o.reshape(B, S, H * d)


def dense_attention(q, k, v):
    B, S, H, dq = q.shape
    nb = S // BLOCK
    qb = q.reshape(B, nb, BLOCK, H, dq).transpose(1, 0, 2, 3, 4)
    scale = 1.0 / math.sqrt(dq)

    def one(qblk):
        s = jnp.einsum('bqhd,bkhd->bhqk', qblk, k).astype(jnp.float32) * scale
        p = jax.nn.softmax(s, axis=-1)
        return jnp.einsum('bhqk,bkhd->bqhd', p.astype(v.dtype), v)

    o = lax.map(one, qb)
    return o.transpose(1, 0, 2, 3, 4).reshape(B, S, H * v.shape[-1])


def token_mixing(h, w_in, swa_q_norm, swa_k_norm, swa_sink, mla_q_lora_norm, mla_w_uq,
                 mla_kv_lora_norm, mla_w_ukv, mla_q_norm, mla_k_norm, w_out):
    B, S, _ = h.shape
    z = h @ w_in
    cuts = np.cumsum([A_Q, A_KV, A_KV, Q_LORA, KV_LORA]).tolist()
    qa, ka, va, cq, ckv, kr = jnp.split(z, cuts, axis=-1)
    qa = rope(rmsnorm(qa.reshape(B, S, N_HEADS_A, HEAD_DIM_A), swa_q_norm))
    ka = rope(rmsnorm(ka.reshape(B, S, N_KV_A, HEAD_DIM_A), swa_k_norm))
    va = va.reshape(B, S, N_KV_A, HEAD_DIM_A)
    oa = window_attention(qa, ka, va, swa_sink)
    qb = (rmsnorm(cq, mla_q_lora_norm) @ mla_w_uq).reshape(B, S, N_HEADS_B, QK_DIM_B)
    kv = (rmsnorm(ckv, mla_kv_lora_norm) @ mla_w_ukv).reshape(B, S, N_HEADS_B, NOPE_B + V_DIM_B)
    k_nope, vb = kv[..., :NOPE_B], kv[..., NOPE_B:]
    k_rope = jnp.broadcast_to(kr[:, :, None, :], (B, S, N_HEADS_B, ROPE_B))
    kb = jnp.concatenate([k_nope, k_rope], axis=-1)
    qb = rmsnorm(qb, mla_q_norm)
    kb = rmsnorm(kb, mla_k_norm)
    qb = jnp.concatenate([qb[..., :NOPE_B], rope(qb[..., NOPE_B:])], axis=-1)
    kb = jnp.concatenate([kb[..., :NOPE_B], rope(kb[..., NOPE_B:])], axis=-1)
    ob = dense_attention(qb, kb, vb)
    return jnp.concatenate([oa, ob], axis=-1) @ w_out


def setup_inputs(seed: int = 0) -> dict:
    key = jax.random.key(seed)
    ks = jax.random.split(key, 32)
    f32 = jnp.float32

    def nrm(k, shape, std):
        return jax.random.normal(k, shape, f32) * std

    def gain(k, dim):
        return 1.0 + 0.02 * jax.random.normal(k, (DEPTH, dim), f32)

    L = DEPTH
    return {
        "x_prompt": nrm(ks[0], (BATCH, SEQ, D_MODEL), 1.0),
        "x_sample": nrm(ks[1], (DEC_BATCH, DEC_SEQ, D_MODEL), 1.0),
        "c_prompt": nrm(ks[2], (BATCH, D_MODEL), 1.0),
        "c_sample": nrm(ks[3], (DEC_BATCH, D_MODEL), 1.0),
        "ada_w": nrm(ks[4], (L, D_MODEL, N_MOD * D_MODEL), D_MODEL ** -0.5),
        "ada_b": nrm(ks[5], (L, N_MOD * D_MODEL), 0.02),
        "ffn1_norm": gain(ks[6], D_MODEL),
        "ffn1_wg": nrm(ks[7], (L, D_MODEL, D_FF), D_MODEL ** -0.5),
        "ffn1_wu": nrm(ks[8], (L, D_MODEL, D_FF), D_MODEL ** -0.5),
        "ffn1_wd": nrm(ks[9], (L, D_FF, D_MODEL), D_FF ** -0.5),
        "mix_norm": gain(ks[10], D_MODEL),
        "w_in": nrm(ks[11], (L, D_MODEL, IN_WIDTH), D_MODEL ** -0.5),
        "swa_q_norm": gain(ks[12], HEAD_DIM_A),
        "swa_k_norm": gain(ks[13], HEAD_DIM_A),
        "swa_sink": nrm(ks[14], (L, N_HEADS_A), 0.5),
        "mla_q_lora_norm": gain(ks[15], Q_LORA),
        "mla_w_uq": nrm(ks[16], (L, Q_LORA, N_HEADS_B * QK_DIM_B), Q_LORA ** -0.5),
        "mla_kv_lora_norm": gain(ks[17], KV_LORA),
        "mla_w_ukv": nrm(ks[18], (L, KV_LORA, N_HEADS_B * (NOPE_B + V_DIM_B)), KV_LORA ** -0.5),
        "mla_q_norm": gain(ks[19], QK_DIM_B),
        "mla_k_norm": gain(ks[20], QK_DIM_B),
        "w_out": nrm(ks[21], (L, MIX_WIDTH, D_MODEL), MIX_WIDTH ** -0.5),
        "ffn2_norm": gain(ks[22], D_MODEL),
        "ffn2_wg": nrm(ks[23], (L, D_MODEL, D_FF), D_MODEL ** -0.5),
        "ffn2_wu": nrm(ks[24], (L, D_MODEL, D_FF), D_MODEL ** -0.5),
        "ffn2_wd": nrm(ks[25], (L, D_FF, D_MODEL), D_FF ** -0.5),
        "final_norm": gain(ks[26], D_MODEL),
    }


def reference(x_prompt, x_sample, c_prompt, c_sample, ada_w, ada_b, ffn1_norm, ffn1_wg, ffn1_wu,
              ffn1_wd, mix_norm, w_in, swa_q_norm, swa_k_norm, swa_sink, mla_q_lora_norm, mla_w_uq,
              mla_kv_lora_norm, mla_w_ukv, mla_q_norm, mla_k_norm, w_out, ffn2_norm, ffn2_wg,
              ffn2_wu, ffn2_wd, final_norm):
    def trunk(x, c):
        for l in range(DEPTH):
            mod = jax.nn.silu(c) @ ada_w[l] + ada_b[l]
            sh1, sc1, g1, sh2, sc2, g2, sh3, sc3, g3 = jnp.split(mod, N_MOD, axis=-1)
            h = modulate(rmsnorm(x, ffn1_norm[l]), sh1, sc1)
            x = x + 0.5 * g1[:, None, :] * swiglu(h, ffn1_wg[l], ffn1_wu[l], ffn1_wd[l])
            h = modulate(rmsnorm(x, mix_norm[l]), sh2, sc2)
            y = token_mixing(h, w_in[l], swa_q_norm[l], swa_k_norm[l], swa_sink[l],
                             mla_q_lora_norm[l], mla_w_uq[l], mla_kv_lora_norm[l], mla_w_ukv[l],
                             mla_q_norm[l], mla_k_norm[l], w_out[l])
            x = x + g2[:, None, :] * y
            h = modulate(rmsnorm(x, ffn2_norm[l]), sh3, sc3)
            x = x + 0.5 * g3[:, None, :] * swiglu(h, ffn2_wg[l], ffn2_wu[l], ffn2_wd[l])
            x = rmsnorm(x, final_norm[l])
        return x

    y_prompt = trunk(x_prompt, c_prompt)
    y_sample = trunk(x_sample, c_sample)
    return (y_prompt, y_sample)
```

```cpp
#include <hip/hip_runtime.h>
#include <hip/hip_cooperative_groups.h>
#include <cstdio>
#include <cstdint>
namespace cg = cooperative_groups;
namespace pg8 {
#define PG8_LAS __attribute__((address_space(3)))
typedef unsigned short bf16_t;
typedef short bf16x8 __attribute__((ext_vector_type(8)));
typedef float f32x4 __attribute__((ext_vector_type(4)));
typedef unsigned u32x4 __attribute__((ext_vector_type(4)));
constexpr int BM = 256, BK = 64, HALF = 128, HTB = HALF * BK * 2  , STAGE_BYTES = 8 * HTB, NXCD = 8, WGM = 8;

__host__ __device__ __forceinline__ int lds_byte(int r, int c) { const int st = (r >> 4) * 2 + (c >> 5), rr = r & 15, cc = c & 31, ob = rr * 64 + cc * 2; return st * 1024 + (ob ^ (((ob >> 9) & 1) << 5)); }
__host__ __device__ __forceinline__ void stage_rc(int b, int& R, int& C) { const int st = b / 1024, sb = b % 1024, swz = sb ^ (((sb >> 9) & 1) << 5); R = (st >> 1) * 16 + swz / 64; C = (st & 1) * 32 + (swz % 64) / 2; }
__host__ __device__ __forceinline__ int perm32(int rho) { const int n = rho >> 4, i = rho & 15; return 8 * (i >> 2) + 4 * n + (i & 3); }
struct Unit { int pm, pn; };
struct Gemm { const bf16_t* A; const bf16_t* Bt; int M, N, K, lda; };

struct StaticOrder {
    int nM, nN, nwg, G, c;
    __host__ __device__ void init(int M, int N, int G_, int c_) { nM = M / BM; nN = N / BM; nwg = nM * nN; G = G_; c = c_; }
    __host__ __device__ bool next(int i, Unit& u) const {
        const long L = (long)i * G + c; if (L >= nwg) return false;
        int wgid = (int)L; { const int q = nwg / NXCD, r = nwg % NXCD, xcd = wgid % NXCD, off = wgid / NXCD; wgid = (xcd < r ? xcd * (q + 1) : r * (q + 1) + (xcd - r) * q) + off; }
        const int nig = WGM * nN, gid = wgid / nig, fm = gid * WGM, gsz = (nM - fm) < WGM ? (nM - fm) : WGM;
        u.pm = fm + ((wgid % nig) % gsz); u.pn = (wgid % nig) / gsz; return true;
    }
    __device__ __forceinline__ void a_ready(const Unit&) const {}
    __device__ __forceinline__ void done(const Unit&) const {}
};
__device__ __forceinline__ unsigned cvt_pk_bf16(float lo, float hi) { unsigned r; asm volatile("v_cvt_pk_bf16_f32 %0, %1, %2" : "=v"(r) : "v"(lo), "v"(hi)); return r; }
typedef float f32x2 __attribute__((ext_vector_type(2)));
template <class Epi, class Sched, bool ALIGN_EPI = false, bool SP2 = false>
__device__ __forceinline__ void gemm_phase(PG8_LAS unsigned char* lds, const Gemm g, const Sched& S, const Epi& E, int tid_in) {
    int tid_l = tid_in; asm volatile("" : "+v"(tid_l));
    const int tid = tid_l, wid = __builtin_amdgcn_readfirstlane(tid >> 6), lane = tid & 63, wr = wid >> 2, wc = wid & 3, fr = lane & 15, fq = lane >> 4;
    const int K = g.K, nt = K / BK;
    unsigned voffA[2], voffB[2];
#pragma unroll
    for (int i = 0; i < 2; ++i) { int R, C; stage_rc(tid * 16 + i * 8192, R, C); const int Rb = Epi::PERM ? ((R & ~31) + perm32(R & 31)) : R;
        voffA[i] = (unsigned)(R * g.lda + C) * 2u; voffB[i] = (unsigned)(Rb * K + C) * 2u; }
    const size_t kstep = (size_t)(BK * 2);
    const size_t hstep = (size_t)HALF * K * 2;
    const size_t tstep = 2 * hstep;
    const size_t hstepA = (size_t)HALF * g.lda * 2, tstepA = 2 * hstepA;
    const unsigned ldsw = (unsigned)wid * 1024u;
    const int aoff = lds_byte(wr * 64 + fr, fq * 8), boff = lds_byte(wc * 32 + fr, fq * 8);
#define PG8_SA(b, h) (((b) * 2 + (h)) * HTB)
#define PG8_SB(b, h) ((4 + (b) * 2 + (h)) * HTB)
#define PG8_STAGE(bufoff, gbase, voff) do { _Pragma("unroll") for (int _i = 0; _i < 2; ++_i) \
        __builtin_amdgcn_global_load_lds((const unsigned*)((const char*)(gbase) + (voff)[_i]), (PG8_LAS unsigned*)(lds + (bufoff) + ldsw + _i * 8192), 16, 0, 0); } while (0)
#define PG8_LDA(dst, b, h) do { _Pragma("unroll") for (int m = 0; m < 4; ++m) _Pragma("unroll") for (int k = 0; k < 2; ++k) dst[m][k] = *(const PG8_LAS bf16x8*)(lds + PG8_SA(b, h) + aoff + m * 2048 + k * 1024); } while (0)
#define PG8_LDB(dst, b, h) do { _Pragma("unroll") for (int n = 0; n < 2; ++n) _Pragma("unroll") for (int k = 0; k < 2; ++k) dst[n][k] = *(const PG8_LAS bf16x8*)(lds + PG8_SB(b, h) + boff + n * 2048 + k * 1024); } while (0)
#define PG8_MMA(ai, bj, At, Bt) do { __builtin_amdgcn_s_setprio(1); _Pragma("unroll") for (int m = 0; m < 4; ++m) _Pragma("unroll") for (int n = 0; n < 2; ++n) _Pragma("unroll") for (int k = 0; k < 2; ++k) \
        acc[ai][bj][m][n] = __builtin_amdgcn_mfma_f32_16x16x32_bf16(Bt[n][k], At[m][k], acc[ai][bj][m][n], 0, 0, 0); __builtin_amdgcn_s_setprio(0); } while (0)
#define PG8_WAIT_V(n) asm volatile("s_waitcnt vmcnt(" #n ")" ::: "memory")
#define PG8_WAIT_L(n) asm volatile("s_waitcnt lgkmcnt(" #n ")" ::: "memory")
#define PG8_BAR __builtin_amdgcn_s_barrier()
#define PG8_SCHED __builtin_amdgcn_sched_barrier(0)
    Unit cur, nxt; int ui = 0;
    if (!S.next(0, cur)) return;
    f32x4 acc[2][2][4][2];
#pragma unroll
    for (int a = 0; a < 2; ++a)
#pragma unroll
        for (int b = 0; b < 2; ++b)
#pragma unroll
            for (int m = 0; m < 4; ++m)
#pragma unroll
                for (int n = 0; n < 2; ++n) acc[a][b][m][n] = (f32x4){0.f, 0.f, 0.f, 0.f};
    bf16x8 At[4][2], B0[2][2], B1[2][2];
    const char* cA = (const char*)g.A + (size_t)cur.pm * tstepA; const char* cB = (const char*)g.Bt + (size_t)cur.pn * tstep;
    S.a_ready(cur);
    if constexpr (SP2) {
        PG8_STAGE(PG8_SB(0, 0), cB, voffB); PG8_STAGE(PG8_SB(0, 1), cB + hstep, voffB); PG8_STAGE(PG8_SA(0, 0), cA, voffA); PG8_STAGE(PG8_SA(0, 1), cA + hstepA, voffA);
        if (wr == 1) PG8_BAR;
        PG8_WAIT_V(2); PG8_BAR;
        PG8_STAGE(PG8_SB(1, 0), cB + kstep, voffB); PG8_STAGE(PG8_SA(1, 0), cA + kstep, voffA); PG8_STAGE(PG8_SB(1, 1), cB + hstep + kstep, voffB);
        PG8_WAIT_V(6); PG8_BAR;
    } else {
        PG8_STAGE(PG8_SB(0, 0), cB, voffB); PG8_STAGE(PG8_SA(0, 0), cA, voffA); PG8_STAGE(PG8_SB(0, 1), cB + hstep, voffB); PG8_STAGE(PG8_SA(0, 1), cA + hstepA, voffA);
        if (wr == 1) PG8_BAR;
        PG8_WAIT_V(4); PG8_BAR;
        PG8_STAGE(PG8_SB(1, 0), cB + kstep, voffB); PG8_STAGE(PG8_SA(1, 0), cA + kstep, voffA); PG8_STAGE(PG8_SB(1, 1), cB + hstep + kstep, voffB);
        PG8_WAIT_V(6); PG8_BAR;
    }
    for (;;) {
        const bool has_next = S.next(ui + 1, nxt);
        const char* nA = has_next ? (const char*)g.A + (size_t)nxt.pm * tstepA : cA; const char* nB = has_next ? (const char*)g.Bt + (size_t)nxt.pn * tstep : cB;
        for (int t = 0; t < nt; t += 2) {
            const bool last = (t == nt - 2);
            const char* a1 = cA + (size_t)(t + 1) * kstep;
            const char* a2 = last ? nA : cA + (size_t)(t + 2) * kstep; const char* b2 = last ? nB : cB + (size_t)(t + 2) * kstep;
            const char* a3 = a2 + kstep; const char* b3 = b2 + kstep;
            if (last && has_next) S.a_ready(nxt);
            if constexpr (SP2) {
            PG8_LDB(B0, 0, 0); PG8_LDB(B1, 0, 1); PG8_SCHED; PG8_LDA(At, 0, 0); PG8_STAGE(PG8_SA(1, 1), a1 + hstepA, voffA);
            PG8_WAIT_V(8); PG8_WAIT_L(0); PG8_BAR; PG8_MMA(0, 0, At, B0); PG8_MMA(0, 1, At, B1); PG8_BAR; PG8_SCHED;
            PG8_LDA(At, 0, 1); PG8_STAGE(PG8_SB(0, 0), b2, voffB); PG8_STAGE(PG8_SB(0, 1), b2 + hstep, voffB); PG8_STAGE(PG8_SA(0, 0), a2, voffA);
            PG8_WAIT_V(8); PG8_WAIT_L(0); PG8_BAR; PG8_MMA(1, 0, At, B0); PG8_MMA(1, 1, At, B1); PG8_BAR; PG8_SCHED;
            PG8_LDB(B0, 1, 0); PG8_LDB(B1, 1, 1); PG8_SCHED; PG8_LDA(At, 1, 0); PG8_STAGE(PG8_SA(0, 1), a2 + hstepA, voffA);
            PG8_WAIT_V(8); PG8_WAIT_L(0); PG8_BAR; PG8_MMA(0, 0, At, B0); PG8_MMA(0, 1, At, B1); PG8_BAR; PG8_SCHED;
            PG8_LDA(At, 1, 1); PG8_STAGE(PG8_SB(1, 0), b3, voffB); PG8_STAGE(PG8_SB(1, 1), b3 + hstep, voffB); PG8_STAGE(PG8_SA(1, 0), a3, voffA);
            PG8_WAIT_V(8); PG8_WAIT_L(0); PG8_BAR; PG8_MMA(1, 0, At, B0); PG8_MMA(1, 1, At, B1); PG8_BAR; PG8_SCHED;
            } else {
            PG8_LDB(B0, 0, 0); PG8_SCHED; PG8_LDA(At, 0, 0); PG8_STAGE(PG8_SA(1, 1), a1 + hstepA, voffA);
            PG8_WAIT_L(8); PG8_BAR; PG8_WAIT_L(0); PG8_MMA(0, 0, At, B0); PG8_BAR; PG8_SCHED;
            PG8_LDB(B1, 0, 1); PG8_STAGE(PG8_SB(0, 0), b2, voffB);
            PG8_BAR; PG8_WAIT_L(0); PG8_MMA(0, 1, At, B1); PG8_BAR;
            PG8_LDA(At, 0, 1); PG8_STAGE(PG8_SA(0, 0), a2, voffA);
            PG8_BAR; PG8_WAIT_L(0); PG8_MMA(1, 0, At, B0); PG8_BAR; PG8_SCHED;
            PG8_STAGE(PG8_SB(0, 1), b2 + hstep, voffB);
            PG8_WAIT_V(6); PG8_BAR; PG8_MMA(1, 1, At, B1); PG8_BAR;
            PG8_LDB(B0, 1, 0); PG8_SCHED; PG8_LDA(At, 1, 0); PG8_STAGE(PG8_SA(0, 1), a2 + hstepA, voffA);
            PG8_WAIT_L(8); PG8_BAR; PG8_WAIT_L(0); PG8_MMA(0, 0, At, B0); PG8_BAR; PG8_SCHED;
            PG8_LDB(B1, 1, 1); PG8_STAGE(PG8_SB(1, 0), b3, voffB);
            PG8_BAR; PG8_WAIT_L(0); PG8_MMA(0, 1, At, B1); PG8_BAR;
            PG8_LDA(At, 1, 1); PG8_STAGE(PG8_SA(1, 0), a3, voffA);
            PG8_BAR; PG8_WAIT_L(0); PG8_MMA(1, 0, At, B0); PG8_BAR; PG8_SCHED;
            PG8_STAGE(PG8_SB(1, 1), b3 + hstep, voffB);
            PG8_WAIT_V(6); PG8_BAR; PG8_MMA(1, 1, At, B1); PG8_BAR;
            }
        }
        if constexpr (ALIGN_EPI) { if (wr == 0) PG8_BAR; }
        if constexpr (!Epi::AFTER_DRAIN) { E(acc, cur, wr, wc, fr, fq); S.done(cur); }
        if (!has_next) break;
#pragma unroll
        for (int a = 0; a < 2; ++a)
#pragma unroll
            for (int b = 0; b < 2; ++b)
#pragma unroll
                for (int m = 0; m < 4; ++m)
#pragma unroll
                    for (int n = 0; n < 2; ++n) acc[a][b][m][n] = (f32x4){0.f, 0.f, 0.f, 0.f};
        cur = nxt; cA = nA; cB = nB; ++ui;
        if constexpr (ALIGN_EPI) { if (wr == 1) PG8_BAR; }
    }
    PG8_WAIT_V(0);
    if constexpr (!ALIGN_EPI) { if (wr == 0) PG8_BAR; }
    PG8_BAR;
    if constexpr (Epi::AFTER_DRAIN) { E.fused(acc, cur, wr, wc, fr, fq, lds, wid, lane); S.done(cur); }
#undef PG8_SA
#undef PG8_SB
#undef PG8_STAGE
#undef PG8_LDA
#undef PG8_LDB
#undef PG8_MMA
#undef PG8_WAIT_V
#undef PG8_WAIT_L
#undef PG8_BAR
#undef PG8_SCHED
}
}

#define LAS __attribute__((address_space(3)))
typedef unsigned short bf16_t;
typedef short bf16x8 __attribute__((ext_vector_type(8)));
typedef float f32x4 __attribute__((ext_vector_type(4)));
typedef float f32x16 __attribute__((ext_vector_type(16)));
typedef unsigned u32x4 __attribute__((ext_vector_type(4)));
typedef unsigned u32x2 __attribute__((ext_vector_type(2)));
typedef short v4i16_t __attribute__((ext_vector_type(4)));
typedef float f32x2_t __attribute__((ext_vector_type(2)));
typedef __bf16 bf16x2_t __attribute__((ext_vector_type(2)));

constexpr int D = 1024, FF = 2816, NMOD = 9, MODW = NMOD * D;
constexpr int GM = 32768;
constexpr int ZW = 1280;
constexpr int INW = 1184;
constexpr int NWAVES = 8, NT = 512;
constexpr float EPS = 1e-6f;
constexpr float LOG2E = 1.4426950408889634f;
constexpr float LOG2_THETA = 13.287712379549449f;

constexpr size_t MiB = 1u << 20;
constexpr size_t WS_MOD = 0;
constexpr size_t MOD_BYTES = 12 * MODW * 4;
constexpr size_t WS_BAR = 768 * 1024;
constexpr size_t CTL_ZERO_BYTES = 1 * MiB;
constexpr size_t WS_WGU1 = 1 * MiB;
constexpr size_t WS_WD1 = WS_WGU1 + (size_t)5632 * 1024 * 2;
constexpr size_t WS_WGU2 = WS_WD1 + (size_t)1024 * 2816 * 2;
constexpr size_t WS_WD2 = WS_WGU2 + (size_t)5632 * 1024 * 2;
constexpr size_t WS_WIN = WS_WD2 + (size_t)1024 * 2816 * 2;
constexpr size_t WS_WUQ = WS_WIN + (size_t)1280 * 1024 * 2;
constexpr size_t WS_WUKV = WS_WUQ + (size_t)768 * 256 * 2;
constexpr size_t WS_WOUT = WS_WUKV + (size_t)1024 * 256 * 2;
constexpr size_t WS_WEND = WS_WOUT + (size_t)1024 * 1024 * 2;
static_assert(WS_WEND <= 40 * MiB, "weights region");
constexpr size_t WS_H = 40 * MiB;
constexpr size_t WS_B = 104 * MiB;
constexpr size_t WS_ACT = WS_B;
constexpr size_t WS_Z = WS_B;
constexpr size_t WS_QB = WS_Z + (size_t)GM * ZW * 2;
constexpr size_t WS_KV = WS_QB + (size_t)GM * 768 * 2;
constexpr size_t WS_KB = WS_KV + (size_t)GM * 1024 * 2;
constexpr size_t WS_END = WS_KB + (size_t)GM * 768 * 2;
static_assert(WS_END <= 400 * MiB && WS_ACT + (size_t)GM * FF * 2 <= 400 * MiB, "ws map");

constexpr int LDS_BYTES = 131072 + 4096;

__device__ __forceinline__ unsigned f2bf(float f) { unsigned u = __builtin_bit_cast(unsigned, f); return (u + 0x7fffu + ((u >> 16) & 1u)) >> 16; }
__device__ __forceinline__ unsigned pk2(float lo, float hi) { f32x2_t v = {lo, hi}; bf16x2_t b = __builtin_convertvector(v, bf16x2_t); return __builtin_bit_cast(unsigned, b); }
__device__ __forceinline__ float bf2f(unsigned short b) { return __builtin_bit_cast(float, (unsigned)b << 16); }
__device__ __forceinline__ float bflo(unsigned w) { return __builtin_bit_cast(float, w << 16); }
__device__ __forceinline__ float bfhi(unsigned w) { return __builtin_bit_cast(float, w & 0xffff0000u); }
template <int M> __device__ __forceinline__ float swz_xor(float v) { return __builtin_bit_cast(float, __builtin_amdgcn_ds_swizzle(__builtin_bit_cast(int, v), (M << 10) | 0x1f)); }
__device__ __forceinline__ float half_sum(float v) { v += swz_xor<1>(v); v += swz_xor<2>(v); v += swz_xor<4>(v); v += swz_xor<8>(v); v += swz_xor<16>(v); return v; }
__device__ __forceinline__ void xhalf_pair(float v, float& lo, float& hi) { unsigned a = __builtin_bit_cast(unsigned, v), b = a;
    asm volatile("s_nop 1\n\tv_permlane32_swap_b32 %0, %1\n\ts_nop 1" : "+v"(a), "+v"(b)); lo = __builtin_bit_cast(float, a); hi = __builtin_bit_cast(float, b); }
__device__ __forceinline__ float xhalf_sum(float v) { float lo, hi; xhalf_pair(v, lo, hi); return lo + hi; }
__device__ __forceinline__ float xhalf_max(float v) { float lo, hi; xhalf_pair(v, lo, hi); return fmaxf(lo, hi); }
__device__ __forceinline__ float wave_sum(float v) { return xhalf_sum(half_sum(v)); }

namespace pg8 {
struct EpiPlain {
    static constexpr bool PERM = true, AFTER_DRAIN = false;
    bf16_t* O; int ldc;
    __device__ __forceinline__ void operator()(const f32x4 (&acc)[2][2][4][2], const Unit& u, int wr, int wc, int fr, int fq) const {
        const int row0 = u.pm * BM + wr * 64 + fr, col0 = u.pn * BM + wc * 32 + 8 * fq;
#pragma unroll
        for (int ai = 0; ai < 2; ++ai)
#pragma unroll
            for (int m = 0; m < 4; ++m) { bf16_t* rowp = O + (size_t)(row0 + ai * HALF + m * 16) * ldc + col0;
#pragma unroll
                for (int bj = 0; bj < 2; ++bj) { const f32x4 v0 = acc[ai][bj][m][0], v1 = acc[ai][bj][m][1];
                    u32x4 w; w.x = pk2(v0[0], v0[1]); w.y = pk2(v0[2], v0[3]); w.z = pk2(v1[0], v1[1]); w.w = pk2(v1[2], v1[3]);
                    *(u32x4*)(rowp + bj * HALF) = w; } }
    }
};
__device__ __forceinline__ float silu_mul(float g, float u) { return g * u * __builtin_amdgcn_rcpf(1.0f + __builtin_amdgcn_exp2f(-g * LOG2E)); }
struct EpiSwiGLU {
    static constexpr bool PERM = true, AFTER_DRAIN = false;
    bf16_t* O; int ldc;
    __device__ __forceinline__ void operator()(const f32x4 (&acc)[2][2][4][2], const Unit& u, int wr, int wc, int fr, int fq) const {
        const int row0 = u.pm * BM + wr * 64 + fr, col0 = u.pn * HALF + wc * 32 + 8 * fq;
#pragma unroll
        for (int ai = 0; ai < 2; ++ai)
#pragma unroll
            for (int m = 0; m < 4; ++m) { bf16_t* rowp = O + (size_t)(row0 + ai * HALF + m * 16) * ldc + col0;
                const f32x4 g0 = acc[ai][0][m][0], g1 = acc[ai][0][m][1], u0 = acc[ai][1][m][0], u1 = acc[ai][1][m][1];
                u32x4 w; w.x = pk2(silu_mul(g0[0], u0[0]), silu_mul(g0[1], u0[1])); w.y = pk2(silu_mul(g0[2], u0[2]), silu_mul(g0[3], u0[3]));
                w.z = pk2(silu_mul(g1[0], u1[0]), silu_mul(g1[1], u1[1])); w.w = pk2(silu_mul(g1[2], u1[2]), silu_mul(g1[3], u1[3]));
                *(u32x4*)rowp = w; }
    }
};
struct EpiResid {
    static constexpr bool PERM = false, AFTER_DRAIN = false;
    const float* base; float* out; const float* gate  ; int seq_shift  ; float scale;
    __device__ __forceinline__ void operator()(const f32x4 (&acc)[2][2][4][2], const Unit& u, int wr, int wc, int fr, int fq) const {
        const int row0 = u.pm * BM + wr * 64 + fr, col0 = u.pn * BM + wc * 32 + 4 * fq;
        const float* gp = gate + (size_t)((u.pm * BM) >> seq_shift) * MODW + col0;
#pragma unroll
        for (int bj = 0; bj < 2; ++bj)
#pragma unroll
            for (int n = 0; n < 2; ++n) { const f32x4 gv = *(const f32x4*)(gp + bj * HALF + n * 16) * scale;
#pragma unroll
                for (int ai = 0; ai < 2; ++ai)
#pragma unroll
                    for (int m = 0; m < 4; ++m) { const size_t off = (size_t)(row0 + ai * HALF + m * 16) * D + col0 + bj * HALF + n * 16;
                        const f32x4 b = *(const f32x4*)(base + off); *(f32x4*)(out + off) = b + gv * acc[ai][bj][m][n]; } }
    }
};
}

struct Args { const float* in[27]; float* out; unsigned char* ws; };

__device__ __forceinline__ void transpose_item(const float* W, int K, int N, bf16_t* WT, int mode, LAS float* scr, int item, int lane) {
    const int nblk = N / 32, kb = item / nblk, nb = item % nblk, k0 = 64 * kb, n0 = 32 * nb;
    int d0 = n0;
    if (mode == 1) d0 = (n0 >> 7) * 256 + (n0 & 127);
    else if (mode == 2) d0 = (n0 >> 7) * 256 + 128 + (n0 & 127);
#pragma unroll 8
    for (int i = 0; i < 32; ++i) { const int kk = 2 * i + (lane >> 5); scr[kk * 33 + (lane & 31)] = W[(size_t)(k0 + kk) * N + n0 + (lane & 31)]; }
    asm volatile("s_waitcnt lgkmcnt(0)" ::: "memory");
    const int c = lane & 7;
#pragma unroll
    for (int j = 0; j < 4; ++j) { const int n = (lane >> 3) + 8 * j; const LAS float* s = scr + (8 * c) * 33 + n;
        u32x4 o; o.x = pk2(s[0 * 33], s[1 * 33]); o.y = pk2(s[2 * 33], s[3 * 33]); o.z = pk2(s[4 * 33], s[5 * 33]); o.w = pk2(s[6 * 33], s[7 * 33]);
        *(u32x4*)(WT + (size_t)(d0 + n) * K + k0 + 8 * c) = o; }
    asm volatile("s_waitcnt lgkmcnt(0)" ::: "memory");
}

typedef const Args __attribute__((address_space(4)))* KArgs0;
__device__ __forceinline__ void phase0(KArgs0 ap, LAS unsigned char* lds, int tid, int wave, int lane) {
    unsigned char* ws = ap->ws;
    {
        LAS float* scr = (LAS float*)(lds + wave * 8704);
        const int gw = blockIdx.x * NWAVES + wave, NGW = gridDim.x * NWAVES;
        constexpr int I_G = (D / 64) * (FF / 32), I_D = (FF / 64) * (D / 32), I_IN = (D / 64) * (INW / 32), I_UQ = (256 / 64) * (768 / 32), I_UKV = (128 / 64) * (1024 / 32), I_OUT = (D / 64) * (D / 32);
        constexpr int NITEMS = 4 * I_G + 2 * I_D + I_IN + I_UQ + I_UKV + I_OUT;
        for (int it = gw; it < NITEMS; it += NGW) {
            int r = it;
            if (r < I_G) { transpose_item(ap->in[7], D, FF, (bf16_t*)(ws + WS_WGU1), 1, scr, r, lane); continue; } r -= I_G;
            if (r < I_G) { transpose_item(ap->in[8], D, FF, (bf16_t*)(ws + WS_WGU1), 2, scr, r, lane); continue; } r -= I_G;
            if (r < I_D) { transpose_item(ap->in[9], FF, D, (bf16_t*)(ws + WS_WD1), 0, scr, r, lane); continue; } r -= I_D;
            if (r < I_G) { transpose_item(ap->in[23], D, FF, (bf16_t*)(ws + WS_WGU2), 1, scr, r, lane); continue; } r -= I_G;
            if (r < I_G) { transpose_item(ap->in[24], D, FF, (bf16_t*)(ws + WS_WGU2), 2, scr, r, lane); continue; } r -= I_G;
            if (r < I_D) { transpose_item(ap->in[25], FF, D, (bf16_t*)(ws + WS_WD2), 0, scr, r, lane); continue; } r -= I_D;
            if (r < I_IN) { transpose_item(ap->in[11], D, INW, (bf16_t*)(ws + WS_WIN), 0, scr, r, lane); continue; } r -= I_IN;
            if (r < I_UQ) { transpose_item(ap->in[16], 256, 768, (bf16_t*)(ws + WS_WUQ), 0, scr, r, lane); continue; } r -= I_UQ;
            if (r < I_UKV) { transpose_item(ap->in[18], 256, 1024, (bf16_t*)(ws + WS_WUKV), 0, scr, r, lane); continue; } r -= I_UKV;
            transpose_item(ap->in[21], D, D, (bf16_t*)(ws + WS_WOUT), 0, scr, r, lane);
        }
        { for (int i = blockIdx.x * NT + tid; i < 1024 * 16; i += gridDim.x * NT) *(u32x4*)(ws + WS_WUKV + (size_t)(i >> 4) * 512 + 256 + (i & 15) * 16) = (u32x4){0u, 0u, 0u, 0u}; }
        { u32x4* p = (u32x4*)(ws + WS_WIN + (size_t)INW * D * 2); const int n16 = (ZW - INW) * D * 2 / 16;
          for (int i = blockIdx.x * NT + tid; i < n16; i += gridDim.x * NT) p[i] = (u32x4){0u, 0u, 0u, 0u}; }
    }
    __syncthreads();
    {
        LAS float* sc = (LAS float*)lds;
        float* mod = (float*)(ws + WS_MOD);
        const float* adaw = ap->in[4]; const float* adab = ap->in[5];
        for (int item = blockIdx.x; item < 18 * 16; item += gridDim.x) {
            const int cb = item % 18, kc = item / 18;
            __syncthreads();
            for (int i = tid; i < 12 * 64; i += NT) { const int s = i >> 6, kk = i & 63;
                const float c = (s < 4) ? ap->in[2][s * D + kc * 64 + kk] : ap->in[3][(s - 4) * D + kc * 64 + kk];
                sc[i] = c / (1.0f + __expf(-c)); }
            __syncthreads();
            const int col = cb * 512 + tid;
            float acc[12];
#pragma unroll
            for (int s = 0; s < 12; ++s) acc[s] = 0.f;
            const float* wp = adaw + (size_t)(kc * 64) * MODW + col;
#pragma unroll 8
            for (int kk = 0; kk < 64; ++kk) { const float w = wp[(size_t)kk * MODW];
#pragma unroll
                for (int s = 0; s < 12; ++s) acc[s] += sc[s * 64 + kk] * w; }
            const float b = (kc == 0) ? adab[col] : 0.f;
#pragma unroll
            for (int s = 0; s < 12; ++s) atomicAdd(mod + s * MODW + col, acc[s] + b);
        }
    }
}

__device__ __forceinline__ void norm_mod_phase(const float* x, const float* gain, const float* mod  , int shoff, int seq_shift, bf16_t* H, int wave, int lane) {
    const int gw = blockIdx.x * NWAVES + wave, NGW = gridDim.x * NWAVES;
    f32x4 gv[4];
#pragma unroll
    for (int j = 0; j < 4; ++j) gv[j] = *(const f32x4*)(gain + 256 * j + 4 * lane);
    for (int m = gw; m < GM; m += NGW) {
        const f32x4* xr = (const f32x4*)(x + (size_t)m * D) + lane;
        f32x4 v[4]; float s = 0.f;
#pragma unroll
        for (int j = 0; j < 4; ++j) { v[j] = xr[64 * j]; s += (v[j].x * v[j].x + v[j].y * v[j].y) + (v[j].z * v[j].z + v[j].w * v[j].w); }
        const float rstd = 1.0f / sqrtf(wave_sum(s) * (1.0f / D) + EPS);
        const float* mp = mod + (size_t)(m >> seq_shift) * MODW + shoff;
        u32x2* o8 = (u32x2*)(H + (size_t)m * D) + lane;
#pragma unroll
        for (int j = 0; j < 4; ++j) { const f32x4 sh = *(const f32x4*)(mp + 256 * j + 4 * lane), sc = *(const f32x4*)(mp + D + 256 * j + 4 * lane);
            const f32x4 y = v[j] * rstd * gv[j] * (sc + 1.0f) + sh; u32x2 w; w.x = pk2(y.x, y.y); w.y = pk2(y.z, y.w); o8[64 * j] = w; }
    }
}
__device__ __forceinline__ void final_norm_phase(float* x, const float* gain, int wave, int lane) {
    const int gw = blockIdx.x * NWAVES + wave, NGW = gridDim.x * NWAVES;
    f32x4 gv[4];
#pragma unroll
    for (int j = 0; j < 4; ++j) gv[j] = *(const f32x4*)(gain + 256 * j + 4 * lane);
    for (int m = gw; m < GM; m += NGW) {
        f32x4* xr = (f32x4*)(x + (size_t)m * D) + lane;
        f32x4 v[4]; float s = 0.f;
#pragma unroll
        for (int j = 0; j < 4; ++j) { v[j] = xr[64 * j]; s += (v[j].x * v[j].x + v[j].y * v[j].y) + (v[j].z * v[j].z + v[j].w * v[j].w); }
        const float rstd = 1.0f / sqrtf(wave_sum(s) * (1.0f / D) + EPS);
#pragma unroll
        for (int j = 0; j < 4; ++j) xr[64 * j] = v[j] * rstd * gv[j];
    }
}

__device__ __forceinline__ void post1_phase(bf16_t* Z, int Smask, const float* gq, const float* gk, const float* gcq, const float* gckv, int wave, int lane) {
    const int gw = blockIdx.x * NWAVES + wave, NGW = gridDim.x * NWAVES;
    const int i = lane & 31, hsel = lane >> 5;
    const float invf = exp2f(-(float)i * (LOG2_THETA / 32.0f));
    const float gq0 = gq[i], gq1 = gq[i + 32], gk0 = gk[i], gk1 = gk[i + 32];
    const float gc0 = gcq[4 * lane], gc1 = gcq[4 * lane + 1], gc2 = gcq[4 * lane + 2], gc3 = gcq[4 * lane + 3];
    const float gv0 = gckv[2 * lane], gv1 = gckv[2 * lane + 1];
    for (int m = gw; m < GM; m += NGW) {
        bf16_t* z = Z + (size_t)m * ZW;
        const float pos = (float)(m & Smask);
        float sn, cs; sincosf(pos * invf, &sn, &cs);
#pragma unroll
        for (int it = 0; it < 5; ++it) {
            const int hh = 2 * it + hsel;
            bf16_t* p = z + hh * 64 + i;
            const float x1 = bf2f(p[0]), x2 = bf2f(p[32]);
            float ss = x1 * x1 + x2 * x2;
            ss = half_sum(ss);
            const float rstd = 1.0f / sqrtf(ss * (1.0f / 64.0f) + EPS);
            const bool isq = hh < 8;
            const float y1 = x1 * rstd * (isq ? gq0 : gk0), y2 = x2 * rstd * (isq ? gq1 : gk1);
            const float scl = isq ? (0.125f * LOG2E) : 1.0f;
            p[0] = (bf16_t)f2bf((y1 * cs - y2 * sn) * scl); p[32] = (bf16_t)f2bf((y2 * cs + y1 * sn) * scl);
        }
        {
            u32x2* p = (u32x2*)(z + 768) + lane; const u32x2 w = *p;
            const float a0 = bflo(w.x), a1 = bfhi(w.x), a2 = bflo(w.y), a3 = bfhi(w.y);
            const float rstd = 1.0f / sqrtf(wave_sum((a0 * a0 + a1 * a1) + (a2 * a2 + a3 * a3)) * (1.0f / 256.0f) + EPS);
            u32x2 o; o.x = pk2(a0 * rstd * gc0, a1 * rstd * gc1); o.y = pk2(a2 * rstd * gc2, a3 * rstd * gc3); *p = o;
        }
        {
            unsigned* p = (unsigned*)(z + 1024) + lane; const unsigned w = *p;
            const float a0 = bflo(w), a1 = bfhi(w);
            const float rstd = 1.0f / sqrtf(wave_sum(a0 * a0 + a1 * a1) * (1.0f / 128.0f) + EPS);
            *p = pk2(a0 * rstd * gv0, a1 * rstd * gv1);
        }
    }
}

__device__ __forceinline__ void post2_phase(bf16_t* QB, const bf16_t* KV, const bf16_t* Z, bf16_t* KB, int Smask, const float* gq, const float* gk, int wave, int lane) {
    const int gw = blockIdx.x * NWAVES + wave, NGW = gridDim.x * NWAVES;
    const bool nope = lane < 32, ropel = (lane >= 32 && lane < 48), act = lane < 48;
    const int i = lane - 32;
    const int e0 = nope ? lane : (64 + (i & 15)), e1 = nope ? lane + 32 : (80 + (i & 15));
    const float invf = exp2f(-(float)(i & 15) * (LOG2_THETA / 16.0f));
    const float gq0 = gq[e0], gq1 = gq[e1], gk0 = gk[e0], gk1 = gk[e1];
    const float qscl = 0.10206207261596577f * LOG2E;
    for (int m = gw; m < GM; m += NGW) {
        const float pos = (float)(m & Smask);
        float sn = 0.f, cs = 1.f;
        if (ropel) sincosf(pos * invf, &sn, &cs);
        bf16_t* q = QB + (size_t)m * 768; const bf16_t* kv = KV + (size_t)m * 1024; bf16_t* kb = KB + (size_t)m * 768;
        const bf16_t* kr = Z + (size_t)m * ZW + 1152;
        float kr0 = 0.f, kr1 = 0.f;
        if (ropel) { kr0 = bf2f(kr[i]); kr1 = bf2f(kr[16 + i]); }
#pragma unroll 2
        for (int h = 0; h < 8; ++h) {
            float x0 = 0.f, x1 = 0.f;
            if (act) { x0 = bf2f(q[h * 96 + e0]); x1 = bf2f(q[h * 96 + e1]); }
            float rstd = 1.0f / sqrtf(wave_sum(x0 * x0 + x1 * x1) * (1.0f / 96.0f) + EPS);
            float y0 = x0 * rstd * gq0, y1 = x1 * rstd * gq1;
            if (ropel) { const float t0 = y0 * cs - y1 * sn, t1 = y1 * cs + y0 * sn; y0 = t0; y1 = t1; }
            if (act) { q[h * 96 + e0] = (bf16_t)f2bf(y0 * qscl); q[h * 96 + e1] = (bf16_t)f2bf(y1 * qscl); }
            float k0 = kr0, k1 = kr1;
            if (nope) { k0 = bf2f(kv[h * 128 + lane]); k1 = bf2f(kv[h * 128 + lane + 32]); }
            rstd = 1.0f / sqrtf(wave_sum(k0 * k0 + k1 * k1) * (1.0f / 96.0f) + EPS);
            float z0 = k0 * rstd * gk0, z1 = k1 * rstd * gk1;
            if (ropel) { const float t0 = z0 * cs - z1 * sn, t1 = z1 * cs + z0 * sn; z0 = t0; z1 = t1; }
            if (act) { kb[h * 96 + e0] = (bf16_t)f2bf(z0); kb[h * 96 + e1] = (bf16_t)f2bf(z1); }
        }
    }
}

#define XB_TMO      128
#define XB_XCNT(j)  (256  + 64 * (j))
#define XB_XSUB(j)  (1280 + 64 * (j))
#define XB_XGEN(j)  (2304 + 64 * (j))
#define XB_TOP      3328
#define XB_TOPGEN   3392
#define XCD_BAR_WORDS 3456
#define XB_SPIN_CAP (1u << 22)

__device__ __forceinline__ unsigned xb_ld(unsigned* p)              { return __hip_atomic_load(p, __ATOMIC_RELAXED, __HIP_MEMORY_SCOPE_AGENT); }
__device__ __forceinline__ unsigned xb_add(unsigned* p, unsigned v) { return __hip_atomic_fetch_add(p, v, __ATOMIC_RELAXED, __HIP_MEMORY_SCOPE_AGENT); }
__device__ __forceinline__ unsigned xb_xcc_id() { return (unsigned)__builtin_amdgcn_s_getreg((3 << 11) | 20) & 0xFu; }
#define XB_SPIN(cond, bar) do { unsigned _sp = 0; while (cond) { __builtin_amdgcn_s_sleep(1); \
    if ((++_sp & 255u) == 0u) { if (xb_ld(&(bar)[XB_TMO])) break; if (_sp > XB_SPIN_CAP) { atomicAdd(&(bar)[XB_TMO], 1u); break; } } } } while (0)

struct XcdBarrier {
    unsigned* bar; unsigned x;
    volatile LAS unsigned* st;
};

__device__ __forceinline__ XcdBarrier xcd_barrier_post(unsigned* bar, volatile LAS unsigned* st, bool leader) {
    XcdBarrier b; b.bar = bar; b.x = xb_xcc_id(); b.st = st;
    if (leader) (void)xb_add(&bar[XB_XCNT(b.x)], 1u);
    return b;
}
__device__ __forceinline__ void xcd_barrier_complete(unsigned* bar, unsigned x, unsigned& nloc, unsigned& nx) {
    const unsigned G = gridDim.x * gridDim.y * gridDim.z;
    unsigned sum, cnt, mine, sp = 0u;
    for (;;) {
        sum = 0u; cnt = 0u; mine = 0u;
#pragma unroll
        for (unsigned j = 0; j < 16; ++j) { const unsigned c = xb_ld(&bar[XB_XCNT(j)]); sum += c; cnt += (c > 0u) ? 1u : 0u; mine = (j == x) ? c : mine; }
        if (sum == G) break;
        __builtin_amdgcn_s_sleep(1);
        if ((++sp & 255u) == 0u) { if (xb_ld(&bar[XB_TMO])) break; if (sp > XB_SPIN_CAP) { atomicAdd(&bar[XB_TMO], 1u); break; } }
    }
    nloc = mine > 0u ? mine : 1u; nx = cnt > 0u ? cnt : 1u;
}

__device__ __forceinline__ void xcd_barrier(const XcdBarrier& b, bool leader) {
    asm volatile("s_waitcnt vmcnt(0)" ::: "memory");
    __syncthreads();
    if (leader) {
        unsigned* bar = b.bar;
        __builtin_amdgcn_s_waitcnt(0);
        unsigned nloc = b.st[0], nx = b.st[1];
        if (nloc == 0u) { xcd_barrier_complete(bar, b.x, nloc, nx); b.st[0] = nloc; b.st[1] = nx; }
        const unsigned old = xb_add(&bar[XB_XSUB(b.x)], 1u);
        const unsigned gen = old / nloc;
        if (old + 1u == (gen + 1u) * nloc) {
            __builtin_amdgcn_fence(__ATOMIC_RELEASE, "agent");
            asm volatile("s_waitcnt vmcnt(0)" ::: "memory");
            const unsigned og = xb_add(&bar[XB_TOP], 1u);
            const unsigned tg = og / nx;
            if (og + 1u == (tg + 1u) * nx) xb_add(&bar[XB_TOPGEN], 1u);
            else XB_SPIN(xb_ld(&bar[XB_TOPGEN]) == tg, bar);
            __builtin_amdgcn_fence(__ATOMIC_ACQUIRE, "agent");
            xb_add(&bar[XB_XGEN(b.x)], 1u);
            asm volatile("s_waitcnt vmcnt(0)" ::: "memory");
        } else {
            XB_SPIN(xb_ld(&bar[XB_XGEN(b.x)]) == gen, bar);
            __builtin_amdgcn_fence(__ATOMIC_ACQUIRE, "agent");
            asm volatile("s_waitcnt vmcnt(0)" ::: "memory");
        }
    }
    __syncthreads();
}

__device__ __forceinline__ int crow(int r, int hi) { return (r & 3) + 8 * (r >> 2) + 4 * hi; }
#define MFMA32(a, b, c) __builtin_amdgcn_mfma_f32_32x32x16_bf16((a), (b), (c), 0, 0, 0)
constexpr int ATT_VP = 192;
template <int DQ> struct AttnCfg { static constexpr int KP = DQ * 2 + 16, KBUF = 64 * KP, VBUF = 64 * ATT_VP, CPR = DQ / 8, NKCH = 64 * CPR; };

template <int DQ, bool SWA>
__device__ __forceinline__ void attn_unit(const bf16_t* Qp, int ldq, const bf16_t* Kp, int ldk, const bf16_t* Vp, int ldv, bf16_t* Op, int ldo,
                                          int S, int q0, float sink_l2, LAS unsigned char* lds, int tid, int wave, int lane) {
    typedef AttnCfg<DQ> C;
    constexpr int NKS = DQ / 16;
    LAS unsigned char* Kb = lds;
    LAS unsigned char* Vb = lds + 2 * C::KBUF;
    LAS float* scr = (LAS float*)(lds + 2 * C::KBUF + 2 * C::VBUF) + wave * 64;
    const int r = lane & 31, h = lane >> 5;
    const int qw = q0 + wave * 32;
    bf16x8 qf[NKS];
#pragma unroll
    for (int ks = 0; ks < NKS; ++ks) qf[ks] = *(const bf16x8*)(Qp + (size_t)(qw + r) * ldq + 16 * ks + 8 * h);
    int t_lo = 0, t_hi = S / 64;
    if (SWA) { const int lo = q0 - 128 < 0 ? 0 : q0 - 128, hi = q0 + 384 > S ? S : q0 + 384; t_lo = lo / 64; t_hi = hi / 64; }
    const int vrow = tid >> 3, vch = tid & 7;
    const int k0row = tid / C::CPR, k0ch = tid % C::CPR;
    const int k1idx = tid + 512; const bool k1on = k1idx < C::NKCH; const int k1row = k1idx / C::CPR, k1ch = k1idx % C::CPR;
    u32x4 rv, rk0, rk1 = (u32x4){0u, 0u, 0u, 0u};
#define ATT_GLOAD(t) do { const size_t kb_ = (size_t)(t) * 64; \
        rv = *(const u32x4*)(Vp + (kb_ + vrow) * ldv + vch * 8); \
        rk0 = *(const u32x4*)(Kp + (kb_ + k0row) * ldk + k0ch * 8); \
        if (k1on) rk1 = *(const u32x4*)(Kp + (kb_ + k1row) * ldk + k1ch * 8); } while (0)
#define ATT_LSTORE(b) do { *(LAS u32x4*)(Vb + (b) * C::VBUF + vrow * ATT_VP + vch * 16) = rv; \
        *(LAS u32x4*)(Kb + (b) * C::KBUF + k0row * C::KP + k0ch * 16) = rk0; \
        if (k1on) *(LAS u32x4*)(Kb + (b) * C::KBUF + k1row * C::KP + k1ch * 16) = rk1; } while (0)
    float mref = SWA ? sink_l2 : -1e30f;
    float lsum = (SWA && h == 0) ? 1.0f : 0.0f;
    f32x16 o0, o1;
#pragma unroll
    for (int i = 0; i < 16; ++i) { o0[i] = 0.f; o1[i] = 0.f; }
    const int koff = r * C::KP + 16 * h;
    const int voff = (4 * h + ((lane & 15) >> 2)) * ATT_VP + ((lane >> 4) & 1) * 32 + (lane & 3) * 8;
    ATT_GLOAD(t_lo); ATT_LSTORE(0);
    __syncthreads();
    for (int t = t_lo; t < t_hi; ++t) {
        const int cur = (t - t_lo) & 1;
        const bool more = (t + 1 < t_hi);
        if (more) ATT_GLOAD(t + 1);
        bool need = true;
        if (SWA) need = (64 * t + 63 >= qw - 128) && (64 * t <= qw + 31 + 128);
        if (need) {
            const LAS unsigned char* kb = Kb + cur * C::KBUF + koff;
            f32x16 p0, p1;
#pragma unroll
            for (int i = 0; i < 16; ++i) { p0[i] = 0.f; p1[i] = 0.f; }
#pragma unroll
            for (int ks = 0; ks < NKS; ++ks) {
                const bf16x8 a0 = *(const LAS bf16x8*)(kb + ks * 32);
                const bf16x8 a1 = *(const LAS bf16x8*)(kb + 32 * C::KP + ks * 32);
                p0 = MFMA32(a0, qf[ks], p0);
                p1 = MFMA32(a1, qf[ks], p1);
            }
            if (SWA) {
                const int qpos = qw + r, kb0 = 64 * t + 4 * h;
#pragma unroll
                for (int i = 0; i < 16; ++i) { const int kp = kb0 + (i & 3) + 8 * (i >> 2); const int d0_ = kp - qpos, d1_ = d0_ + 32;
                    if (d0_ > 128 || d0_ < -128) p0[i] = -1e30f; if (d1_ > 128 || d1_ < -128) p1[i] = -1e30f; }
            }
            float mx = fmaxf(p0[0], p1[0]);
#pragma unroll
            for (int i = 1; i < 16; ++i) mx = fmaxf(mx, fmaxf(p0[i], p1[i]));
            mx = xhalf_max(mx);
            if (__any(mx > mref + 8.0f)) {
                const float mnew = fmaxf(mref, mx), alpha = __builtin_amdgcn_exp2f(mref - mnew);
                mref = mnew; lsum *= alpha;
                if (h == 0) scr[r] = alpha;
                asm volatile("s_waitcnt lgkmcnt(0)" ::: "memory");
#pragma unroll
                for (int g = 0; g < 4; ++g) { const f32x4 av = *(const LAS f32x4*)(scr + 8 * g + 4 * h);
#pragma unroll
                    for (int j = 0; j < 4; ++j) { o0[4 * g + j] *= av[j]; o1[4 * g + j] *= av[j]; } }
                asm volatile("s_waitcnt lgkmcnt(0)" ::: "memory");
            }
            float ps = 0.f;
#pragma unroll
            for (int i = 0; i < 16; ++i) { p0[i] = __builtin_amdgcn_exp2f(p0[i] - mref); p1[i] = __builtin_amdgcn_exp2f(p1[i] - mref); ps += p0[i] + p1[i]; }
            lsum += ps;
            bf16x8 pf[4];
#pragma unroll
            for (int s2 = 0; s2 < 2; ++s2) {
                u32x4 w0, w1;
                w0.x = pk2(p0[8 * s2 + 0], p0[8 * s2 + 1]); w0.y = pk2(p0[8 * s2 + 2], p0[8 * s2 + 3]); w0.z = pk2(p0[8 * s2 + 4], p0[8 * s2 + 5]); w0.w = pk2(p0[8 * s2 + 6], p0[8 * s2 + 7]);
                w1.x = pk2(p1[8 * s2 + 0], p1[8 * s2 + 1]); w1.y = pk2(p1[8 * s2 + 2], p1[8 * s2 + 3]); w1.z = pk2(p1[8 * s2 + 4], p1[8 * s2 + 5]); w1.w = pk2(p1[8 * s2 + 6], p1[8 * s2 + 7]);
                pf[s2] = __builtin_bit_cast(bf16x8, w0); pf[2 + s2] = __builtin_bit_cast(bf16x8, w1);
            }
            const LAS unsigned char* vb = Vb + cur * C::VBUF + voff;
#pragma unroll
            for (int s = 0; s < 4; ++s) {
                const v4i16_t l0 = __builtin_amdgcn_ds_read_tr16_b64_v4i16((LAS v4i16_t*)(vb + (16 * s) * ATT_VP));
                const v4i16_t h0 = __builtin_amdgcn_ds_read_tr16_b64_v4i16((LAS v4i16_t*)(vb + (16 * s + 8) * ATT_VP));
                const v4i16_t l1 = __builtin_amdgcn_ds_read_tr16_b64_v4i16((LAS v4i16_t*)(vb + (16 * s) * ATT_VP + 64));
                const v4i16_t h1 = __builtin_amdgcn_ds_read_tr16_b64_v4i16((LAS v4i16_t*)(vb + (16 * s + 8) * ATT_VP + 64));
                const bf16x8 v0 = (bf16x8){l0[0], l0[1], l0[2], l0[3], h0[0], h0[1], h0[2], h0[3]};
                const bf16x8 v1 = (bf16x8){l1[0], l1[1], l1[2], l1[3], h1[0], h1[1], h1[2], h1[3]};
                o0 = MFMA32(pf[s], v0, o0);
                o1 = MFMA32(pf[s], v1, o1);
            }
        }
        if (more) ATT_LSTORE(cur ^ 1);
        __syncthreads();
    }
    lsum = xhalf_sum(lsum);
    if (h == 0) scr[r] = 1.0f / lsum;
    asm volatile("s_waitcnt lgkmcnt(0)" ::: "memory");
#pragma unroll
    for (int g = 0; g < 4; ++g) { const f32x4 av = *(const LAS f32x4*)(scr + 8 * g + 4 * h);
#pragma unroll
        for (int j = 0; j < 4; ++j) { const int q = qw + 8 * g + 4 * h + j; bf16_t* op = Op + (size_t)q * ldo + r;
            op[0] = (bf16_t)f2bf(o0[4 * g + j] * av[j]); op[32] = (bf16_t)f2bf(o1[4 * g + j] * av[j]); } }
    asm volatile("s_waitcnt lgkmcnt(0)" ::: "memory");
#undef ATT_GLOAD
#undef ATT_LSTORE
}

template <class Epi>
__device__ __forceinline__ void run_gemm(LAS unsigned char* lds, const bf16_t* A, int lda, const bf16_t* Bt, int N, int K, const Epi& E, int tid) {
    int bx = (int)blockIdx.x; asm volatile("" : "+s"(bx), "+s"(A), "+s"(Bt));
    pg8::Gemm g{A, Bt, GM, N, K, lda}; pg8::StaticOrder S; S.init(GM, N, (int)gridDim.x, bx);
    pg8::gemm_phase<Epi, pg8::StaticOrder, true, true>(lds, g, S, E, tid);
}

typedef const Args __attribute__((address_space(4)))* KArgs;
#define PHASE_BEGIN() KArgs ap = (KArgs)__builtin_amdgcn_kernarg_segment_ptr(); asm volatile("" : "+s"(ap)); \
    unsigned char* ws = ap->ws; (void)ws; \
    int lane; asm volatile("v_mbcnt_lo_u32_b32 %0, -1, 0\n\tv_mbcnt_hi_u32_b32 %0, -1, %0" : "=v"(lane)); const int wave = wave_s, tid = wave_s * 64 + lane; (void)tid; \
    const float* xin = ap->in[g]; (void)xin; float* out = ap->out + (size_t)g * GM * D; (void)out; \
    const float* mod = (const float*)(ws + WS_MOD) + (size_t)(g ? 4 : 0) * MODW; (void)mod; \
    const int S = g ? 4096 : 8192, seq_shift = g ? 12 : 13, nseq = g ? 8 : 4; (void)S; (void)seq_shift; (void)nseq
#define WSP(off) ((bf16_t*)(ws + (off)))

__global__ void __launch_bounds__(NT, 2) fwd_kernel(Args a) {
    extern __shared__ __attribute__((aligned(16))) unsigned char lds_raw[];
    cg::grid_group grid = cg::this_grid();
    LAS unsigned char* lds = (LAS unsigned char*)lds_raw;
    const int wave_s = __builtin_amdgcn_readfirstlane((int)threadIdx.x >> 6);
    volatile LAS unsigned* bar_st = (volatile LAS unsigned*)(lds + 131072);
    if (threadIdx.x < 2) bar_st[threadIdx.x] = 0u;
    __syncthreads();
    { const int g = 0; PHASE_BEGIN(); (void)xcd_barrier_post((unsigned*)(ws + WS_BAR), bar_st, tid == 0); phase0(ap, lds, tid, wave, lane); }
    grid.sync();
#define SEAM() do { const int g = 0; PHASE_BEGIN(); XcdBarrier b_; b_.bar = (unsigned*)(ws + WS_BAR); b_.x = xb_xcc_id(); b_.st = bar_st; xcd_barrier(b_, tid == 0); } while (0)

    for (int g = 0; g < 2; ++g) {
        { PHASE_BEGIN(); norm_mod_phase(xin, ap->in[6], mod, 0, seq_shift, WSP(WS_H), wave, lane); }
        SEAM();
        { PHASE_BEGIN(); run_gemm(lds, WSP(WS_H), D, WSP(WS_WGU1), 2 * FF, D, pg8::EpiSwiGLU{WSP(WS_ACT), FF}, tid); }
        SEAM();
        { PHASE_BEGIN(); run_gemm(lds, WSP(WS_ACT), FF, WSP(WS_WD1), D, FF, pg8::EpiResid{xin, out, mod + 2 * D, seq_shift, 0.5f}, tid); }
        SEAM();
        { PHASE_BEGIN(); norm_mod_phase(out, ap->in[10], mod, 3 * D, seq_shift, WSP(WS_H), wave, lane); }
        SEAM();
        { PHASE_BEGIN(); run_gemm(lds, WSP(WS_H), D, WSP(WS_WIN), ZW, D, pg8::EpiPlain{WSP(WS_Z), ZW}, tid); }
        SEAM();
        { PHASE_BEGIN(); post1_phase(WSP(WS_Z), S - 1, ap->in[12], ap->in[13], ap->in[15], ap->in[17], wave, lane); }
        SEAM();
        { PHASE_BEGIN(); run_gemm(lds, WSP(WS_Z) + 768, ZW, WSP(WS_WUQ), 768, 256, pg8::EpiPlain{WSP(WS_QB), 768}, tid); }
        { PHASE_BEGIN(); run_gemm(lds, WSP(WS_Z) + 1024, ZW, WSP(WS_WUKV), 1024, 256, pg8::EpiPlain{WSP(WS_KV), 1024}, tid); }
        SEAM();
        { PHASE_BEGIN(); post2_phase(WSP(WS_QB), WSP(WS_KV), WSP(WS_Z), WSP(WS_KB), S - 1, ap->in[19], ap->in[20], wave, lane); }
        SEAM();
        {
            PHASE_BEGIN();
            bf16_t* H = WSP(WS_H); bf16_t* Z = WSP(WS_Z); bf16_t* QB = WSP(WS_QB); bf16_t* KV = WSP(WS_KV); bf16_t* KB = WSP(WS_KB);
            const int nqb = S / 256, nunits = nseq * 8 * nqb;
            const int G = (int)gridDim.x, bx = (int)blockIdx.x;
            const int vcu = (G % 8 == 0) ? (bx % 8) * (G / 8) + bx / 8 : bx;
            for (int u = vcu; u < 2 * nunits; u += G) {
                const bool dense = u < nunits; const int uu = dense ? u : u - nunits;
                const int qb = uu % nqb, hd = (uu / nqb) & 7, s = uu / (nqb * 8);
                const size_t r0 = (size_t)s * S;
                if (dense)
                    attn_unit<96, false>(QB + r0 * 768 + hd * 96, 768, KB + r0 * 768 + hd * 96, 768, KV + r0 * 1024 + hd * 128 + 64, 1024,
                                         H + r0 * 1024 + 512 + hd * 64, 1024, S, qb * 256, 0.f, lds, tid, wave, lane);
                else
                    attn_unit<64, true>(Z + r0 * ZW + hd * 64, ZW, Z + r0 * ZW + 512 + (hd >> 2) * 64, ZW, Z + r0 * ZW + 640 + (hd >> 2) * 64, ZW,
                                        H + r0 * 1024 + hd * 64, 1024, S, qb * 256, ap->in[14][hd] * LOG2E, lds, tid, wave, lane);
            }
        }
        SEAM();
        { PHASE_BEGIN(); run_gemm(lds, WSP(WS_H), D, WSP(WS_WOUT), D, D, pg8::EpiResid{out, out, mod + 5 * D, seq_shift, 1.0f}, tid); }
        SEAM();
        { PHASE_BEGIN(); norm_mod_phase(out, ap->in[22], mod, 6 * D, seq_shift, WSP(WS_H), wave, lane); }
        SEAM();
        { PHASE_BEGIN(); run_gemm(lds, WSP(WS_H), D, WSP(WS_WGU2), 2 * FF, D, pg8::EpiSwiGLU{WSP(WS_ACT), FF}, tid); }
        SEAM();
        { PHASE_BEGIN(); run_gemm(lds, WSP(WS_ACT), FF, WSP(WS_WD2), D, FF, pg8::EpiResid{out, out, mod + 8 * D, seq_shift, 0.5f}, tid); }
        SEAM();
        { PHASE_BEGIN(); final_norm_phase(out, ap->in[26], wave, lane); }
    }
}

extern "C" void kernel_launch(void* const* d_in, const int* in_sizes, int n_in, void* d_out, int out_size, void* d_ws, size_t ws_size, hipStream_t stream) {
    static int grid = 0;
    if (grid == 0) {
        int dev = 0, cus = 0, per_cu = 0;
        hipGetDevice(&dev);
        hipDeviceGetAttribute(&cus, hipDeviceAttributeMultiprocessorCount, dev);
        hipFuncSetAttribute((const void*)fwd_kernel, hipFuncAttributeMaxDynamicSharedMemorySize, LDS_BYTES);
        hipOccupancyMaxActiveBlocksPerMultiprocessor(&per_cu, (const void*)fwd_kernel, NT, LDS_BYTES);
        if (per_cu < 1) per_cu = 1;
        if (per_cu > 1) per_cu = 1;
        grid = cus * per_cu;
        if (n_in != 27 || ws_size < WS_END) fprintf(stderr, "kernel_launch: unexpected n_in %d or ws_size %zu\n", n_in, ws_size);
    }
    hipMemsetAsync((char*)d_ws, 0, CTL_ZERO_BYTES, stream);
    Args a{};
    for (int i = 0; i < 27; ++i) a.in[i] = (const float*)d_in[i];
    a.out = (float*)d_out; a.ws = (unsigned char*)d_ws;
    void* args[] = {&a};
    hipError_t e = hipLaunchCooperativeKernel((const void*)fwd_kernel, dim3(grid), dim3(NT), args, LDS_BYTES, stream);
    if (e != hipSuccess) fprintf(stderr, "cooperative launch failed: %s (grid %d)\n", hipGetErrorString(e), grid);
}
```

```cpp
#include <hip/hip_runtime.h>
#include <hip/hip_cooperative_groups.h>
#include <cstdio>
#include <cstdint>
namespace cg = cooperative_groups;
namespace pg8 {
#define PG8_LAS __attribute__((address_space(3)))
typedef unsigned short bf16_t;
typedef short bf16x8 __attribute__((ext_vector_type(8)));
typedef float f32x4 __attribute__((ext_vector_type(4)));
typedef unsigned u32x4 __attribute__((ext_vector_type(4)));
constexpr int BM = 256, BK = 64, HALF = 128, HTB = HALF * BK * 2  , STAGE_BYTES = 8 * HTB, NXCD = 8, WGM = 8;

__host__ __device__ __forceinline__ int lds_byte(int r, int c) { const int st = (r >> 4) * 2 + (c >> 5), rr = r & 15, cc = c & 31, ob = rr * 64 + cc * 2; return st * 1024 + (ob ^ (((ob >> 9) & 1) << 5)); }
__host__ __device__ __forceinline__ void stage_rc(int b, int& R, int& C) { const int st = b / 1024, sb = b % 1024, swz = sb ^ (((sb >> 9) & 1) << 5); R = (st >> 1) * 16 + swz / 64; C = (st & 1) * 32 + (swz % 64) / 2; }
__host__ __device__ __forceinline__ int perm32(int rho) { const int n = rho >> 4, i = rho & 15; return 8 * (i >> 2) + 4 * n + (i & 3); }
struct Unit { int pm, pn; };
struct Gemm { const bf16_t* A; const bf16_t* Bt; int M, N, K, lda; };

struct StaticOrder {
    int nM, nN, nwg, G, c;
    __host__ __device__ void init(int M, int N, int G_, int c_) { nM = M / BM; nN = N / BM; nwg = nM * nN; G = G_; c = c_; }
    __host__ __device__ bool next(int i, Unit& u) const {
        const long L = (long)i * G + c; if (L >= nwg) return false;
        int wgid = (int)L; { const int q = nwg / NXCD, r = nwg % NXCD, xcd = wgid % NXCD, off = wgid / NXCD; wgid = (xcd < r ? xcd * (q + 1) : r * (q + 1) + (xcd - r) * q) + off; }
        const int nig = WGM * nN, gid = wgid / nig, fm = gid * WGM, gsz = (nM - fm) < WGM ? (nM - fm) : WGM;
        u.pm = fm + ((wgid % nig) % gsz); u.pn = (wgid % nig) / gsz; return true;
    }
    __device__ __forceinline__ void a_ready(const Unit&) const {}
    __device__ __forceinline__ void done(const Unit&) const {}
};
__device__ __forceinline__ unsigned cvt_pk_bf16(float lo, float hi) { unsigned r; asm volatile("v_cvt_pk_bf16_f32 %0, %1, %2" : "=v"(r) : "v"(lo), "v"(hi)); return r; }
typedef float f32x2 __attribute__((ext_vector_type(2)));
template <class Epi, class Sched, bool ALIGN_EPI = false, bool SP2 = false>
__device__ __forceinline__ void gemm_phase(PG8_LAS unsigned char* lds, const Gemm g, const Sched& S, const Epi& E, int tid_in) {
    int tid_l = tid_in; asm volatile("" : "+v"(tid_l));
    const int tid = tid_l, wid = __builtin_amdgcn_readfirstlane(tid >> 6), lane = tid & 63, wr = wid >> 2, wc = wid & 3, fr = lane & 15, fq = lane >> 4;
    const int K = g.K, nt = K / BK;
    unsigned voffA[2], voffB[2];
#pragma unroll
    for (int i = 0; i < 2; ++i) { int R, C; stage_rc(tid * 16 + i * 8192, R, C); const int Rb = Epi::PERM ? ((R & ~31) + perm32(R & 31)) : R;
        voffA[i] = (unsigned)(R * g.lda + C) * 2u; voffB[i] = (unsigned)(Rb * K + C) * 2u; }
    const size_t kstep = (size_t)(BK * 2);
    const size_t hstep = (size_t)HALF * K * 2;
    const size_t tstep = 2 * hstep;
    const size_t hstepA = (size_t)HALF * g.lda * 2, tstepA = 2 * hstepA;
    const unsigned ldsw = (unsigned)wid * 1024u;
    const int aoff = lds_byte(wr * 64 + fr, fq * 8), boff = lds_byte(wc * 32 + fr, fq * 8);
#define PG8_SA(b, h) (((b) * 2 + (h)) * HTB)
#define PG8_SB(b, h) ((4 + (b) * 2 + (h)) * HTB)
#define PG8_STAGE(bufoff, gbase, voff) do { _Pragma("unroll") for (int _i = 0; _i < 2; ++_i) \
        __builtin_amdgcn_global_load_lds((const unsigned*)((const char*)(gbase) + (voff)[_i]), (PG8_LAS unsigned*)(lds + (bufoff) + ldsw + _i * 8192), 16, 0, 0); } while (0)
#define PG8_LDA(dst, b, h) do { _Pragma("unroll") for (int m = 0; m < 4; ++m) _Pragma("unroll") for (int k = 0; k < 2; ++k) dst[m][k] = *(const PG8_LAS bf16x8*)(lds + PG8_SA(b, h) + aoff + m * 2048 + k * 1024); } while (0)
#define PG8_LDB(dst, b, h) do { _Pragma("unroll") for (int n = 0; n < 2; ++n) _Pragma("unroll") for (int k = 0; k < 2; ++k) dst[n][k] = *(const PG8_LAS bf16x8*)(lds + PG8_SB(b, h) + boff + n * 2048 + k * 1024); } while (0)
#define PG8_MMA(ai, bj, At, Bt) do { __builtin_amdgcn_s_setprio(1); _Pragma("unroll") for (int m = 0; m < 4; ++m) _Pragma("unroll") for (int n = 0; n < 2; ++n) _Pragma("unroll") for (int k = 0; k < 2; ++k) \
        acc[ai][bj][m][n] = __builtin_amdgcn_mfma_f32_16x16x32_bf16(Bt[n][k], At[m][k], acc[ai][bj][m][n], 0, 0, 0); __builtin_amdgcn_s_setprio(0); } while (0)
#define PG8_WAIT_V(n) asm volatile("s_waitcnt vmcnt(" #n ")" ::: "memory")
#define PG8_WAIT_L(n) asm volatile("s_waitcnt lgkmcnt(" #n ")" ::: "memory")
#define PG8_BAR __builtin_amdgcn_s_barrier()
#define PG8_SCHED __builtin_amdgcn_sched_barrier(0)
    Unit cur, nxt; int ui = 0;
    if (!S.next(0, cur)) return;
    f32x4 acc[2][2][4][2];
#pragma unroll
    for (int a = 0; a < 2; ++a)
#pragma unroll
        for (int b = 0; b < 2; ++b)
#pragma unroll
            for (int m = 0; m < 4; ++m)
#pragma unroll
                for (int n = 0; n < 2; ++n) acc[a][b][m][n] = (f32x4){0.f, 0.f, 0.f, 0.f};
    bf16x8 At[4][2], B0[2][2], B1[2][2];
    const char* cA = (const char*)g.A + (size_t)cur.pm * tstepA; const char* cB = (const char*)g.Bt + (size_t)cur.pn * tstep;
    S.a_ready(cur);
    if constexpr (SP2) {
        PG8_STAGE(PG8_SB(0, 0), cB, voffB); PG8_STAGE(PG8_SB(0, 1), cB + hstep, voffB); PG8_STAGE(PG8_SA(0, 0), cA, voffA); PG8_STAGE(PG8_SA(0, 1), cA + hstepA, voffA);
        if (wr == 1) PG8_BAR;
        PG8_WAIT_V(2); PG8_BAR;
        PG8_STAGE(PG8_SB(1, 0), cB + kstep, voffB); PG8_STAGE(PG8_SA(1, 0), cA + kstep, voffA); PG8_STAGE(PG8_SB(1, 1), cB + hstep + kstep, voffB);
        PG8_WAIT_V(6); PG8_BAR;
    } else {
        PG8_STAGE(PG8_SB(0, 0), cB, voffB); PG8_STAGE(PG8_SA(0, 0), cA, voffA); PG8_STAGE(PG8_SB(0, 1), cB + hstep, voffB); PG8_STAGE(PG8_SA(0, 1), cA + hstepA, voffA);
        if (wr == 1) PG8_BAR;
        PG8_WAIT_V(4); PG8_BAR;
        PG8_STAGE(PG8_SB(1, 0), cB + kstep, voffB); PG8_STAGE(PG8_SA(1, 0), cA + kstep, voffA); PG8_STAGE(PG8_SB(1, 1), cB + hstep + kstep, voffB);
        PG8_WAIT_V(6); PG8_BAR;
    }
    for (;;) {
        const bool has_next = S.next(ui + 1, nxt);
        const char* nA = has_next ? (const char*)g.A + (size_t)nxt.pm * tstepA : cA; const char* nB = has_next ? (const char*)g.Bt + (size_t)nxt.pn * tstep : cB;
        for (int t = 0; t < nt; t += 2) {
            const bool last = (t == nt - 2);
            const char* a1 = cA + (size_t)(t + 1) * kstep;
            const char* a2 = last ? nA : cA + (size_t)(t + 2) * kstep; const char* b2 = last ? nB : cB + (size_t)(t + 2) * kstep;
            const char* a3 = a2 + kstep; const char* b3 = b2 + kstep;
            if (last && has_next) S.a_ready(nxt);
            if constexpr (SP2) {
            PG8_LDB(B0, 0, 0); PG8_LDB(B1, 0, 1); PG8_SCHED; PG8_LDA(At, 0, 0); PG8_STAGE(PG8_SA(1, 1), a1 + hstepA, voffA);
            PG8_WAIT_V(8); PG8_WAIT_L(0); PG8_BAR; PG8_MMA(0, 0, At, B0); PG8_MMA(0, 1, At, B1); PG8_BAR; PG8_SCHED;
            PG8_LDA(At, 0, 1); PG8_STAGE(PG8_SB(0, 0), b2, voffB); PG8_STAGE(PG8_SB(0, 1), b2 + hstep, voffB); PG8_STAGE(PG8_SA(0, 0), a2, voffA);
            PG8_WAIT_V(8); PG8_WAIT_L(0); PG8_BAR; PG8_MMA(1, 0, At, B0); PG8_MMA(1, 1, At, B1); PG8_BAR; PG8_SCHED;
            PG8_LDB(B0, 1, 0); PG8_LDB(B1, 1, 1); PG8_SCHED; PG8_LDA(At, 1, 0); PG8_STAGE(PG8_SA(0, 1), a2 + hstepA, voffA);
            PG8_WAIT_V(8); PG8_WAIT_L(0); PG8_BAR; PG8_MMA(0, 0, At, B0); PG8_MMA(0, 1, At, B1); PG8_BAR; PG8_SCHED;
            PG8_LDA(At, 1, 1); PG8_STAGE(PG8_SB(1, 0), b3, voffB); PG8_STAGE(PG8_SB(1, 1), b3 + hstep, voffB); PG8_STAGE(PG8_SA(1, 0), a3, voffA);
            PG8_WAIT_V(8); PG8_WAIT_L(0); PG8_BAR; PG8_MMA(1, 0, At, B0); PG8_MMA(1, 1, At, B1); PG8_BAR; PG8_SCHED;
            } else {
            PG8_LDB(B0, 0, 0); PG8_SCHED; PG8_LDA(At, 0, 0); PG8_STAGE(PG8_SA(1, 1), a1 + hstepA, voffA);
            PG8_WAIT_L(8); PG8_BAR; PG8_WAIT_L(0); PG8_MMA(0, 0, At, B0); PG8_BAR; PG8_SCHED;
            PG8_LDB(B1, 0, 1); PG8_STAGE(PG8_SB(0, 0), b2, voffB);
            PG8_BAR; PG8_WAIT_L(0); PG8_MMA(0, 1, At, B1); PG8_BAR;
            PG8_LDA(At, 0, 1); PG8_STAGE(PG8_SA(0, 0), a2, voffA);
            PG8_BAR; PG8_WAIT_L(0); PG8_MMA(1, 0, At, B0); PG8_BAR; PG8_SCHED;
            PG8_STAGE(PG8_SB(0, 1), b2 + hstep, voffB);
            PG8_WAIT_V(6); PG8_BAR; PG8_MMA(1, 1, At, B1); PG8_BAR;
            PG8_LDB(B0, 1, 0); PG8_SCHED; PG8_LDA(At, 1, 0); PG8_STAGE(PG8_SA(0, 1), a2 + hstepA, voffA);
            PG8_WAIT_L(8); PG8_BAR; PG8_WAIT_L(0); PG8_MMA(0, 0, At, B0); PG8_BAR; PG8_SCHED;
            PG8_LDB(B1, 1, 1); PG8_STAGE(PG8_SB(1, 0), b3, voffB);
            PG8_BAR; PG8_WAIT_L(0); PG8_MMA(0, 1, At, B1); PG8_BAR;
            PG8_LDA(At, 1, 1); PG8_STAGE(PG8_SA(1, 0), a3, voffA);
            PG8_BAR; PG8_WAIT_L(0); PG8_MMA(1, 0, At, B0); PG8_BAR; PG8_SCHED;
            PG8_STAGE(PG8_SB(1, 1), b3 + hstep, voffB);
            PG8_WAIT_V(6); PG8_BAR; PG8_MMA(1, 1, At, B1); PG8_BAR;
            }
        }
        if constexpr (ALIGN_EPI) { if (wr == 0) PG8_BAR; }
        if constexpr (!Epi::AFTER_DRAIN) { E(acc, cur, wr, wc, fr, fq); S.done(cur); }
        if (!has_next) break;
#pragma unroll
        for (int a = 0; a < 2; ++a)
#pragma unroll
            for (int b = 0; b < 2; ++b)
#pragma unroll
                for (int m = 0; m < 4; ++m)
#pragma unroll
                    for (int n = 0; n < 2; ++n) acc[a][b][m][n] = (f32x4){0.f, 0.f, 0.f, 0.f};
        cur = nxt; cA = nA; cB = nB; ++ui;
        if constexpr (ALIGN_EPI) { if (wr == 1) PG8_BAR; }
    }
    PG8_WAIT_V(0);
    if constexpr (!ALIGN_EPI) { if (wr == 0) PG8_BAR; }
    PG8_BAR;
    if constexpr (Epi::AFTER_DRAIN) { E.fused(acc, cur, wr, wc, fr, fq, lds, wid, lane); S.done(cur); }
#undef PG8_SA
#undef PG8_SB
#undef PG8_STAGE
#undef PG8_LDA
#undef PG8_LDB
#undef PG8_MMA
#undef PG8_WAIT_V
#undef PG8_WAIT_L
#undef PG8_BAR
#undef PG8_SCHED
}
}

#define LAS __attribute__((address_space(3)))
typedef unsigned short bf16_t;
typedef short bf16x8 __attribute__((ext_vector_type(8)));
typedef float f32x4 __attribute__((ext_vector_type(4)));
typedef float f32x16 __attribute__((ext_vector_type(16)));
typedef unsigned u32x4 __attribute__((ext_vector_type(4)));
typedef unsigned u32x2 __attribute__((ext_vector_type(2)));
typedef short v4i16_t __attribute__((ext_vector_type(4)));
typedef float f32x2_t __attribute__((ext_vector_type(2)));
typedef __bf16 bf16x2_t __attribute__((ext_vector_type(2)));

constexpr int D = 1024, FF = 2816, NMOD = 9, MODW = NMOD * D;
constexpr int GM = 32768;
constexpr int ZW = 1280;
constexpr int INW = 1184;
constexpr int NWAVES = 8, NT = 512;
constexpr float EPS = 1e-6f;
constexpr float LOG2E = 1.4426950408889634f;
constexpr float LOG2_THETA = 13.287712379549449f;

constexpr size_t MiB = 1u << 20;
constexpr size_t WS_MOD = 0;
constexpr size_t MOD_BYTES = 12 * MODW * 4;
constexpr size_t WS_BAR = 768 * 1024;
constexpr size_t CTL_ZERO_BYTES = 1 * MiB;
constexpr size_t WS_WGU1 = 1 * MiB;
constexpr size_t WS_WD1 = WS_WGU1 + (size_t)5632 * 1024 * 2;
constexpr size_t WS_WGU2 = WS_WD1 + (size_t)1024 * 2816 * 2;
constexpr size_t WS_WD2 = WS_WGU2 + (size_t)5632 * 1024 * 2;
constexpr size_t WS_WIN = WS_WD2 + (size_t)1024 * 2816 * 2;
constexpr size_t WS_WUQ = WS_WIN + (size_t)1280 * 1024 * 2;
constexpr size_t WS_WUKV = WS_WUQ + (size_t)768 * 256 * 2;
constexpr size_t WS_WOUT = WS_WUKV + (size_t)1024 * 256 * 2;
constexpr size_t WS_WEND = WS_WOUT + (size_t)1024 * 1024 * 2;
static_assert(WS_WEND <= 40 * MiB, "weights region");
constexpr size_t WS_H = 40 * MiB;
constexpr size_t WS_B = 104 * MiB;
constexpr size_t WS_ACT = WS_B;
constexpr size_t WS_Z = WS_B;
constexpr size_t WS_QB = WS_Z + (size_t)GM * ZW * 2;
constexpr size_t WS_KV = WS_QB + (size_t)GM * 768 * 2;
constexpr size_t WS_KB = WS_KV + (size_t)GM * 1024 * 2;
constexpr size_t WS_END = WS_KB + (size_t)GM * 768 * 2;
static_assert(WS_END <= 400 * MiB && WS_ACT + (size_t)GM * FF * 2 <= 400 * MiB, "ws map");

constexpr int LDS_BYTES = 131072 + 4096;

__device__ __forceinline__ unsigned f2bf(float f) { unsigned u = __builtin_bit_cast(unsigned, f); return (u + 0x7fffu + ((u >> 16) & 1u)) >> 16; }
__device__ __forceinline__ unsigned pk2(float lo, float hi) { f32x2_t v = {lo, hi}; bf16x2_t b = __builtin_convertvector(v, bf16x2_t); return __builtin_bit_cast(unsigned, b); }
__device__ __forceinline__ float bf2f(unsigned short b) { return __builtin_bit_cast(float, (unsigned)b << 16); }
__device__ __forceinline__ float bflo(unsigned w) { return __builtin_bit_cast(float, w << 16); }
__device__ __forceinline__ float bfhi(unsigned w) { return __builtin_bit_cast(float, w & 0xffff0000u); }
template <int M> __device__ __forceinline__ float swz_xor(float v) { return __builtin_bit_cast(float, __builtin_amdgcn_ds_swizzle(__builtin_bit_cast(int, v), (M << 10) | 0x1f)); }
__device__ __forceinline__ float half_sum(float v) { v += swz_xor<1>(v); v += swz_xor<2>(v); v += swz_xor<4>(v); v += swz_xor<8>(v); v += swz_xor<16>(v); return v; }
__device__ __forceinline__ void xhalf_pair(float v, float& lo, float& hi) { unsigned a = __builtin_bit_cast(unsigned, v), b = a;
    asm volatile("s_nop 1\n\tv_permlane32_swap_b32 %0, %1\n\ts_nop 1" : "+v"(a), "+v"(b)); lo = __builtin_bit_cast(float, a); hi = __builtin_bit_cast(float, b); }
__device__ __forceinline__ float xhalf_sum(float v) { float lo, hi; xhalf_pair(v, lo, hi); return lo + hi; }
__device__ __forceinline__ float xhalf_max(float v) { float lo, hi; xhalf_pair(v, lo, hi); return fmaxf(lo, hi); }
__device__ __forceinline__ float wave_sum(float v) { return xhalf_sum(half_sum(v)); }

namespace pg8 {
struct EpiPlain {
    static constexpr bool PERM = true, AFTER_DRAIN = false;
    bf16_t* O; int ldc;
    __device__ __forceinline__ void operator()(const f32x4 (&acc)[2][2][4][2], const Unit& u, int wr, int wc, int fr, int fq) const {
        const int row0 = u.pm * BM + wr * 64 + fr, col0 = u.pn * BM + wc * 32 + 8 * fq;
#pragma unroll
        for (int ai = 0; ai < 2; ++ai)
#pragma unroll
            for (int m = 0; m < 4; ++m) { bf16_t* rowp = O + (size_t)(row0 + ai * HALF + m * 16) * ldc + col0;
#pragma unroll
                for (int bj = 0; bj < 2; ++bj) { const f32x4 v0 = acc[ai][bj][m][0], v1 = acc[ai][bj][m][1];
                    u32x4 w; w.x = pk2(v0[0], v0[1]); w.y = pk2(v0[2], v0[3]); w.z = pk2(v1[0], v1[1]); w.w = pk2(v1[2], v1[3]);
                    *(u32x4*)(rowp + bj * HALF) = w; } }
    }
};
__device__ __forceinline__ float silu_mul(float g, float u) { return g * u * __builtin_amdgcn_rcpf(1.0f + __builtin_amdgcn_exp2f(-g * LOG2E)); }
struct EpiSwiGLU {
    static constexpr bool PERM = true, AFTER_DRAIN = false;
    bf16_t* O; int ldc;
    __device__ __forceinline__ void operator()(const f32x4 (&acc)[2][2][4][2], const Unit& u, int wr, int wc, int fr, int fq) const {
        const int row0 = u.pm * BM + wr * 64 + fr, col0 = u.pn * HALF + wc * 32 + 8 * fq;
#pragma unroll
        for (int ai = 0; ai < 2; ++ai)
#pragma unroll
            for (int m = 0; m < 4; ++m) { bf16_t* rowp = O + (size_t)(row0 + ai * HALF + m * 16) * ldc + col0;
                const f32x4 g0 = acc[ai][0][m][0], g1 = acc[ai][0][m][1], u0 = acc[ai][1][m][0], u1 = acc[ai][1][m][1];
                u32x4 w; w.x = pk2(silu_mul(g0[0], u0[0]), silu_mul(g0[1], u0[1])); w.y = pk2(silu_mul(g0[2], u0[2]), silu_mul(g0[3], u0[3]));
                w.z = pk2(silu_mul(g1[0], u1[0]), silu_mul(g1[1], u1[1])); w.w = pk2(silu_mul(g1[2], u1[2]), silu_mul(g1[3], u1[3]));
                *(u32x4*)rowp = w; }
    }
};
struct EpiResid {
    static constexpr bool PERM = false, AFTER_DRAIN = false;
    const float* base; float* out; const float* gate  ; int seq_shift  ; float scale;
    __device__ __forceinline__ void operator()(const f32x4 (&acc)[2][2][4][2], const Unit& u, int wr, int wc, int fr, int fq) const {
        const int row0 = u.pm * BM + wr * 64 + fr, col0 = u.pn * BM + wc * 32 + 4 * fq;
        const float* gp = gate + (size_t)((u.pm * BM) >> seq_shift) * MODW + col0;
#pragma unroll
        for (int bj = 0; bj < 2; ++bj)
#pragma unroll
            for (int n = 0; n < 2; ++n) { const f32x4 gv = *(const f32x4*)(gp + bj * HALF + n * 16) * scale;
#pragma unroll
                for (int ai = 0; ai < 2; ++ai)
#pragma unroll
                    for (int m = 0; m < 4; ++m) { const size_t off = (size_t)(row0 + ai * HALF + m * 16) * D + col0 + bj * HALF + n * 16;
                        const f32x4 b = *(const f32x4*)(base + off); *(f32x4*)(out + off) = b + gv * acc[ai][bj][m][n]; } }
    }
};
}

struct Args { const float* in[27]; float* out; unsigned char* ws; };

__device__ __forceinline__ void transpose_item(const float* W, int K, int N, bf16_t* WT, int mode, LAS float* scr, int item, int lane) {
    const int nblk = N / 32, kb = item / nblk, nb = item % nblk, k0 = 64 * kb, n0 = 32 * nb;
    int d0 = n0;
    if (mode == 1) d0 = (n0 >> 7) * 256 + (n0 & 127);
    else if (mode == 2) d0 = (n0 >> 7) * 256 + 128 + (n0 & 127);
#pragma unroll 8
    for (int i = 0; i < 32; ++i) { const int kk = 2 * i + (lane >> 5); scr[kk * 33 + (lane & 31)] = W[(size_t)(k0 + kk) * N + n0 + (lane & 31)]; }
    asm volatile("s_waitcnt lgkmcnt(0)" ::: "memory");
    const int c = lane & 7;
#pragma unroll
    for (int j = 0; j < 4; ++j) { const int n = (lane >> 3) + 8 * j; const LAS float* s = scr + (8 * c) * 33 + n;
        u32x4 o; o.x = pk2(s[0 * 33], s[1 * 33]); o.y = pk2(s[2 * 33], s[3 * 33]); o.z = pk2(s[4 * 33], s[5 * 33]); o.w = pk2(s[6 * 33], s[7 * 33]);
        *(u32x4*)(WT + (size_t)(d0 + n) * K + k0 + 8 * c) = o; }
    asm volatile("s_waitcnt lgkmcnt(0)" ::: "memory");
}

typedef const Args __attribute__((address_space(4)))* KArgs0;
__device__ __forceinline__ void phase0(KArgs0 ap, LAS unsigned char* lds, int tid, int wave, int lane) {
    unsigned char* ws = ap->ws;
    {
        LAS float* scr = (LAS float*)(lds + wave * 8704);
        const int gw = blockIdx.x * NWAVES + wave, NGW = gridDim.x * NWAVES;
        constexpr int I_G = (D / 64) * (FF / 32), I_D = (FF / 64) * (D / 32), I_IN = (D / 64) * (INW / 32), I_UQ = (256 / 64) * (768 / 32), I_UKV = (128 / 64) * (1024 / 32), I_OUT = (D / 64) * (D / 32);
        constexpr int NITEMS = 4 * I_G + 2 * I_D + I_IN + I_UQ + I_UKV + I_OUT;
        for (int it = gw; it < NITEMS; it += NGW) {
            int r = it;
            if (r < I_G) { transpose_item(ap->in[7], D, FF, (bf16_t*)(ws + WS_WGU1), 1, scr, r, lane); continue; } r -= I_G;
            if (r < I_G) { transpose_item(ap->in[8], D, FF, (bf16_t*)(ws + WS_WGU1), 2, scr, r, lane); continue; } r -= I_G;
            if (r < I_D) { transpose_item(ap->in[9], FF, D, (bf16_t*)(ws + WS_WD1), 0, scr, r, lane); continue; } r -= I_D;
            if (r < I_G) { transpose_item(ap->in[23], D, FF, (bf16_t*)(ws + WS_WGU2), 1, scr, r, lane); continue; } r -= I_G;
            if (r < I_G) { transpose_item(ap->in[24], D, FF, (bf16_t*)(ws + WS_WGU2), 2, scr, r, lane); continue; } r -= I_G;
            if (r < I_D) { transpose_item(ap->in[25], FF, D, (bf16_t*)(ws + WS_WD2), 0, scr, r, lane); continue; } r -= I_D;
            if (r < I_IN) { transpose_item(ap->in[11], D, INW, (bf16_t*)(ws + WS_WIN), 0, scr, r, lane); continue; } r -= I_IN;
            if (r < I_UQ) { transpose_item(ap->in[16], 256, 768, (bf16_t*)(ws + WS_WUQ), 0, scr, r, lane); continue; } r -= I_UQ;
            if (r < I_UKV) { transpose_item(ap->in[18], 256, 1024, (bf16_t*)(ws + WS_WUKV), 0, scr, r, lane); continue; } r -= I_UKV;
            transpose_item(ap->in[21], D, D, (bf16_t*)(ws + WS_WOUT), 0, scr, r, lane);
        }
        { for (int i = blockIdx.x * NT + tid; i < 1024 * 16; i += gridDim.x * NT) *(u32x4*)(ws + WS_WUKV + (size_t)(i >> 4) * 512 + 256 + (i & 15) * 16) = (u32x4){0u, 0u, 0u, 0u}; }
        { u32x4* p = (u32x4*)(ws + WS_WIN + (size_t)INW * D * 2); const int n16 = (ZW - INW) * D * 2 / 16;
          for (int i = blockIdx.x * NT + tid; i < n16; i += gridDim.x * NT) p[i] = (u32x4){0u, 0u, 0u, 0u}; }
    }
    __syncthreads();
    {
        LAS float* sc = (LAS float*)lds;
        float* mod = (float*)(ws + WS_MOD);
        const float* adaw = ap->in[4]; const float* adab = ap->in[5];
        for (int item = blockIdx.x; item < 18 * 16; item += gridDim.x) {
            const int cb = item % 18, kc = item / 18;
            __syncthreads();
            for (int i = tid; i < 12 * 64; i += NT) { const int s = i >> 6, kk = i & 63;
                const float c = (s < 4) ? ap->in[2][s * D + kc * 64 + kk] : ap->in[3][(s - 4) * D + kc * 64 + kk];
                sc[i] = c / (1.0f + __expf(-c)); }
            __syncthreads();
            const int col = cb * 512 + tid;
            float acc[12];
#pragma unroll
            for (int s = 0; s < 12; ++s) acc[s] = 0.f;
            const float* wp = adaw + (size_t)(kc * 64) * MODW + col;
#pragma unroll 8
            for (int kk = 0; kk < 64; ++kk) { const float w = wp[(size_t)kk * MODW];
#pragma unroll
                for (int s = 0; s < 12; ++s) acc[s] += sc[s * 64 + kk] * w; }
            const float b = (kc == 0) ? adab[col] : 0.f;
#pragma unroll
            for (int s = 0; s < 12; ++s) atomicAdd(mod + s * MODW + col, acc[s] + b);
        }
    }
}

__device__ __forceinline__ void norm_mod_phase(const float* x, const float* gain, const float* mod  , int shoff, int seq_shift, bf16_t* H, int wave, int lane) {
    const int gw = blockIdx.x * NWAVES + wave, NGW = gridDim.x * NWAVES;
    f32x4 gv[4];
#pragma unroll
    for (int j = 0; j < 4; ++j) gv[j] = *(const f32x4*)(gain + 256 * j + 4 * lane);
    for (int m = gw; m < GM; m += NGW) {
        const f32x4* xr = (const f32x4*)(x + (size_t)m * D) + lane;
        f32x4 v[4]; float s = 0.f;
#pragma unroll
        for (int j = 0; j < 4; ++j) { v[j] = xr[64 * j]; s += (v[j].x * v[j].x + v[j].y * v[j].y) + (v[j].z * v[j].z + v[j].w * v[j].w); }
        const float rstd = 1.0f / sqrtf(wave_sum(s) * (1.0f / D) + EPS);
        const float* mp = mod + (size_t)(m >> seq_shift) * MODW + shoff;
        u32x2* o8 = (u32x2*)(H + (size_t)m * D) + lane;
#pragma unroll
        for (int j = 0; j < 4; ++j) { const f32x4 sh = *(const f32x4*)(mp + 256 * j + 4 * lane), sc = *(const f32x4*)(mp + D + 256 * j + 4 * lane);
            const f32x4 y = v[j] * rstd * gv[j] * (sc + 1.0f) + sh; u32x2 w; w.x = pk2(y.x, y.y); w.y = pk2(y.z, y.w); o8[64 * j] = w; }
    }
}
__device__ __forceinline__ void final_norm_phase(float* x, const float* gain, int wave, int lane) {
    const int gw = blockIdx.x * NWAVES + wave, NGW = gridDim.x * NWAVES;
    f32x4 gv[4];
#pragma unroll
    for (int j = 0; j < 4; ++j) gv[j] = *(const f32x4*)(gain + 256 * j + 4 * lane);
    for (int m = gw; m < GM; m += NGW) {
        f32x4* xr = (f32x4*)(x + (size_t)m * D) + lane;
        f32x4 v[4]; float s = 0.f;
#pragma unroll
        for (int j = 0; j < 4; ++j) { v[j] = xr[64 * j]; s += (v[j].x * v[j].x + v[j].y * v[j].y) + (v[j].z * v[j].z + v[j].w * v[j].w); }
        const float rstd = 1.0f / sqrtf(wave_sum(s) * (1.0f / D) + EPS);
#pragma unroll
        for (int j = 0; j < 4; ++j) xr[64 * j] = v[j] * rstd * gv[j];
    }
}

__device__ __forceinline__ float oct_sum(float v) { v += swz_xor<1>(v); v += swz_xor<2>(v); v += swz_xor<4>(v); return v; }

__device__ __forceinline__ void post1_phase(bf16_t* Z, int Smask, const float* gq, const float* gk, const float* gcq, const float* gckv, int wave, int lane) {
    const int gw = blockIdx.x * NWAVES + wave, NGW = gridDim.x * NWAVES;
    const int sub = lane & 7, hq = lane >> 3;
    float invf[4], gq0[4], gq1[4], gk0[4], gk1[4];
#pragma unroll
    for (int e = 0; e < 4; ++e) { const int i = 4 * sub + e; invf[e] = exp2f(-(float)i * (LOG2_THETA / 32.0f)); gq0[e] = gq[i]; gq1[e] = gq[i + 32]; gk0[e] = gk[i]; gk1[e] = gk[i + 32]; }
    const float gc0 = gcq[4 * lane], gc1 = gcq[4 * lane + 1], gc2 = gcq[4 * lane + 2], gc3 = gcq[4 * lane + 3];
    const float gv0 = gckv[2 * lane], gv1 = gckv[2 * lane + 1];
    const bool kact = lane < 16;
    for (int m = gw; m < GM; m += NGW) {
        bf16_t* z = Z + (size_t)m * ZW;
        u32x2* pq0 = (u32x2*)(z + hq * 64 + 4 * sub); u32x2* pq1 = (u32x2*)(z + hq * 64 + 32 + 4 * sub);
        u32x2* pk0 = (u32x2*)(z + 512 + (hq & 1) * 64 + 4 * sub); u32x2* pk1 = (u32x2*)(z + 512 + (hq & 1) * 64 + 32 + 4 * sub);
        u32x2* pc = (u32x2*)(z + 768) + lane; unsigned* pv = (unsigned*)(z + 1024) + lane;
        const u32x2 wq0 = *pq0, wq1 = *pq1, wk0 = *pk0, wk1 = *pk1, wc = *pc; const unsigned wv = *pv;
        const float pos = (float)(m & Smask);
        float sn[4], cs[4];
#pragma unroll
        for (int e = 0; e < 4; ++e) sincosf(pos * invf[e], &sn[e], &cs[e]);
        {
            const float a[4] = {bflo(wq0.x), bfhi(wq0.x), bflo(wq0.y), bfhi(wq0.y)}, b[4] = {bflo(wq1.x), bfhi(wq1.x), bflo(wq1.y), bfhi(wq1.y)};
            float ss = 0.f;
#pragma unroll
            for (int e = 0; e < 4; ++e) ss += a[e] * a[e] + b[e] * b[e];
            const float rstd = 1.0f / sqrtf(oct_sum(ss) * (1.0f / 64.0f) + EPS) * (0.125f * LOG2E);
            float o0[4], o1[4];
#pragma unroll
            for (int e = 0; e < 4; ++e) { const float y1 = a[e] * rstd * gq0[e], y2 = b[e] * rstd * gq1[e]; o0[e] = y1 * cs[e] - y2 * sn[e]; o1[e] = y2 * cs[e] + y1 * sn[e]; }
            u32x2 w; w.x = pk2(o0[0], o0[1]); w.y = pk2(o0[2], o0[3]); *pq0 = w; w.x = pk2(o1[0], o1[1]); w.y = pk2(o1[2], o1[3]); *pq1 = w;
        }
        {
            const float a[4] = {bflo(wk0.x), bfhi(wk0.x), bflo(wk0.y), bfhi(wk0.y)}, b[4] = {bflo(wk1.x), bfhi(wk1.x), bflo(wk1.y), bfhi(wk1.y)};
            float ss = 0.f;
#pragma unroll
            for (int e = 0; e < 4; ++e) ss += a[e] * a[e] + b[e] * b[e];
            const float rstd = 1.0f / sqrtf(oct_sum(ss) * (1.0f / 64.0f) + EPS);
            float o0[4], o1[4];
#pragma unroll
            for (int e = 0; e < 4; ++e) { const float y1 = a[e] * rstd * gk0[e], y2 = b[e] * rstd * gk1[e]; o0[e] = y1 * cs[e] - y2 * sn[e]; o1[e] = y2 * cs[e] + y1 * sn[e]; }
            if (kact) { u32x2 w; w.x = pk2(o0[0], o0[1]); w.y = pk2(o0[2], o0[3]); *pk0 = w; w.x = pk2(o1[0], o1[1]); w.y = pk2(o1[2], o1[3]); *pk1 = w; }
        }
        {
            const float a0 = bflo(wc.x), a1 = bfhi(wc.x), a2 = bflo(wc.y), a3 = bfhi(wc.y);
            const float rstd = 1.0f / sqrtf(wave_sum((a0 * a0 + a1 * a1) + (a2 * a2 + a3 * a3)) * (1.0f / 256.0f) + EPS);
            u32x2 o; o.x = pk2(a0 * rstd * gc0, a1 * rstd * gc1); o.y = pk2(a2 * rstd * gc2, a3 * rstd * gc3); *pc = o;
        }
        {
            const float a0 = bflo(wv), a1 = bfhi(wv);
            const float rstd = 1.0f / sqrtf(wave_sum(a0 * a0 + a1 * a1) * (1.0f / 128.0f) + EPS);
            *pv = pk2(a0 * rstd * gv0, a1 * rstd * gv1);
        }
    }
}

__device__ __forceinline__ void post2_phase(bf16_t* QB, const bf16_t* KV, const bf16_t* Z, bf16_t* KB, int Smask, const float* gq, const float* gk, int wave, int lane) {
    const int gw = blockIdx.x * NWAVES + wave, NGW = gridDim.x * NWAVES;
    const int sub = lane & 7, h = lane >> 3;
    float gqn[8], gkn[8], gqr[4], gkr[4], invf[2];
#pragma unroll
    for (int e = 0; e < 8; ++e) { gqn[e] = gq[8 * sub + e]; gkn[e] = gk[8 * sub + e]; }
#pragma unroll
    for (int e = 0; e < 2; ++e) { const int i = 2 * sub + e; invf[e] = exp2f(-(float)i * (LOG2_THETA / 16.0f)); gqr[e] = gq[64 + i]; gqr[2 + e] = gq[80 + i]; gkr[e] = gk[64 + i]; gkr[2 + e] = gk[80 + i]; }
    const float qscl = 0.10206207261596577f * LOG2E;
    for (int m = gw; m < GM; m += NGW) {
        bf16_t* q = QB + (size_t)m * 768 + h * 96; const bf16_t* kv = KV + (size_t)m * 1024 + h * 128; bf16_t* kb = KB + (size_t)m * 768 + h * 96;
        const bf16_t* kr = Z + (size_t)m * ZW + 1152;
        const u32x4 wq = *(const u32x4*)(q + 8 * sub); const unsigned wqa = *(const unsigned*)(q + 64 + 2 * sub), wqb = *(const unsigned*)(q + 80 + 2 * sub);
        const u32x4 wk = *(const u32x4*)(kv + 8 * sub); const unsigned wka = *(const unsigned*)(kr + 2 * sub), wkb = *(const unsigned*)(kr + 16 + 2 * sub);
        const float pos = (float)(m & Smask);
        float sn[2], cs[2];
#pragma unroll
        for (int e = 0; e < 2; ++e) sincosf(pos * invf[e], &sn[e], &cs[e]);
        {
            const float n[8] = {bflo(wq.x), bfhi(wq.x), bflo(wq.y), bfhi(wq.y), bflo(wq.z), bfhi(wq.z), bflo(wq.w), bfhi(wq.w)};
            const float r0[2] = {bflo(wqa), bfhi(wqa)}, r1[2] = {bflo(wqb), bfhi(wqb)};
            float ss = r0[0] * r0[0] + r0[1] * r0[1] + r1[0] * r1[0] + r1[1] * r1[1];
#pragma unroll
            for (int e = 0; e < 8; ++e) ss += n[e] * n[e];
            const float rstd = 1.0f / sqrtf(oct_sum(ss) * (1.0f / 96.0f) + EPS) * qscl;
            u32x4 o; o.x = pk2(n[0] * rstd * gqn[0], n[1] * rstd * gqn[1]); o.y = pk2(n[2] * rstd * gqn[2], n[3] * rstd * gqn[3]);
            o.z = pk2(n[4] * rstd * gqn[4], n[5] * rstd * gqn[5]); o.w = pk2(n[6] * rstd * gqn[6], n[7] * rstd * gqn[7]);
            float a[2], b[2];
#pragma unroll
            for (int e = 0; e < 2; ++e) { const float y0 = r0[e] * rstd * gqr[e], y1 = r1[e] * rstd * gqr[2 + e]; a[e] = y0 * cs[e] - y1 * sn[e]; b[e] = y1 * cs[e] + y0 * sn[e]; }
            *(u32x4*)(q + 8 * sub) = o; *(unsigned*)(q + 64 + 2 * sub) = pk2(a[0], a[1]); *(unsigned*)(q + 80 + 2 * sub) = pk2(b[0], b[1]);
        }
        {
            const float n[8] = {bflo(wk.x), bfhi(wk.x), bflo(wk.y), bfhi(wk.y), bflo(wk.z), bfhi(wk.z), bflo(wk.w), bfhi(wk.w)};
            const float r0[2] = {bflo(wka), bfhi(wka)}, r1[2] = {bflo(wkb), bfhi(wkb)};
            float ss = r0[0] * r0[0] + r0[1] * r0[1] + r1[0] * r1[0] + r1[1] * r1[1];
#pragma unroll
            for (int e = 0; e < 8; ++e) ss += n[e] * n[e];
            const float rstd = 1.0f / sqrtf(oct_sum(ss) * (1.0f / 96.0f) + EPS);
            u32x4 o; o.x = pk2(n[0] * rstd * gkn[0], n[1] * rstd * gkn[1]); o.y = pk2(n[2] * rstd * gkn[2], n[3] * rstd * gkn[3]);
            o.z = pk2(n[4] * rstd * gkn[4], n[5] * rstd * gkn[5]); o.w = pk2(n[6] * rstd * gkn[6], n[7] * rstd * gkn[7]);
            float a[2], b[2];
#pragma unroll
            for (int e = 0; e < 2; ++e) { const float y0 = r0[e] * rstd * gkr[e], y1 = r1[e] * rstd * gkr[2 + e]; a[e] = y0 * cs[e] - y1 * sn[e]; b[e] = y1 * cs[e] + y0 * sn[e]; }
            *(u32x4*)(kb + 8 * sub) = o; *(unsigned*)(kb + 64 + 2 * sub) = pk2(a[0], a[1]); *(unsigned*)(kb + 80 + 2 * sub) = pk2(b[0], b[1]);
        }
    }
}

#define XB_TMO      128
#define XB_XCNT(j)  (256  + 64 * (j))
#define XB_XSUB(j)  (1280 + 64 * (j))
#define XB_XGEN(j)  (2304 + 64 * (j))
#define XB_TOP      3328
#define XB_TOPGEN   3392
#define XCD_BAR_WORDS 3456
#define XB_SPIN_CAP (1u << 22)

__device__ __forceinline__ unsigned xb_ld(unsigned* p)              { return __hip_atomic_load(p, __ATOMIC_RELAXED, __HIP_MEMORY_SCOPE_AGENT); }
__device__ __forceinline__ unsigned xb_add(unsigned* p, unsigned v) { return __hip_atomic_fetch_add(p, v, __ATOMIC_RELAXED, __HIP_MEMORY_SCOPE_AGENT); }
__device__ __forceinline__ unsigned xb_xcc_id() { return (unsigned)__builtin_amdgcn_s_getreg((3 << 11) | 20) & 0xFu; }
#define XB_SPIN(cond, bar) do { unsigned _sp = 0; while (cond) { __builtin_amdgcn_s_sleep(1); \
    if ((++_sp & 255u) == 0u) { if (xb_ld(&(bar)[XB_TMO])) break; if (_sp > XB_SPIN_CAP) { atomicAdd(&(bar)[XB_TMO], 1u); break; } } } } while (0)

struct XcdBarrier {
    unsigned* bar; unsigned x;
    volatile LAS unsigned* st;
};

__device__ __forceinline__ XcdBarrier xcd_barrier_post(unsigned* bar, volatile LAS unsigned* st, bool leader) {
    XcdBarrier b; b.bar = bar; b.x = xb_xcc_id(); b.st = st;
    if (leader) (void)xb_add(&bar[XB_XCNT(b.x)], 1u);
    return b;
}
__device__ __forceinline__ void xcd_barrier_complete(unsigned* bar, unsigned x, unsigned& nloc, unsigned& nx) {
    const unsigned G = gridDim.x * gridDim.y * gridDim.z;
    unsigned sum, cnt, mine, sp = 0u;
    for (;;) {
        sum = 0u; cnt = 0u; mine = 0u;
#pragma unroll
        for (unsigned j = 0; j < 16; ++j) { const unsigned c = xb_ld(&bar[XB_XCNT(j)]); sum += c; cnt += (c > 0u) ? 1u : 0u; mine = (j == x) ? c : mine; }
        if (sum == G) break;
        __builtin_amdgcn_s_sleep(1);
        if ((++sp & 255u) == 0u) { if (xb_ld(&bar[XB_TMO])) break; if (sp > XB_SPIN_CAP) { atomicAdd(&bar[XB_TMO], 1u); break; } }
    }
    nloc = mine > 0u ? mine : 1u; nx = cnt > 0u ? cnt : 1u;
}

__device__ __forceinline__ void xcd_barrier(const XcdBarrier& b, bool leader) {
    asm volatile("s_waitcnt vmcnt(0)" ::: "memory");
    __syncthreads();
    if (leader) {
        unsigned* bar = b.bar;
        __builtin_amdgcn_s_waitcnt(0);
        unsigned nloc = b.st[0], nx = b.st[1];
        if (nloc == 0u) { xcd_barrier_complete(bar, b.x, nloc, nx); b.st[0] = nloc; b.st[1] = nx; }
        const unsigned old = xb_add(&bar[XB_XSUB(b.x)], 1u);
        const unsigned gen = old / nloc;
        if (old + 1u == (gen + 1u) * nloc) {
            __builtin_amdgcn_fence(__ATOMIC_RELEASE, "agent");
            asm volatile("s_waitcnt vmcnt(0)" ::: "memory");
            const unsigned og = xb_add(&bar[XB_TOP], 1u);
            const unsigned tg = og / nx;
            if (og + 1u == (tg + 1u) * nx) xb_add(&bar[XB_TOPGEN], 1u);
            else XB_SPIN(xb_ld(&bar[XB_TOPGEN]) == tg, bar);
            __builtin_amdgcn_fence(__ATOMIC_ACQUIRE, "agent");
            xb_add(&bar[XB_XGEN(b.x)], 1u);
            asm volatile("s_waitcnt vmcnt(0)" ::: "memory");
        } else {
            XB_SPIN(xb_ld(&bar[XB_XGEN(b.x)]) == gen, bar);
            __builtin_amdgcn_fence(__ATOMIC_ACQUIRE, "agent");
            asm volatile("s_waitcnt vmcnt(0)" ::: "memory");
        }
    }
    __syncthreads();
}

__device__ __forceinline__ int crow(int r, int hi) { return (r & 3) + 8 * (r >> 2) + 4 * hi; }
#define MFMA32(a, b, c) __builtin_amdgcn_mfma_f32_32x32x16_bf16((a), (b), (c), 0, 0, 0)
constexpr int ATT_VP = 192;
template <int DQ> struct AttnCfg { static constexpr int KP = DQ * 2 + 16, KBUF = 64 * KP, VBUF = 64 * ATT_VP, CPR = DQ / 8, NKCH = 64 * CPR; };

template <int DQ, bool SWA>
__device__ __forceinline__ void attn_unit(const bf16_t* Qp, int ldq, const bf16_t* Kp, int ldk, const bf16_t* Vp, int ldv, bf16_t* Op, int ldo,
                                          int S, int q0, float sink_l2, LAS unsigned char* lds, int tid, int wave, int lane) {
    typedef AttnCfg<DQ> C;
    constexpr int NKS = DQ / 16;
    LAS unsigned char* Kb = lds;
    LAS unsigned char* Vb = lds + 2 * C::KBUF;
    LAS float* scr = (LAS float*)(lds + 2 * C::KBUF + 2 * C::VBUF) + wave * 64;
    const int r = lane & 31, h = lane >> 5;
    const int qw = q0 + wave * 32;
    bf16x8 qf[NKS];
#pragma unroll
    for (int ks = 0; ks < NKS; ++ks) qf[ks] = *(const bf16x8*)(Qp + (size_t)(qw + r) * ldq + 16 * ks + 8 * h);
    int t_lo = 0, t_hi = S / 64;
    if (SWA) { const int lo = q0 - 128 < 0 ? 0 : q0 - 128, hi = q0 + 384 > S ? S : q0 + 384; t_lo = lo / 64; t_hi = hi / 64; }
    const int vrow = tid >> 3, vch = tid & 7;
    const int k0row = tid / C::CPR, k0ch = tid % C::CPR;
    const int k1idx = tid + 512; const bool k1on = k1idx < C::NKCH; const int k1row = k1idx / C::CPR, k1ch = k1idx % C::CPR;
    u32x4 rv, rk0, rk1 = (u32x4){0u, 0u, 0u, 0u};
#define ATT_GLOAD(t) do { const size_t kb_ = (size_t)(t) * 64; \
        rv = *(const u32x4*)(Vp + (kb_ + vrow) * ldv + vch * 8); \
        rk0 = *(const u32x4*)(Kp + (kb_ + k0row) * ldk + k0ch * 8); \
        if (k1on) rk1 = *(const u32x4*)(Kp + (kb_ + k1row) * ldk + k1ch * 8); } while (0)
#define ATT_LSTORE(b) do { *(LAS u32x4*)(Vb + (b) * C::VBUF + vrow * ATT_VP + vch * 16) = rv; \
        *(LAS u32x4*)(Kb + (b) * C::KBUF + k0row * C::KP + k0ch * 16) = rk0; \
        if (k1on) *(LAS u32x4*)(Kb + (b) * C::KBUF + k1row * C::KP + k1ch * 16) = rk1; } while (0)
    float mref = SWA ? sink_l2 : -1e30f;
    float lsum = (SWA && h == 0) ? 1.0f : 0.0f;
    f32x16 o0, o1;
#pragma unroll
    for (int i = 0; i < 16; ++i) { o0[i] = 0.f; o1[i] = 0.f; }
    const int koff = r * C::KP + 16 * h;
    const int voff = (4 * h + ((lane & 15) >> 2)) * ATT_VP + ((lane >> 4) & 1) * 32 + (lane & 3) * 8;
    ATT_GLOAD(t_lo); ATT_LSTORE(0);
    __syncthreads();
    for (int t = t_lo; t < t_hi; ++t) {
        const int cur = (t - t_lo) & 1;
        const bool more = (t + 1 < t_hi);
        if (more) ATT_GLOAD(t + 1);
        bool need = true;
        if (SWA) need = (64 * t + 63 >= qw - 128) && (64 * t <= qw + 31 + 128);
        if (need) {
            const LAS unsigned char* kb = Kb + cur * C::KBUF + koff;
            f32x16 p0, p1;
#pragma unroll
            for (int i = 0; i < 16; ++i) { p0[i] = 0.f; p1[i] = 0.f; }
#pragma unroll
            for (int ks = 0; ks < NKS; ++ks) {
                const bf16x8 a0 = *(const LAS bf16x8*)(kb + ks * 32);
                const bf16x8 a1 = *(const LAS bf16x8*)(kb + 32 * C::KP + ks * 32);
                p0 = MFMA32(a0, qf[ks], p0);
                p1 = MFMA32(a1, qf[ks], p1);
            }
            if (SWA) {
                const int qpos = qw + r, kb0 = 64 * t + 4 * h;
#pragma unroll
                for (int i = 0; i < 16; ++i) { const int kp = kb0 + (i & 3) + 8 * (i >> 2); const int d0_ = kp - qpos, d1_ = d0_ + 32;
                    if (d0_ > 128 || d0_ < -128) p0[i] = -1e30f; if (d1_ > 128 || d1_ < -128) p1[i] = -1e30f; }
            }
            float mx = fmaxf(p0[0], p1[0]);
#pragma unroll
            for (int i = 1; i < 16; ++i) mx = fmaxf(mx, fmaxf(p0[i], p1[i]));
            mx = xhalf_max(mx);
            if (__any(mx > mref + 8.0f)) {
                const float mnew = fmaxf(mref, mx), alpha = __builtin_amdgcn_exp2f(mref - mnew);
                mref = mnew; lsum *= alpha;
                if (h == 0) scr[r] = alpha;
                asm volatile("s_waitcnt lgkmcnt(0)" ::: "memory");
#pragma unroll
                for (int g = 0; g < 4; ++g) { const f32x4 av = *(const LAS f32x4*)(scr + 8 * g + 4 * h);
#pragma unroll
                    for (int j = 0; j < 4; ++j) { o0[4 * g + j] *= av[j]; o1[4 * g + j] *= av[j]; } }
                asm volatile("s_waitcnt lgkmcnt(0)" ::: "memory");
            }
            float ps = 0.f;
#pragma unroll
            for (int i = 0; i < 16; ++i) { p0[i] = __builtin_amdgcn_exp2f(p0[i] - mref); p1[i] = __builtin_amdgcn_exp2f(p1[i] - mref); ps += p0[i] + p1[i]; }
            lsum += ps;
            bf16x8 pf[4];
#pragma unroll
            for (int s2 = 0; s2 < 2; ++s2) {
                u32x4 w0, w1;
                w0.x = pk2(p0[8 * s2 + 0], p0[8 * s2 + 1]); w0.y = pk2(p0[8 * s2 + 2], p0[8 * s2 + 3]); w0.z = pk2(p0[8 * s2 + 4], p0[8 * s2 + 5]); w0.w = pk2(p0[8 * s2 + 6], p0[8 * s2 + 7]);
                w1.x = pk2(p1[8 * s2 + 0], p1[8 * s2 + 1]); w1.y = pk2(p1[8 * s2 + 2], p1[8 * s2 + 3]); w1.z = pk2(p1[8 * s2 + 4], p1[8 * s2 + 5]); w1.w = pk2(p1[8 * s2 + 6], p1[8 * s2 + 7]);
                pf[s2] = __builtin_bit_cast(bf16x8, w0); pf[2 + s2] = __builtin_bit_cast(bf16x8, w1);
            }
            const LAS unsigned char* vb = Vb + cur * C::VBUF + voff;
#pragma unroll
            for (int s = 0; s < 4; ++s) {
                const v4i16_t l0 = __builtin_amdgcn_ds_read_tr16_b64_v4i16((LAS v4i16_t*)(vb + (16 * s) * ATT_VP));
                const v4i16_t h0 = __builtin_amdgcn_ds_read_tr16_b64_v4i16((LAS v4i16_t*)(vb + (16 * s + 8) * ATT_VP));
                const v4i16_t l1 = __builtin_amdgcn_ds_read_tr16_b64_v4i16((LAS v4i16_t*)(vb + (16 * s) * ATT_VP + 64));
                const v4i16_t h1 = __builtin_amdgcn_ds_read_tr16_b64_v4i16((LAS v4i16_t*)(vb + (16 * s + 8) * ATT_VP + 64));
                const bf16x8 v0 = (bf16x8){l0[0], l0[1], l0[2], l0[3], h0[0], h0[1], h0[2], h0[3]};
                const bf16x8 v1 = (bf16x8){l1[0], l1[1], l1[2], l1[3], h1[0], h1[1], h1[2], h1[3]};
                o0 = MFMA32(pf[s], v0, o0);
                o1 = MFMA32(pf[s], v1, o1);
            }
        }
        if (more) ATT_LSTORE(cur ^ 1);
        __syncthreads();
    }
    lsum = xhalf_sum(lsum);
    if (h == 0) scr[r] = 1.0f / lsum;
    asm volatile("s_waitcnt lgkmcnt(0)" ::: "memory");
#pragma unroll
    for (int g = 0; g < 4; ++g) { const f32x4 av = *(const LAS f32x4*)(scr + 8 * g + 4 * h);
#pragma unroll
        for (int j = 0; j < 4; ++j) { const int q = qw + 8 * g + 4 * h + j; bf16_t* op = Op + (size_t)q * ldo + r;
            op[0] = (bf16_t)f2bf(o0[4 * g + j] * av[j]); op[32] = (bf16_t)f2bf(o1[4 * g + j] * av[j]); } }
    asm volatile("s_waitcnt lgkmcnt(0)" ::: "memory");
#undef ATT_GLOAD
#undef ATT_LSTORE
}

template <class Epi>
__device__ __forceinline__ void run_gemm(LAS unsigned char* lds, const bf16_t* A, int lda, const bf16_t* Bt, int N, int K, const Epi& E, int tid) {
    int bx = (int)blockIdx.x; asm volatile("" : "+s"(bx), "+s"(A), "+s"(Bt));
    pg8::Gemm g{A, Bt, GM, N, K, lda}; pg8::StaticOrder S; S.init(GM, N, (int)gridDim.x, bx);
    pg8::gemm_phase<Epi, pg8::StaticOrder, true, true>(lds, g, S, E, tid);
}

typedef const Args __attribute__((address_space(4)))* KArgs;
#define PHASE_BEGIN() KArgs ap = (KArgs)__builtin_amdgcn_kernarg_segment_ptr(); asm volatile("" : "+s"(ap)); \
    unsigned char* ws = ap->ws; (void)ws; \
    int lane; asm volatile("v_mbcnt_lo_u32_b32 %0, -1, 0\n\tv_mbcnt_hi_u32_b32 %0, -1, %0" : "=v"(lane)); const int wave = wave_s, tid = wave_s * 64 + lane; (void)tid; \
    const float* xin = ap->in[g]; (void)xin; float* out = ap->out + (size_t)g * GM * D; (void)out; \
    const float* mod = (const float*)(ws + WS_MOD) + (size_t)(g ? 4 : 0) * MODW; (void)mod; \
    const int S = g ? 4096 : 8192, seq_shift = g ? 12 : 13, nseq = g ? 8 : 4; (void)S; (void)seq_shift; (void)nseq
#define WSP(off) ((bf16_t*)(ws + (off)))

__global__ void __launch_bounds__(NT, 2) fwd_kernel(Args a) {
    extern __shared__ __attribute__((aligned(16))) unsigned char lds_raw[];
    cg::grid_group grid = cg::this_grid();
    LAS unsigned char* lds = (LAS unsigned char*)lds_raw;
    const int wave_s = __builtin_amdgcn_readfirstlane((int)threadIdx.x >> 6);
    volatile LAS unsigned* bar_st = (volatile LAS unsigned*)(lds + 131072);
    if (threadIdx.x < 2) bar_st[threadIdx.x] = 0u;
    __syncthreads();
    { const int g = 0; PHASE_BEGIN(); (void)xcd_barrier_post((unsigned*)(ws + WS_BAR), bar_st, tid == 0); phase0(ap, lds, tid, wave, lane); }
    grid.sync();
#define SEAM() do { const int g = 0; PHASE_BEGIN(); XcdBarrier b_; b_.bar = (unsigned*)(ws + WS_BAR); b_.x = xb_xcc_id(); b_.st = bar_st; xcd_barrier(b_, tid == 0); } while (0)

    for (int g = 0; g < 2; ++g) {
        { PHASE_BEGIN(); norm_mod_phase(xin, ap->in[6], mod, 0, seq_shift, WSP(WS_H), wave, lane); }
        SEAM();
        { PHASE_BEGIN(); run_gemm(lds, WSP(WS_H), D, WSP(WS_WGU1), 2 * FF, D, pg8::EpiSwiGLU{WSP(WS_ACT), FF}, tid); }
        SEAM();
        { PHASE_BEGIN(); run_gemm(lds, WSP(WS_ACT), FF, WSP(WS_WD1), D, FF, pg8::EpiResid{xin, out, mod + 2 * D, seq_shift, 0.5f}, tid); }
        SEAM();
        { PHASE_BEGIN(); norm_mod_phase(out, ap->in[10], mod, 3 * D, seq_shift, WSP(WS_H), wave, lane); }
        SEAM();
        { PHASE_BEGIN(); run_gemm(lds, WSP(WS_H), D, WSP(WS_WIN), ZW, D, pg8::EpiPlain{WSP(WS_Z), ZW}, tid); }
        SEAM();
        { PHASE_BEGIN(); post1_phase(WSP(WS_Z), S - 1, ap->in[12], ap->in[13], ap->in[15], ap->in[17], wave, lane); }
        SEAM();
        { PHASE_BEGIN(); run_gemm(lds, WSP(WS_Z) + 768, ZW, WSP(WS_WUQ), 768, 256, pg8::EpiPlain{WSP(WS_QB), 768}, tid); }
        { PHASE_BEGIN(); run_gemm(lds, WSP(WS_Z) + 1024, ZW, WSP(WS_WUKV), 1024, 256, pg8::EpiPlain{WSP(WS_KV), 1024}, tid); }
        SEAM();
        { PHASE_BEGIN(); post2_phase(WSP(WS_QB), WSP(WS_KV), WSP(WS_Z), WSP(WS_KB), S - 1, ap->in[19], ap->in[20], wave, lane); }
        SEAM();
        {
            PHASE_BEGIN();
            bf16_t* H = WSP(WS_H); bf16_t* Z = WSP(WS_Z); bf16_t* QB = WSP(WS_QB); bf16_t* KV = WSP(WS_KV); bf16_t* KB = WSP(WS_KB);
            const int nqb = S / 256, nunits = nseq * 8 * nqb;
            const int G = (int)gridDim.x, bx = (int)blockIdx.x;
            const int vcu = (G % 8 == 0) ? (bx % 8) * (G / 8) + bx / 8 : bx;
            for (int u = vcu; u < 2 * nunits; u += G) {
                const bool dense = u < nunits; const int uu = dense ? u : u - nunits;
                const int qb = uu % nqb, hd = (uu / nqb) & 7, s = uu / (nqb * 8);
                const size_t r0 = (size_t)s * S;
                if (dense)
                    attn_unit<96, false>(QB + r0 * 768 + hd * 96, 768, KB + r0 * 768 + hd * 96, 768, KV + r0 * 1024 + hd * 128 + 64, 1024,
                                         H + r0 * 1024 + 512 + hd * 64, 1024, S, qb * 256, 0.f, lds, tid, wave, lane);
                else
                    attn_unit<64, true>(Z + r0 * ZW + hd * 64, ZW, Z + r0 * ZW + 512 + (hd >> 2) * 64, ZW, Z + r0 * ZW + 640 + (hd >> 2) * 64, ZW,
                                        H + r0 * 1024 + hd * 64, 1024, S, qb * 256, ap->in[14][hd] * LOG2E, lds, tid, wave, lane);
            }
        }
        SEAM();
        { PHASE_BEGIN(); run_gemm(lds, WSP(WS_H), D, WSP(WS_WOUT), D, D, pg8::EpiResid{out, out, mod + 5 * D, seq_shift, 1.0f}, tid); }
        SEAM();
        { PHASE_BEGIN(); norm_mod_phase(out, ap->in[22], mod, 6 * D, seq_shift, WSP(WS_H), wave, lane); }
        SEAM();
        { PHASE_BEGIN(); run_gemm(lds, WSP(WS_H), D, WSP(WS_WGU2), 2 * FF, D, pg8::EpiSwiGLU{WSP(WS_ACT), FF}, tid); }
        SEAM();
        { PHASE_BEGIN(); run_gemm(lds, WSP(WS_ACT), FF, WSP(WS_WD2), D, FF, pg8::EpiResid{out, out, mod + 8 * D, seq_shift, 0.5f}, tid); }
        SEAM();
        { PHASE_BEGIN(); final_norm_phase(out, ap->in[26], wave, lane); }
    }
}

extern "C" void kernel_launch(void* const* d_in, const int* in_sizes, int n_in, void* d_out, int out_size, void* d_ws, size_t ws_size, hipStream_t stream) {
    static int grid = 0;
    if (grid == 0) {
        int dev = 0, cus = 0, per_cu = 0;
        hipGetDevice(&dev);
        hipDeviceGetAttribute(&cus, hipDeviceAttributeMultiprocessorCount, dev);
        hipFuncSetAttribute((const void*)fwd_kernel, hipFuncAttributeMaxDynamicSharedMemorySize, LDS_BYTES);
        hipOccupancyMaxActiveBlocksPerMultiprocessor(&per_cu, (const void*)fwd_kernel, NT, LDS_BYTES);
        if (per_cu < 1) per_cu = 1;
        if (per_cu > 1) per_cu = 1;
        grid = cus * per_cu;
        if (n_in != 27 || ws_size < WS_END) fprintf(stderr, "kernel_launch: unexpected n_in %d or ws_size %zu\n", n_in, ws_size);
    }
    hipMemsetAsync((char*)d_ws, 0, CTL_ZERO_BYTES, stream);
    Args a{};
    for (int i = 0; i < 27; ++i) a.in[i] = (const float*)d_in[i];
    a.out = (float*)d_out; a.ws = (unsigned char*)d_ws;
    void* args[] = {&a};
    hipError_t e = hipLaunchCooperativeKernel((const void*)fwd_kernel, dim3(grid), dim3(NT), args, LDS_BYTES, stream);
    if (e != hipSuccess) fprintf(stderr, "cooperative launch failed: %s (grid %d)\n", hipGetErrorString(e), grid);
}
```

```cpp
#include <hip/hip_runtime.h>
#include <hip/hip_cooperative_groups.h>
#include <cstdio>
#include <cstdint>
namespace cg = cooperative_groups;
namespace pg8 {
#define PG8_LAS __attribute__((address_space(3)))
typedef unsigned short bf16_t;
typedef short bf16x8 __attribute__((ext_vector_type(8)));
typedef float f32x4 __attribute__((ext_vector_type(4)));
typedef unsigned u32x4 __attribute__((ext_vector_type(4)));
constexpr int BM = 256, BK = 64, HALF = 128, HTB = HALF * BK * 2  , STAGE_BYTES = 8 * HTB, NXCD = 8, WGM = 8;

__host__ __device__ __forceinline__ int lds_byte(int r, int c) { const int st = (r >> 4) * 2 + (c >> 5), rr = r & 15, cc = c & 31, ob = rr * 64 + cc * 2; return st * 1024 + (ob ^ (((ob >> 9) & 1) << 5)); }
__host__ __device__ __forceinline__ void stage_rc(int b, int& R, int& C) { const int st = b / 1024, sb = b % 1024, swz = sb ^ (((sb >> 9) & 1) << 5); R = (st >> 1) * 16 + swz / 64; C = (st & 1) * 32 + (swz % 64) / 2; }
__host__ __device__ __forceinline__ int perm32(int rho) { const int n = rho >> 4, i = rho & 15; return 8 * (i >> 2) + 4 * n + (i & 3); }
struct Unit { int pm, pn; };
struct Gemm { const bf16_t* A; const bf16_t* Bt; int M, N, K, lda; };

struct StaticOrder {
    int nM, nN, nwg, G, c;
    __host__ __device__ void init(int M, int N, int G_, int c_) { nM = M / BM; nN = N / BM; nwg = nM * nN; G = G_; c = c_; }
    __host__ __device__ bool next(int i, Unit& u) const {
        const long L = (long)i * G + c; if (L >= nwg) return false;
        int wgid = (int)L; { const int q = nwg / NXCD, r = nwg % NXCD, xcd = wgid % NXCD, off = wgid / NXCD; wgid = (xcd < r ? xcd * (q + 1) : r * (q + 1) + (xcd - r) * q) + off; }
        const int nig = WGM * nN, gid = wgid / nig, fm = gid * WGM, gsz = (nM - fm) < WGM ? (nM - fm) : WGM;
        u.pm = fm + ((wgid % nig) % gsz); u.pn = (wgid % nig) / gsz; return true;
    }
    __device__ __forceinline__ void a_ready(const Unit&) const {}
    __device__ __forceinline__ void done(const Unit&) const {}
};
__device__ __forceinline__ unsigned cvt_pk_bf16(float lo, float hi) { unsigned r; asm volatile("v_cvt_pk_bf16_f32 %0, %1, %2" : "=v"(r) : "v"(lo), "v"(hi)); return r; }
typedef float f32x2 __attribute__((ext_vector_type(2)));
template <class Epi, class Sched, bool ALIGN_EPI = false, bool SP2 = false>
__device__ __forceinline__ void gemm_phase(PG8_LAS unsigned char* lds, const Gemm g, const Sched& S, const Epi& E, int tid_in) {
    int tid_l = tid_in; asm volatile("" : "+v"(tid_l));
    const int tid = tid_l, wid = __builtin_amdgcn_readfirstlane(tid >> 6), lane = tid & 63, wr = wid >> 2, wc = wid & 3, fr = lane & 15, fq = lane >> 4;
    const int K = g.K, nt = K / BK;
    unsigned voffA[2], voffB[2];
#pragma unroll
    for (int i = 0; i < 2; ++i) { int R, C; stage_rc(tid * 16 + i * 8192, R, C); const int Rb = Epi::PERM ? ((R & ~31) + perm32(R & 31)) : R;
        voffA[i] = (unsigned)(R * g.lda + C) * 2u; voffB[i] = (unsigned)(Rb * K + C) * 2u; }
    const size_t kstep = (size_t)(BK * 2);
    const size_t hstep = (size_t)HALF * K * 2;
    const size_t tstep = 2 * hstep;
    const size_t hstepA = (size_t)HALF * g.lda * 2, tstepA = 2 * hstepA;
    const unsigned ldsw = (unsigned)wid * 1024u;
    const int aoff = lds_byte(wr * 64 + fr, fq * 8), boff = lds_byte(wc * 32 + fr, fq * 8);
#define PG8_SA(b, h) (((b) * 2 + (h)) * HTB)
#define PG8_SB(b, h) ((4 + (b) * 2 + (h)) * HTB)
#define PG8_STAGE(bufoff, gbase, voff) do { _Pragma("unroll") for (int _i = 0; _i < 2; ++_i) \
        __builtin_amdgcn_global_load_lds((const unsigned*)((const char*)(gbase) + (voff)[_i]), (PG8_LAS unsigned*)(lds + (bufoff) + ldsw + _i * 8192), 16, 0, 0); } while (0)
#define PG8_LDA(dst, b, h) do { _Pragma("unroll") for (int m = 0; m < 4; ++m) _Pragma("unroll") for (int k = 0; k < 2; ++k) dst[m][k] = *(const PG8_LAS bf16x8*)(lds + PG8_SA(b, h) + aoff + m * 2048 + k * 1024); } while (0)
#define PG8_LDB(dst, b, h) do { _Pragma("unroll") for (int n = 0; n < 2; ++n) _Pragma("unroll") for (int k = 0; k < 2; ++k) dst[n][k] = *(const PG8_LAS bf16x8*)(lds + PG8_SB(b, h) + boff + n * 2048 + k * 1024); } while (0)
#define PG8_MMA(ai, bj, At, Bt) do { __builtin_amdgcn_s_setprio(1); _Pragma("unroll") for (int m = 0; m < 4; ++m) _Pragma("unroll") for (int n = 0; n < 2; ++n) _Pragma("unroll") for (int k = 0; k < 2; ++k) \
        acc[ai][bj][m][n] = __builtin_amdgcn_mfma_f32_16x16x32_bf16(Bt[n][k], At[m][k], acc[ai][bj][m][n], 0, 0, 0); __builtin_amdgcn_s_setprio(0); } while (0)
#define PG8_WAIT_V(n) asm volatile("s_waitcnt vmcnt(" #n ")" ::: "memory")
#define PG8_WAIT_L(n) asm volatile("s_waitcnt lgkmcnt(" #n ")" ::: "memory")
#define PG8_BAR __builtin_amdgcn_s_barrier()
#define PG8_SCHED __builtin_amdgcn_sched_barrier(0)
    Unit cur, nxt; int ui = 0;
    if (!S.next(0, cur)) return;
    f32x4 acc[2][2][4][2];
#pragma unroll
    for (int a = 0; a < 2; ++a)
#pragma unroll
        for (int b = 0; b < 2; ++b)
#pragma unroll
            for (int m = 0; m < 4; ++m)
#pragma unroll
                for (int n = 0; n < 2; ++n) acc[a][b][m][n] = (f32x4){0.f, 0.f, 0.f, 0.f};
    bf16x8 At[4][2], B0[2][2], B1[2][2];
    const char* cA = (const char*)g.A + (size_t)cur.pm * tstepA; const char* cB = (const char*)g.Bt + (size_t)cur.pn * tstep;
    S.a_ready(cur);
    if constexpr (SP2) {
        PG8_STAGE(PG8_SB(0, 0), cB, voffB); PG8_STAGE(PG8_SB(0, 1), cB + hstep, voffB); PG8_STAGE(PG8_SA(0, 0), cA, voffA); PG8_STAGE(PG8_SA(0, 1), cA + hstepA, voffA);
        if (wr == 1) PG8_BAR;
        PG8_WAIT_V(2); PG8_BAR;
        PG8_STAGE(PG8_SB(1, 0), cB + kstep, voffB); PG8_STAGE(PG8_SA(1, 0), cA + kstep, voffA); PG8_STAGE(PG8_SB(1, 1), cB + hstep + kstep, voffB);
        PG8_WAIT_V(6); PG8_BAR;
    } else {
        PG8_STAGE(PG8_SB(0, 0), cB, voffB); PG8_STAGE(PG8_SA(0, 0), cA, voffA); PG8_STAGE(PG8_SB(0, 1), cB + hstep, voffB); PG8_STAGE(PG8_SA(0, 1), cA + hstepA, voffA);
        if (wr == 1) PG8_BAR;
        PG8_WAIT_V(4); PG8_BAR;
        PG8_STAGE(PG8_SB(1, 0), cB + kstep, voffB); PG8_STAGE(PG8_SA(1, 0), cA + kstep, voffA); PG8_STAGE(PG8_SB(1, 1), cB + hstep + kstep, voffB);
        PG8_WAIT_V(6); PG8_BAR;
    }
    for (;;) {
        const bool has_next = S.next(ui + 1, nxt);
        const char* nA = has_next ? (const char*)g.A + (size_t)nxt.pm * tstepA : cA; const char* nB = has_next ? (const char*)g.Bt + (size_t)nxt.pn * tstep : cB;
        for (int t = 0; t < nt; t += 2) {
            const bool last = (t == nt - 2);
            const char* a1 = cA + (size_t)(t + 1) * kstep;
            const char* a2 = last ? nA : cA + (size_t)(t + 2) * kstep; const char* b2 = last ? nB : cB + (size_t)(t + 2) * kstep;
            const char* a3 = a2 + kstep; const char* b3 = b2 + kstep;
            if (last && has_next) S.a_ready(nxt);
            if constexpr (SP2) {
            PG8_LDB(B0, 0, 0); PG8_LDB(B1, 0, 1); PG8_SCHED; PG8_LDA(At, 0, 0); PG8_STAGE(PG8_SA(1, 1), a1 + hstepA, voffA);
            PG8_WAIT_V(8); PG8_WAIT_L(0); PG8_BAR; PG8_MMA(0, 0, At, B0); PG8_MMA(0, 1, At, B1); PG8_BAR; PG8_SCHED;
            PG8_LDA(At, 0, 1); PG8_STAGE(PG8_SB(0, 0), b2, voffB); PG8_STAGE(PG8_SB(0, 1), b2 + hstep, voffB); PG8_STAGE(PG8_SA(0, 0), a2, voffA);
            PG8_WAIT_V(8); PG8_WAIT_L(0); PG8_BAR; PG8_MMA(1, 0, At, B0); PG8_MMA(1, 1, At, B1); PG8_BAR; PG8_SCHED;
            PG8_LDB(B0, 1, 0); PG8_LDB(B1, 1, 1); PG8_SCHED; PG8_LDA(At, 1, 0); PG8_STAGE(PG8_SA(0, 1), a2 + hstepA, voffA);
            PG8_WAIT_V(8); PG8_WAIT_L(0); PG8_BAR; PG8_MMA(0, 0, At, B0); PG8_MMA(0, 1, At, B1); PG8_BAR; PG8_SCHED;
            PG8_LDA(At, 1, 1); PG8_STAGE(PG8_SB(1, 0), b3, voffB); PG8_STAGE(PG8_SB(1, 1), b3 + hstep, voffB); PG8_STAGE(PG8_SA(1, 0), a3, voffA);
            PG8_WAIT_V(8); PG8_WAIT_L(0); PG8_BAR; PG8_MMA(1, 0, At, B0); PG8_MMA(1, 1, At, B1); PG8_BAR; PG8_SCHED;
            } else {
            PG8_LDB(B0, 0, 0); PG8_SCHED; PG8_LDA(At, 0, 0); PG8_STAGE(PG8_SA(1, 1), a1 + hstepA, voffA);
            PG8_WAIT_L(8); PG8_BAR; PG8_WAIT_L(0); PG8_MMA(0, 0, At, B0); PG8_BAR; PG8_SCHED;
            PG8_LDB(B1, 0, 1); PG8_STAGE(PG8_SB(0, 0), b2, voffB);
            PG8_BAR; PG8_WAIT_L(0); PG8_MMA(0, 1, At, B1); PG8_BAR;
            PG8_LDA(At, 0, 1); PG8_STAGE(PG8_SA(0, 0), a2, voffA);
            PG8_BAR; PG8_WAIT_L(0); PG8_MMA(1, 0, At, B0); PG8_BAR; PG8_SCHED;
            PG8_STAGE(PG8_SB(0, 1), b2 + hstep, voffB);
            PG8_WAIT_V(6); PG8_BAR; PG8_MMA(1, 1, At, B1); PG8_BAR;
            PG8_LDB(B0, 1, 0); PG8_SCHED; PG8_LDA(At, 1, 0); PG8_STAGE(PG8_SA(0, 1), a2 + hstepA, voffA);
            PG8_WAIT_L(8); PG8_BAR; PG8_WAIT_L(0); PG8_MMA(0, 0, At, B0); PG8_BAR; PG8_SCHED;
            PG8_LDB(B1, 1, 1); PG8_STAGE(PG8_SB(1, 0), b3, voffB);
            PG8_BAR; PG8_WAIT_L(0); PG8_MMA(0, 1, At, B1); PG8_BAR;
            PG8_LDA(At, 1, 1); PG8_STAGE(PG8_SA(1, 0), a3, voffA);
            PG8_BAR; PG8_WAIT_L(0); PG8_MMA(1, 0, At, B0); PG8_BAR; PG8_SCHED;
            PG8_STAGE(PG8_SB(1, 1), b3 + hstep, voffB);
            PG8_WAIT_V(6); PG8_BAR; PG8_MMA(1, 1, At, B1); PG8_BAR;
            }
        }
        if constexpr (ALIGN_EPI) { if (wr == 0) PG8_BAR; }
        if constexpr (!Epi::AFTER_DRAIN) { E(acc, cur, wr, wc, fr, fq); S.done(cur); }
        if (!has_next) break;
#pragma unroll
        for (int a = 0; a < 2; ++a)
#pragma unroll
            for (int b = 0; b < 2; ++b)
#pragma unroll
                for (int m = 0; m < 4; ++m)
#pragma unroll
                    for (int n = 0; n < 2; ++n) acc[a][b][m][n] = (f32x4){0.f, 0.f, 0.f, 0.f};
        cur = nxt; cA = nA; cB = nB; ++ui;
        if constexpr (ALIGN_EPI) { if (wr == 1) PG8_BAR; }
    }
    PG8_WAIT_V(0);
    if constexpr (!ALIGN_EPI) { if (wr == 0) PG8_BAR; }
    PG8_BAR;
    if constexpr (Epi::AFTER_DRAIN) { E.fused(acc, cur, wr, wc, fr, fq, lds, wid, lane); S.done(cur); }
#undef PG8_SA
#undef PG8_SB
#undef PG8_STAGE
#undef PG8_LDA
#undef PG8_LDB
#undef PG8_MMA
#undef PG8_WAIT_V
#undef PG8_WAIT_L
#undef PG8_BAR
#undef PG8_SCHED
}
}

#define LAS __attribute__((address_space(3)))
typedef unsigned short bf16_t;
typedef short bf16x8 __attribute__((ext_vector_type(8)));
typedef float f32x4 __attribute__((ext_vector_type(4)));
typedef float f32x16 __attribute__((ext_vector_type(16)));
typedef unsigned u32x4 __attribute__((ext_vector_type(4)));
typedef unsigned u32x2 __attribute__((ext_vector_type(2)));
typedef short v4i16_t __attribute__((ext_vector_type(4)));
typedef float f32x2_t __attribute__((ext_vector_type(2)));
typedef __bf16 bf16x2_t __attribute__((ext_vector_type(2)));

constexpr int D = 1024, FF = 2816, NMOD = 9, MODW = NMOD * D;
constexpr int GM = 32768;
constexpr int ZW = 1280;
constexpr int INW = 1184;
constexpr int NWAVES = 8, NT = 512;
constexpr float EPS = 1e-6f;
constexpr float LOG2E = 1.4426950408889634f;
constexpr float LOG2_THETA = 13.287712379549449f;

constexpr size_t MiB = 1u << 20;
constexpr size_t WS_MOD = 0;
constexpr size_t MOD_BYTES = 12 * MODW * 4;
constexpr size_t WS_BAR = 768 * 1024;
constexpr size_t CTL_ZERO_BYTES = 1 * MiB;
constexpr size_t WS_WGU1 = 1 * MiB;
constexpr size_t WS_WD1 = WS_WGU1 + (size_t)5632 * 1024 * 2;
constexpr size_t WS_WGU2 = WS_WD1 + (size_t)1024 * 2816 * 2;
constexpr size_t WS_WD2 = WS_WGU2 + (size_t)5632 * 1024 * 2;
constexpr size_t WS_WIN = WS_WD2 + (size_t)1024 * 2816 * 2;
constexpr size_t WS_WUQ = WS_WIN + (size_t)1280 * 1024 * 2;
constexpr size_t WS_WUKV = WS_WUQ + (size_t)768 * 256 * 2;
constexpr size_t WS_WOUT = WS_WUKV + (size_t)1024 * 256 * 2;
constexpr size_t WS_WEND = WS_WOUT + (size_t)1024 * 1024 * 2;
static_assert(WS_WEND <= 40 * MiB, "weights region");
constexpr size_t WS_H = 40 * MiB;
constexpr size_t WS_B = 104 * MiB;
constexpr size_t WS_ACT = WS_B;
constexpr size_t WS_Z = WS_B;
constexpr size_t WS_QB = WS_Z + (size_t)GM * ZW * 2;
constexpr size_t WS_KV = WS_QB + (size_t)GM * 768 * 2;
constexpr size_t WS_KB = WS_KV + (size_t)GM * 1024 * 2;
constexpr size_t WS_END = WS_KB + (size_t)GM * 768 * 2;
static_assert(WS_END <= 400 * MiB && WS_ACT + (size_t)GM * FF * 2 <= 400 * MiB, "ws map");

constexpr int LDS_BYTES = 131072 + 4096;

__device__ __forceinline__ unsigned f2bf(float f) { unsigned u = __builtin_bit_cast(unsigned, f); return (u + 0x7fffu + ((u >> 16) & 1u)) >> 16; }
__device__ __forceinline__ unsigned pk2(float lo, float hi) { f32x2_t v = {lo, hi}; bf16x2_t b = __builtin_convertvector(v, bf16x2_t); return __builtin_bit_cast(unsigned, b); }
__device__ __forceinline__ float bf2f(unsigned short b) { return __builtin_bit_cast(float, (unsigned)b << 16); }
__device__ __forceinline__ float bflo(unsigned w) { return __builtin_bit_cast(float, w << 16); }
__device__ __forceinline__ float bfhi(unsigned w) { return __builtin_bit_cast(float, w & 0xffff0000u); }
template <int M> __device__ __forceinline__ float swz_xor(float v) { return __builtin_bit_cast(float, __builtin_amdgcn_ds_swizzle(__builtin_bit_cast(int, v), (M << 10) | 0x1f)); }
__device__ __forceinline__ float half_sum(float v) { v += swz_xor<1>(v); v += swz_xor<2>(v); v += swz_xor<4>(v); v += swz_xor<8>(v); v += swz_xor<16>(v); return v; }
__device__ __forceinline__ void xhalf_pair(float v, float& lo, float& hi) { unsigned a = __builtin_bit_cast(unsigned, v), b = a;
    asm volatile("s_nop 1\n\tv_permlane32_swap_b32 %0, %1\n\ts_nop 1" : "+v"(a), "+v"(b)); lo = __builtin_bit_cast(float, a); hi = __builtin_bit_cast(float, b); }
__device__ __forceinline__ float xhalf_sum(float v) { float lo, hi; xhalf_pair(v, lo, hi); return lo + hi; }
__device__ __forceinline__ float xhalf_max(float v) { float lo, hi; xhalf_pair(v, lo, hi); return fmaxf(lo, hi); }
__device__ __forceinline__ float wave_sum(float v) { return xhalf_sum(half_sum(v)); }

namespace pg8 {
struct EpiPlain {
    static constexpr bool PERM = true, AFTER_DRAIN = false;
    bf16_t* O; int ldc;
    __device__ __forceinline__ void operator()(const f32x4 (&acc)[2][2][4][2], const Unit& u, int wr, int wc, int fr, int fq) const {
        const int row0 = u.pm * BM + wr * 64 + fr, col0 = u.pn * BM + wc * 32 + 8 * fq;
#pragma unroll
        for (int ai = 0; ai < 2; ++ai)
#pragma unroll
            for (int m = 0; m < 4; ++m) { bf16_t* rowp = O + (size_t)(row0 + ai * HALF + m * 16) * ldc + col0;
#pragma unroll
                for (int bj = 0; bj < 2; ++bj) { const f32x4 v0 = acc[ai][bj][m][0], v1 = acc[ai][bj][m][1];
                    u32x4 w; w.x = pk2(v0[0], v0[1]); w.y = pk2(v0[2], v0[3]); w.z = pk2(v1[0], v1[1]); w.w = pk2(v1[2], v1[3]);
                    *(u32x4*)(rowp + bj * HALF) = w; } }
    }
};
__device__ __forceinline__ float silu_mul(float g, float u) { return g * u * __builtin_amdgcn_rcpf(1.0f + __builtin_amdgcn_exp2f(-g * LOG2E)); }
struct EpiSwiGLU {
    static constexpr bool PERM = true, AFTER_DRAIN = false;
    bf16_t* O; int ldc;
    __device__ __forceinline__ void operator()(const f32x4 (&acc)[2][2][4][2], const Unit& u, int wr, int wc, int fr, int fq) const {
        const int row0 = u.pm * BM + wr * 64 + fr, col0 = u.pn * HALF + wc * 32 + 8 * fq;
#pragma unroll
        for (int ai = 0; ai < 2; ++ai)
#pragma unroll
            for (int m = 0; m < 4; ++m) { bf16_t* rowp = O + (size_t)(row0 + ai * HALF + m * 16) * ldc + col0;
                const f32x4 g0 = acc[ai][0][m][0], g1 = acc[ai][0][m][1], u0 = acc[ai][1][m][0], u1 = acc[ai][1][m][1];
                u32x4 w; w.x = pk2(silu_mul(g0[0], u0[0]), silu_mul(g0[1], u0[1])); w.y = pk2(silu_mul(g0[2], u0[2]), silu_mul(g0[3], u0[3]));
                w.z = pk2(silu_mul(g1[0], u1[0]), silu_mul(g1[1], u1[1])); w.w = pk2(silu_mul(g1[2], u1[2]), silu_mul(g1[3], u1[3]));
                *(u32x4*)rowp = w; }
    }
};
struct EpiResid {
    static constexpr bool PERM = false, AFTER_DRAIN = false;
    const float* base; float* out; const float* gate  ; int seq_shift  ; float scale;
    __device__ __forceinline__ void operator()(const f32x4 (&acc)[2][2][4][2], const Unit& u, int wr, int wc, int fr, int fq) const {
        const int row0 = u.pm * BM + wr * 64 + fr, col0 = u.pn * BM + wc * 32 + 4 * fq;
        const float* gp = gate + (size_t)((u.pm * BM) >> seq_shift) * MODW + col0;
#pragma unroll
        for (int bj = 0; bj < 2; ++bj)
#pragma unroll
            for (int n = 0; n < 2; ++n) { const f32x4 gv = *(const f32x4*)(gp + bj * HALF + n * 16) * scale;
#pragma unroll
                for (int ai = 0; ai < 2; ++ai)
#pragma unroll
                    for (int m = 0; m < 4; ++m) { const size_t off = (size_t)(row0 + ai * HALF + m * 16) * D + col0 + bj * HALF + n * 16;
                        const f32x4 b = *(const f32x4*)(base + off); *(f32x4*)(out + off) = b + gv * acc[ai][bj][m][n]; } }
    }
};
}

struct Args { const float* in[27]; float* out; unsigned char* ws; };

__device__ __forceinline__ void transpose_item(const float* W, int K, int N, bf16_t* WT, int mode, LAS float* scr, int item, int lane) {
    const int nblk = N / 32, kb = item / nblk, nb = item % nblk, k0 = 64 * kb, n0 = 32 * nb;
    int d0 = n0;
    if (mode == 1) d0 = (n0 >> 7) * 256 + (n0 & 127);
    else if (mode == 2) d0 = (n0 >> 7) * 256 + 128 + (n0 & 127);
#pragma unroll 8
    for (int i = 0; i < 32; ++i) { const int kk = 2 * i + (lane >> 5); scr[kk * 33 + (lane & 31)] = W[(size_t)(k0 + kk) * N + n0 + (lane & 31)]; }
    asm volatile("s_waitcnt lgkmcnt(0)" ::: "memory");
    const int c = lane & 7;
#pragma unroll
    for (int j = 0; j < 4; ++j) { const int n = (lane >> 3) + 8 * j; const LAS float* s = scr + (8 * c) * 33 + n;
        u32x4 o; o.x = pk2(s[0 * 33], s[1 * 33]); o.y = pk2(s[2 * 33], s[3 * 33]); o.z = pk2(s[4 * 33], s[5 * 33]); o.w = pk2(s[6 * 33], s[7 * 33]);
        *(u32x4*)(WT + (size_t)(d0 + n) * K + k0 + 8 * c) = o; }
    asm volatile("s_waitcnt lgkmcnt(0)" ::: "memory");
}

typedef const Args __attribute__((address_space(4)))* KArgs0;
__device__ __forceinline__ void phase0(KArgs0 ap, LAS unsigned char* lds, int tid, int wave, int lane) {
    unsigned char* ws = ap->ws;
    {
        LAS float* scr = (LAS float*)(lds + wave * 8704);
        const int gw = blockIdx.x * NWAVES + wave, NGW = gridDim.x * NWAVES;
        constexpr int I_G = (D / 64) * (FF / 32), I_D = (FF / 64) * (D / 32), I_IN = (D / 64) * (INW / 32), I_UQ = (256 / 64) * (768 / 32), I_UKV = (128 / 64) * (1024 / 32), I_OUT = (D / 64) * (D / 32);
        constexpr int NITEMS = 4 * I_G + 2 * I_D + I_IN + I_UQ + I_UKV + I_OUT;
        for (int it = gw; it < NITEMS; it += NGW) {
            int r = it;
            if (r < I_G) { transpose_item(ap->in[7], D, FF, (bf16_t*)(ws + WS_WGU1), 1, scr, r, lane); continue; } r -= I_G;
            if (r < I_G) { transpose_item(ap->in[8], D, FF, (bf16_t*)(ws + WS_WGU1), 2, scr, r, lane); continue; } r -= I_G;
            if (r < I_D) { transpose_item(ap->in[9], FF, D, (bf16_t*)(ws + WS_WD1), 0, scr, r, lane); continue; } r -= I_D;
            if (r < I_G) { transpose_item(ap->in[23], D, FF, (bf16_t*)(ws + WS_WGU2), 1, scr, r, lane); continue; } r -= I_G;
            if (r < I_G) { transpose_item(ap->in[24], D, FF, (bf16_t*)(ws + WS_WGU2), 2, scr, r, lane); continue; } r -= I_G;
            if (r < I_D) { transpose_item(ap->in[25], FF, D, (bf16_t*)(ws + WS_WD2), 0, scr, r, lane); continue; } r -= I_D;
            if (r < I_IN) { transpose_item(ap->in[11], D, INW, (bf16_t*)(ws + WS_WIN), 0, scr, r, lane); continue; } r -= I_IN;
            if (r < I_UQ) { transpose_item(ap->in[16], 256, 768, (bf16_t*)(ws + WS_WUQ), 0, scr, r, lane); continue; } r -= I_UQ;
            if (r < I_UKV) { transpose_item(ap->in[18], 256, 1024, (bf16_t*)(ws + WS_WUKV), 0, scr, r, lane); continue; } r -= I_UKV;
            transpose_item(ap->in[21], D, D, (bf16_t*)(ws + WS_WOUT), 0, scr, r, lane);
        }
        { for (int i = blockIdx.x * NT + tid; i < 1024 * 16; i += gridDim.x * NT) *(u32x4*)(ws + WS_WUKV + (size_t)(i >> 4) * 512 + 256 + (i & 15) * 16) = (u32x4){0u, 0u, 0u, 0u}; }
        { u32x4* p = (u32x4*)(ws + WS_WIN + (size_t)INW * D * 2); const int n16 = (ZW - INW) * D * 2 / 16;
          for (int i = blockIdx.x * NT + tid; i < n16; i += gridDim.x * NT) p[i] = (u32x4){0u, 0u, 0u, 0u}; }
    }
    __syncthreads();
    {
        LAS float* sc = (LAS float*)lds;
        float* mod = (float*)(ws + WS_MOD);
        const float* adaw = ap->in[4]; const float* adab = ap->in[5];
        for (int item = blockIdx.x; item < 18 * 16; item += gridDim.x) {
            const int cb = item % 18, kc = item / 18;
            __syncthreads();
            for (int i = tid; i < 12 * 64; i += NT) { const int s = i >> 6, kk = i & 63;
                const float c = (s < 4) ? ap->in[2][s * D + kc * 64 + kk] : ap->in[3][(s - 4) * D + kc * 64 + kk];
                sc[i] = c / (1.0f + __expf(-c)); }
            __syncthreads();
            const int col = cb * 512 + tid;
            float acc[12];
#pragma unroll
            for (int s = 0; s < 12; ++s) acc[s] = 0.f;
            const float* wp = adaw + (size_t)(kc * 64) * MODW + col;
#pragma unroll 8
            for (int kk = 0; kk < 64; ++kk) { const float w = wp[(size_t)kk * MODW];
#pragma unroll
                for (int s = 0; s < 12; ++s) acc[s] += sc[s * 64 + kk] * w; }
            const float b = (kc == 0) ? adab[col] : 0.f;
#pragma unroll
            for (int s = 0; s < 12; ++s) atomicAdd(mod + s * MODW + col, acc[s] + b);
        }
    }
}

__device__ __forceinline__ void norm_mod_phase(const float* x, const float* gain, const float* mod  , int shoff, int seq_shift, bf16_t* H, int wave, int lane) {
    const int gw = blockIdx.x * NWAVES + wave, NGW = gridDim.x * NWAVES;
    f32x4 gv[4];
#pragma unroll
    for (int j = 0; j < 4; ++j) gv[j] = *(const f32x4*)(gain + 256 * j + 4 * lane);
    for (int m = gw; m < GM; m += NGW) {
        const f32x4* xr = (const f32x4*)(x + (size_t)m * D) + lane;
        f32x4 v[4]; float s = 0.f;
#pragma unroll
        for (int j = 0; j < 4; ++j) { v[j] = xr[64 * j]; s += (v[j].x * v[j].x + v[j].y * v[j].y) + (v[j].z * v[j].z + v[j].w * v[j].w); }
        const float rstd = 1.0f / sqrtf(wave_sum(s) * (1.0f / D) + EPS);
        const float* mp = mod + (size_t)(m >> seq_shift) * MODW + shoff;
        u32x2* o8 = (u32x2*)(H + (size_t)m * D) + lane;
#pragma unroll
        for (int j = 0; j < 4; ++j) { const f32x4 sh = *(const f32x4*)(mp + 256 * j + 4 * lane), sc = *(const f32x4*)(mp + D + 256 * j + 4 * lane);
            const f32x4 y = v[j] * rstd * gv[j] * (sc + 1.0f) + sh; u32x2 w; w.x = pk2(y.x, y.y); w.y = pk2(y.z, y.w); o8[64 * j] = w; }
    }
}
__device__ __forceinline__ void final_norm_phase(float* x, const float* gain, int wave, int lane) {
    const int gw = blockIdx.x * NWAVES + wave, NGW = gridDim.x * NWAVES;
    f32x4 gv[4];
#pragma unroll
    for (int j = 0; j < 4; ++j) gv[j] = *(const f32x4*)(gain + 256 * j + 4 * lane);
    for (int m = gw; m < GM; m += NGW) {
        f32x4* xr = (f32x4*)(x + (size_t)m * D) + lane;
        f32x4 v[4]; float s = 0.f;
#pragma unroll
        for (int j = 0; j < 4; ++j) { v[j] = xr[64 * j]; s += (v[j].x * v[j].x + v[j].y * v[j].y) + (v[j].z * v[j].z + v[j].w * v[j].w); }
        const float rstd = 1.0f / sqrtf(wave_sum(s) * (1.0f / D) + EPS);
#pragma unroll
        for (int j = 0; j < 4; ++j) xr[64 * j] = v[j] * rstd * gv[j];
    }
}

__device__ __forceinline__ float oct_sum(float v) { v += swz_xor<1>(v); v += swz_xor<2>(v); v += swz_xor<4>(v); return v; }

__device__ __forceinline__ void post1_phase(bf16_t* Z, int Smask, const float* gq, const float* gk, const float* gcq, const float* gckv, int wave, int lane) {
    const int gw = blockIdx.x * NWAVES + wave, NGW = gridDim.x * NWAVES;
    const int sub = lane & 7, hq = lane >> 3;
    float invf[4], gq0[4], gq1[4], gk0[4], gk1[4];
#pragma unroll
    for (int e = 0; e < 4; ++e) { const int i = 4 * sub + e; invf[e] = exp2f(-(float)i * (LOG2_THETA / 32.0f)); gq0[e] = gq[i]; gq1[e] = gq[i + 32]; gk0[e] = gk[i]; gk1[e] = gk[i + 32]; }
    const float gc0 = gcq[4 * lane], gc1 = gcq[4 * lane + 1], gc2 = gcq[4 * lane + 2], gc3 = gcq[4 * lane + 3];
    const float gv0 = gckv[2 * lane], gv1 = gckv[2 * lane + 1];
    const bool kact = lane < 16;
    for (int m = gw; m < GM; m += NGW) {
        bf16_t* z = Z + (size_t)m * ZW;
        u32x2* pq0 = (u32x2*)(z + hq * 64 + 4 * sub); u32x2* pq1 = (u32x2*)(z + hq * 64 + 32 + 4 * sub);
        u32x2* pk0 = (u32x2*)(z + 512 + (hq & 1) * 64 + 4 * sub); u32x2* pk1 = (u32x2*)(z + 512 + (hq & 1) * 64 + 32 + 4 * sub);
        u32x2* pc = (u32x2*)(z + 768) + lane; unsigned* pv = (unsigned*)(z + 1024) + lane;
        const u32x2 wq0 = *pq0, wq1 = *pq1, wk0 = *pk0, wk1 = *pk1, wc = *pc; const unsigned wv = *pv;
        const float pos = (float)(m & Smask);
        float sn[4], cs[4];
#pragma unroll
        for (int e = 0; e < 4; ++e) sincosf(pos * invf[e], &sn[e], &cs[e]);
        {
            const float a[4] = {bflo(wq0.x), bfhi(wq0.x), bflo(wq0.y), bfhi(wq0.y)}, b[4] = {bflo(wq1.x), bfhi(wq1.x), bflo(wq1.y), bfhi(wq1.y)};
            float ss = 0.f;
#pragma unroll
            for (int e = 0; e < 4; ++e) ss += a[e] * a[e] + b[e] * b[e];
            const float rstd = 1.0f / sqrtf(oct_sum(ss) * (1.0f / 64.0f) + EPS) * (0.125f * LOG2E);
            float o0[4], o1[4];
#pragma unroll
            for (int e = 0; e < 4; ++e) { const float y1 = a[e] * rstd * gq0[e], y2 = b[e] * rstd * gq1[e]; o0[e] = y1 * cs[e] - y2 * sn[e]; o1[e] = y2 * cs[e] + y1 * sn[e]; }
            u32x2 w; w.x = pk2(o0[0], o0[1]); w.y = pk2(o0[2], o0[3]); *pq0 = w; w.x = pk2(o1[0], o1[1]); w.y = pk2(o1[2], o1[3]); *pq1 = w;
        }
        {
            const float a[4] = {bflo(wk0.x), bfhi(wk0.x), bflo(wk0.y), bfhi(wk0.y)}, b[4] = {bflo(wk1.x), bfhi(wk1.x), bflo(wk1.y), bfhi(wk1.y)};
            float ss = 0.f;
#pragma unroll
            for (int e = 0; e < 4; ++e) ss += a[e] * a[e] + b[e] * b[e];
            const float rstd = 1.0f / sqrtf(oct_sum(ss) * (1.0f / 64.0f) + EPS);
            float o0[4], o1[4];
#pragma unroll
            for (int e = 0; e < 4; ++e) { const float y1 = a[e] * rstd * gk0[e], y2 = b[e] * rstd * gk1[e]; o0[e] = y1 * cs[e] - y2 * sn[e]; o1[e] = y2 * cs[e] + y1 * sn[e]; }
            if (kact) { u32x2 w; w.x = pk2(o0[0], o0[1]); w.y = pk2(o0[2], o0[3]); *pk0 = w; w.x = pk2(o1[0], o1[1]); w.y = pk2(o1[2], o1[3]); *pk1 = w; }
        }
        {
            const float a0 = bflo(wc.x), a1 = bfhi(wc.x), a2 = bflo(wc.y), a3 = bfhi(wc.y);
            const float rstd = 1.0f / sqrtf(wave_sum((a0 * a0 + a1 * a1) + (a2 * a2 + a3 * a3)) * (1.0f / 256.0f) + EPS);
            u32x2 o; o.x = pk2(a0 * rstd * gc0, a1 * rstd * gc1); o.y = pk2(a2 * rstd * gc2, a3 * rstd * gc3); *pc = o;
        }
        {
            const float a0 = bflo(wv), a1 = bfhi(wv);
            const float rstd = 1.0f / sqrtf(wave_sum(a0 * a0 + a1 * a1) * (1.0f / 128.0f) + EPS);
            *pv = pk2(a0 * rstd * gv0, a1 * rstd * gv1);
        }
    }
}

__device__ __forceinline__ void post2_phase(bf16_t* QB, const bf16_t* KV, const bf16_t* Z, bf16_t* KB, int Smask, const float* gq, const float* gk, int wave, int lane) {
    const int gw = blockIdx.x * NWAVES + wave, NGW = gridDim.x * NWAVES;
    const int sub = lane & 7, h = lane >> 3;
    float gqn[8], gkn[8], gqr[4], gkr[4], invf[2];
#pragma unroll
    for (int e = 0; e < 8; ++e) { gqn[e] = gq[8 * sub + e]; gkn[e] = gk[8 * sub + e]; }
#pragma unroll
    for (int e = 0; e < 2; ++e) { const int i = 2 * sub + e; invf[e] = exp2f(-(float)i * (LOG2_THETA / 16.0f)); gqr[e] = gq[64 + i]; gqr[2 + e] = gq[80 + i]; gkr[e] = gk[64 + i]; gkr[2 + e] = gk[80 + i]; }
    const float qscl = 0.10206207261596577f * LOG2E;
    for (int m = gw; m < GM; m += NGW) {
        bf16_t* q = QB + (size_t)m * 768 + h * 96; const bf16_t* kv = KV + (size_t)m * 1024 + h * 128; bf16_t* kb = KB + (size_t)m * 768 + h * 96;
        const bf16_t* kr = Z + (size_t)m * ZW + 1152;
        const u32x4 wq = *(const u32x4*)(q + 8 * sub); const unsigned wqa = *(const unsigned*)(q + 64 + 2 * sub), wqb = *(const unsigned*)(q + 80 + 2 * sub);
        const u32x4 wk = *(const u32x4*)(kv + 8 * sub); const unsigned wka = *(const unsigned*)(kr + 2 * sub), wkb = *(const unsigned*)(kr + 16 + 2 * sub);
        const float pos = (float)(m & Smask);
        float sn[2], cs[2];
#pragma unroll
        for (int e = 0; e < 2; ++e) sincosf(pos * invf[e], &sn[e], &cs[e]);
        {
            const float n[8] = {bflo(wq.x), bfhi(wq.x), bflo(wq.y), bfhi(wq.y), bflo(wq.z), bfhi(wq.z), bflo(wq.w), bfhi(wq.w)};
            const float r0[2] = {bflo(wqa), bfhi(wqa)}, r1[2] = {bflo(wqb), bfhi(wqb)};
            float ss = r0[0] * r0[0] + r0[1] * r0[1] + r1[0] * r1[0] + r1[1] * r1[1];
#pragma unroll
            for (int e = 0; e < 8; ++e) ss += n[e] * n[e];
            const float rstd = 1.0f / sqrtf(oct_sum(ss) * (1.0f / 96.0f) + EPS) * qscl;
            u32x4 o; o.x = pk2(n[0] * rstd * gqn[0], n[1] * rstd * gqn[1]); o.y = pk2(n[2] * rstd * gqn[2], n[3] * rstd * gqn[3]);
            o.z = pk2(n[4] * rstd * gqn[4], n[5] * rstd * gqn[5]); o.w = pk2(n[6] * rstd * gqn[6], n[7] * rstd * gqn[7]);
            float a[2], b[2];
#pragma unroll
            for (int e = 0; e < 2; ++e) { const float y0 = r0[e] * rstd * gqr[e], y1 = r1[e] * rstd * gqr[2 + e]; a[e] = y0 * cs[e] - y1 * sn[e]; b[e] = y1 * cs[e] + y0 * sn[e]; }
            *(u32x4*)(q + 8 * sub) = o; *(unsigned*)(q + 64 + 2 * sub) = pk2(a[0], a[1]); *(unsigned*)(q + 80 + 2 * sub) = pk2(b[0], b[1]);
        }
        {
            const float n[8] = {bflo(wk.x), bfhi(wk.x), bflo(wk.y), bfhi(wk.y), bflo(wk.z), bfhi(wk.z), bflo(wk.w), bfhi(wk.w)};
            const float r0[2] = {bflo(wka), bfhi(wka)}, r1[2] = {bflo(wkb), bfhi(wkb)};
            float ss = r0[0] * r0[0] + r0[1] * r0[1] + r1[0] * r1[0] + r1[1] * r1[1];
#pragma unroll
            for (int e = 0; e < 8; ++e) ss += n[e] * n[e];
            const float rstd = 1.0f / sqrtf(oct_sum(ss) * (1.0f / 96.0f) + EPS);
            u32x4 o; o.x = pk2(n[0] * rstd * gkn[0], n[1] * rstd * gkn[1]); o.y = pk2(n[2] * rstd * gkn[2], n[3] * rstd * gkn[3]);
            o.z = pk2(n[4] * rstd * gkn[4], n[5] * rstd * gkn[5]); o.w = pk2(n[6] * rstd * gkn[6], n[7] * rstd * gkn[7]);
            float a[2], b[2];
#pragma unroll
            for (int e = 0; e < 2; ++e) { const float y0 = r0[e] * rstd * gkr[e], y1 = r1[e] * rstd * gkr[2 + e]; a[e] = y0 * cs[e] - y1 * sn[e]; b[e] = y1 * cs[e] + y0 * sn[e]; }
            *(u32x4*)(kb + 8 * sub) = o; *(unsigned*)(kb + 64 + 2 * sub) = pk2(a[0], a[1]); *(unsigned*)(kb + 80 + 2 * sub) = pk2(b[0], b[1]);
        }
    }
}

#define XB_TMO      128
#define XB_XCNT(j)  (256  + 64 * (j))
#define XB_XSUB(j)  (1280 + 64 * (j))
#define XB_XGEN(j)  (2304 + 64 * (j))
#define XB_TOP      3328
#define XB_TOPGEN   3392
#define XCD_BAR_WORDS 3456
#define XB_SPIN_CAP (1u << 22)

__device__ __forceinline__ unsigned xb_ld(unsigned* p)              { return __hip_atomic_load(p, __ATOMIC_RELAXED, __HIP_MEMORY_SCOPE_AGENT); }
__device__ __forceinline__ unsigned xb_add(unsigned* p, unsigned v) { return __hip_atomic_fetch_add(p, v, __ATOMIC_RELAXED, __HIP_MEMORY_SCOPE_AGENT); }
__device__ __forceinline__ unsigned xb_xcc_id() { return (unsigned)__builtin_amdgcn_s_getreg((3 << 11) | 20) & 0xFu; }
#define XB_SPIN(cond, bar) do { unsigned _sp = 0; while (cond) { __builtin_amdgcn_s_sleep(1); \
    if ((++_sp & 255u) == 0u) { if (xb_ld(&(bar)[XB_TMO])) break; if (_sp > XB_SPIN_CAP) { atomicAdd(&(bar)[XB_TMO], 1u); break; } } } } while (0)

struct XcdBarrier {
    unsigned* bar; unsigned x;
    volatile LAS unsigned* st;
};

__device__ __forceinline__ XcdBarrier xcd_barrier_post(unsigned* bar, volatile LAS unsigned* st, bool leader) {
    XcdBarrier b; b.bar = bar; b.x = xb_xcc_id(); b.st = st;
    if (leader) (void)xb_add(&bar[XB_XCNT(b.x)], 1u);
    return b;
}
__device__ __forceinline__ void xcd_barrier_complete(unsigned* bar, unsigned x, unsigned& nloc, unsigned& nx) {
    const unsigned G = gridDim.x * gridDim.y * gridDim.z;
    unsigned sum, cnt, mine, sp = 0u;
    for (;;) {
        sum = 0u; cnt = 0u; mine = 0u;
#pragma unroll
        for (unsigned j = 0; j < 16; ++j) { const unsigned c = xb_ld(&bar[XB_XCNT(j)]); sum += c; cnt += (c > 0u) ? 1u : 0u; mine = (j == x) ? c : mine; }
        if (sum == G) break;
        __builtin_amdgcn_s_sleep(1);
        if ((++sp & 255u) == 0u) { if (xb_ld(&bar[XB_TMO])) break; if (sp > XB_SPIN_CAP) { atomicAdd(&bar[XB_TMO], 1u); break; } }
    }
    nloc = mine > 0u ? mine : 1u; nx = cnt > 0u ? cnt : 1u;
}

__device__ __forceinline__ void xcd_barrier(const XcdBarrier& b, bool leader) {
    asm volatile("s_waitcnt vmcnt(0)" ::: "memory");
    __syncthreads();
    if (leader) {
        unsigned* bar = b.bar;
        __builtin_amdgcn_s_waitcnt(0);
        unsigned nloc = b.st[0], nx = b.st[1];
        if (nloc == 0u) { xcd_barrier_complete(bar, b.x, nloc, nx); b.st[0] = nloc; b.st[1] = nx; }
        const unsigned old = xb_add(&bar[XB_XSUB(b.x)], 1u);
        const unsigned gen = old / nloc;
        if (old + 1u == (gen + 1u) * nloc) {
            __builtin_amdgcn_fence(__ATOMIC_RELEASE, "agent");
            asm volatile("s_waitcnt vmcnt(0)" ::: "memory");
            const unsigned og = xb_add(&bar[XB_TOP], 1u);
            const unsigned tg = og / nx;
            if (og + 1u == (tg + 1u) * nx) xb_add(&bar[XB_TOPGEN], 1u);
            else XB_SPIN(xb_ld(&bar[XB_TOPGEN]) == tg, bar);
            __builtin_amdgcn_fence(__ATOMIC_ACQUIRE, "agent");
            xb_add(&bar[XB_XGEN(b.x)], 1u);
            asm volatile("s_waitcnt vmcnt(0)" ::: "memory");
        } else {
            XB_SPIN(xb_ld(&bar[XB_XGEN(b.x)]) == gen, bar);
            __builtin_amdgcn_fence(__ATOMIC_ACQUIRE, "agent");
            asm volatile("s_waitcnt vmcnt(0)" ::: "memory");
        }
    }
    __syncthreads();
}

__device__ __forceinline__ int crow(int r, int hi) { return (r & 3) + 8 * (r >> 2) + 4 * hi; }
#define MFMA32(a, b, c) __builtin_amdgcn_mfma_f32_32x32x16_bf16((a), (b), (c), 0, 0, 0)
constexpr int ATT_VP = 192;
template <int DQ> struct AttnCfg { static constexpr int KP = DQ * 2 + 16, KBUF = 64 * KP, VBUF = 64 * ATT_VP, CPR = DQ / 8, NKCH = 64 * CPR; };

template <int DQ, bool SWA>
__device__ __forceinline__ void attn_unit(const bf16_t* Qp, int ldq, const bf16_t* Kp, int ldk, const bf16_t* Vp, int ldv, bf16_t* Op, int ldo,
                                          int S, int q0, float sink_l2, LAS unsigned char* lds, int tid, int wave, int lane) {
    typedef AttnCfg<DQ> C;
    constexpr int NKS = DQ / 16;
    LAS unsigned char* Kb = lds;
    LAS unsigned char* Vb = lds + 2 * C::KBUF;
    LAS float* scr = (LAS float*)(lds + 2 * C::KBUF + 2 * C::VBUF) + wave * 64;
    const int r = lane & 31, h = lane >> 5;
    const int qw = q0 + wave * 32;
    bf16x8 qf[NKS];
#pragma unroll
    for (int ks = 0; ks < NKS; ++ks) qf[ks] = *(const bf16x8*)(Qp + (size_t)(qw + r) * ldq + 16 * ks + 8 * h);
    int t_lo = 0, t_hi = S / 64;
    if (SWA) { const int lo = q0 - 128 < 0 ? 0 : q0 - 128, hi = q0 + 384 > S ? S : q0 + 384; t_lo = lo / 64; t_hi = hi / 64; }
    const int vrow = tid >> 3, vch = tid & 7;
    const int k0row = tid / C::CPR, k0ch = tid % C::CPR;
    const int k1idx = tid + 512; const bool k1on = k1idx < C::NKCH; const int k1row = k1idx / C::CPR, k1ch = k1idx % C::CPR;
    u32x4 rvA, rk0A, rk1A = (u32x4){0u, 0u, 0u, 0u};
    const unsigned vofs = (unsigned)(vrow * ldv + vch * 8), k0ofs = (unsigned)(k0row * ldk + k0ch * 8), k1ofs = (unsigned)(k1row * ldk + k1ch * 8);
#define ATT_GLOAD(X, t) do { const bf16_t* Vt_ = Vp + (size_t)(t) * 64 * ldv; const bf16_t* Kt_ = Kp + (size_t)(t) * 64 * ldk; \
        rv##X = *(const u32x4*)(Vt_ + vofs); \
        rk0##X = *(const u32x4*)(Kt_ + k0ofs); \
        if (k1on) rk1##X = *(const u32x4*)(Kt_ + k1ofs); } while (0)
#define ATT_LSTORE(X, b) do { *(LAS u32x4*)(Vb + (b) * C::VBUF + vrow * ATT_VP + vch * 16) = rv##X; \
        *(LAS u32x4*)(Kb + (b) * C::KBUF + k0row * C::KP + k0ch * 16) = rk0##X; \
        if (k1on) *(LAS u32x4*)(Kb + (b) * C::KBUF + k1row * C::KP + k1ch * 16) = rk1##X; } while (0)
    float mref = SWA ? sink_l2 : 0.0f;
    f32x16 o0, o1, o2, negm;
#pragma unroll
    for (int i = 0; i < 16; ++i) { o0[i] = 0.f; o1[i] = 0.f; o2[i] = 0.f; negm[i] = -mref; }
    const bf16x8 ones = (bf16x8){0x3F80, 0x3F80, 0x3F80, 0x3F80, 0x3F80, 0x3F80, 0x3F80, 0x3F80};
    const int koff = r * C::KP + 16 * h;
    const int voff = (4 * h + ((lane & 15) >> 2)) * ATT_VP + ((lane >> 4) & 1) * 32 + (lane & 3) * 8;
    ATT_GLOAD(A, t_lo); ATT_LSTORE(A, 0);
    if (t_lo + 1 < t_hi) ATT_GLOAD(A, t_lo + 1);
    __syncthreads();
    auto step = [&](const int t, const int cur, u32x4& rvX, u32x4& rk0X, u32x4& rk1X) __attribute__((always_inline)) {
        bool need = true;
        if (SWA) need = (64 * t + 63 >= qw - 128) && (64 * t <= qw + 31 + 128);
        if (need) {
            const LAS unsigned char* kb = Kb + cur * C::KBUF + koff;
            bf16x8 ka[NKS], kc[NKS];
#pragma unroll
            for (int ks = 0; ks < NKS; ++ks) { ka[ks] = *(const LAS bf16x8*)(kb + ks * 32); kc[ks] = *(const LAS bf16x8*)(kb + 32 * C::KP + ks * 32); }
            __builtin_amdgcn_sched_barrier(0);
            f32x16 p0 = negm, p1 = negm;
#pragma unroll
            for (int ks = 0; ks < NKS; ++ks) { p0 = MFMA32(ka[ks], qf[ks], p0); p1 = MFMA32(kc[ks], qf[ks], p1); }
            __builtin_amdgcn_sched_barrier(0);
            const LAS unsigned char* vb = Vb + cur * C::VBUF + voff;
            v4i16_t vl0[4], vh0[4], vl1[4], vh1[4];
#pragma unroll
            for (int s = 0; s < 4; ++s) {
                vl0[s] = __builtin_amdgcn_ds_read_tr16_b64_v4i16((LAS v4i16_t*)(vb + (16 * s) * ATT_VP));
                vh0[s] = __builtin_amdgcn_ds_read_tr16_b64_v4i16((LAS v4i16_t*)(vb + (16 * s + 8) * ATT_VP));
                vl1[s] = __builtin_amdgcn_ds_read_tr16_b64_v4i16((LAS v4i16_t*)(vb + (16 * s) * ATT_VP + 64));
                vh1[s] = __builtin_amdgcn_ds_read_tr16_b64_v4i16((LAS v4i16_t*)(vb + (16 * s + 8) * ATT_VP + 64));
            }
            __builtin_amdgcn_sched_barrier(0);
            if (SWA) {
                const int qpos = qw + r, kb0 = 64 * t + 4 * h;
#pragma unroll
                for (int i = 0; i < 16; ++i) { const int kp = kb0 + (i & 3) + 8 * (i >> 2); const int d0_ = kp - qpos, d1_ = d0_ + 32;
                    if (d0_ > 128 || d0_ < -128) p0[i] = -1e30f; if (d1_ > 128 || d1_ < -128) p1[i] = -1e30f; }
            }
            float mx = fmaxf(p0[0], p1[0]);
#pragma unroll
            for (int i = 1; i < 16; ++i) mx = fmaxf(mx, fmaxf(p0[i], p1[i]));
            mx = xhalf_max(mx);
            if (__any(mx > 8.0f)) {
                const float dl = fmaxf(mx, 0.0f), alpha = __builtin_amdgcn_exp2f(-dl);
                mref += dl;
#pragma unroll
                for (int i = 0; i < 16; ++i) { p0[i] -= dl; p1[i] -= dl; negm[i] = -mref; }
                if (h == 0) scr[r] = alpha;
                asm volatile("s_waitcnt lgkmcnt(0)" ::: "memory");
#pragma unroll
                for (int g = 0; g < 4; ++g) { const f32x4 av = *(const LAS f32x4*)(scr + 8 * g + 4 * h);
#pragma unroll
                    for (int j = 0; j < 4; ++j) { o0[4 * g + j] *= av[j]; o1[4 * g + j] *= av[j]; o2[4 * g + j] *= av[j]; } }
                asm volatile("s_waitcnt lgkmcnt(0)" ::: "memory");
            }
#pragma unroll
            for (int i = 0; i < 16; ++i) { p0[i] = __builtin_amdgcn_exp2f(p0[i]); p1[i] = __builtin_amdgcn_exp2f(p1[i]); }
            bf16x8 pf[4];
#pragma unroll
            for (int s2 = 0; s2 < 2; ++s2) {
                u32x4 w0, w1;
                w0.x = pk2(p0[8 * s2 + 0], p0[8 * s2 + 1]); w0.y = pk2(p0[8 * s2 + 2], p0[8 * s2 + 3]); w0.z = pk2(p0[8 * s2 + 4], p0[8 * s2 + 5]); w0.w = pk2(p0[8 * s2 + 6], p0[8 * s2 + 7]);
                w1.x = pk2(p1[8 * s2 + 0], p1[8 * s2 + 1]); w1.y = pk2(p1[8 * s2 + 2], p1[8 * s2 + 3]); w1.z = pk2(p1[8 * s2 + 4], p1[8 * s2 + 5]); w1.w = pk2(p1[8 * s2 + 6], p1[8 * s2 + 7]);
                pf[s2] = __builtin_bit_cast(bf16x8, w0); pf[2 + s2] = __builtin_bit_cast(bf16x8, w1);
            }
            __builtin_amdgcn_sched_barrier(0);
#pragma unroll
            for (int s = 0; s < 4; ++s) {
                const bf16x8 v0 = (bf16x8){vl0[s][0], vl0[s][1], vl0[s][2], vl0[s][3], vh0[s][0], vh0[s][1], vh0[s][2], vh0[s][3]};
                const bf16x8 v1 = (bf16x8){vl1[s][0], vl1[s][1], vl1[s][2], vl1[s][3], vh1[s][0], vh1[s][1], vh1[s][2], vh1[s][3]};
                o0 = MFMA32(pf[s], v0, o0);
                o1 = MFMA32(pf[s], v1, o1);
                o2 = MFMA32(pf[s], ones, o2);
            }
        }
        if (t + 1 < t_hi) { *(LAS u32x4*)(Vb + (cur ^ 1) * C::VBUF + vrow * ATT_VP + vch * 16) = rvX;
            *(LAS u32x4*)(Kb + (cur ^ 1) * C::KBUF + k0row * C::KP + k0ch * 16) = rk0X;
            if (k1on) *(LAS u32x4*)(Kb + (cur ^ 1) * C::KBUF + k1row * C::KP + k1ch * 16) = rk1X; }
        if (t + 2 < t_hi) { const bf16_t* Vt_ = Vp + (size_t)(t + 2) * 64 * ldv; const bf16_t* Kt_ = Kp + (size_t)(t + 2) * 64 * ldk;
            rvX = *(const u32x4*)(Vt_ + vofs);
            rk0X = *(const u32x4*)(Kt_ + k0ofs);
            if (k1on) rk1X = *(const u32x4*)(Kt_ + k1ofs); }
        __syncthreads();
    };
    for (int t = t_lo; t < t_hi; t += 2) { step(t, 0, rvA, rk0A, rk1A); step(t + 1, 1, rvA, rk0A, rk1A); }
    if (SWA) { if (h == 0) scr[r] = __builtin_amdgcn_exp2f(sink_l2 - mref); asm volatile("s_waitcnt lgkmcnt(0)" ::: "memory"); }
#pragma unroll
    for (int g = 0; g < 4; ++g) { f32x4 sv = (f32x4){0.f, 0.f, 0.f, 0.f}; if (SWA) sv = *(const LAS f32x4*)(scr + 8 * g + 4 * h);
#pragma unroll
        for (int j = 0; j < 4; ++j) { const int q = qw + 8 * g + 4 * h + j; bf16_t* op = Op + (size_t)q * ldo + r; const float rl = 1.0f / (o2[4 * g + j] + sv[j]);
            op[0] = (bf16_t)f2bf(o0[4 * g + j] * rl); op[32] = (bf16_t)f2bf(o1[4 * g + j] * rl); } }
    asm volatile("s_waitcnt lgkmcnt(0)" ::: "memory");
#undef ATT_GLOAD
#undef ATT_LSTORE
}

template <class Epi>
__device__ __forceinline__ void run_gemm(LAS unsigned char* lds, const bf16_t* A, int lda, const bf16_t* Bt, int N, int K, const Epi& E, int tid) {
    int bx = (int)blockIdx.x; asm volatile("" : "+s"(bx), "+s"(A), "+s"(Bt));
    pg8::Gemm g{A, Bt, GM, N, K, lda}; pg8::StaticOrder S; S.init(GM, N, (int)gridDim.x, bx);
    pg8::gemm_phase<Epi, pg8::StaticOrder, true, true>(lds, g, S, E, tid);
}

typedef const Args __attribute__((address_space(4)))* KArgs;
#define PHASE_BEGIN() KArgs ap = (KArgs)__builtin_amdgcn_kernarg_segment_ptr(); asm volatile("" : "+s"(ap)); \
    unsigned char* ws = ap->ws; (void)ws; \
    int lane; asm volatile("v_mbcnt_lo_u32_b32 %0, -1, 0\n\tv_mbcnt_hi_u32_b32 %0, -1, %0" : "=v"(lane)); const int wave = wave_s, tid = wave_s * 64 + lane; (void)tid; \
    const float* xin = ap->in[g]; (void)xin; float* out = ap->out + (size_t)g * GM * D; (void)out; \
    const float* mod = (const float*)(ws + WS_MOD) + (size_t)(g ? 4 : 0) * MODW; (void)mod; \
    const int S = g ? 4096 : 8192, seq_shift = g ? 12 : 13, nseq = g ? 8 : 4; (void)S; (void)seq_shift; (void)nseq
#define WSP(off) ((bf16_t*)(ws + (off)))

__global__ void __launch_bounds__(NT, 2) fwd_kernel(Args a) {
    extern __shared__ __attribute__((aligned(16))) unsigned char lds_raw[];
    cg::grid_group grid = cg::this_grid();
    LAS unsigned char* lds = (LAS unsigned char*)lds_raw;
    const int wave_s = __builtin_amdgcn_readfirstlane((int)threadIdx.x >> 6);
    volatile LAS unsigned* bar_st = (volatile LAS unsigned*)(lds + 131072);
    if (threadIdx.x < 2) bar_st[threadIdx.x] = 0u;
    __syncthreads();
    { const int g = 0; PHASE_BEGIN(); (void)xcd_barrier_post((unsigned*)(ws + WS_BAR), bar_st, tid == 0); phase0(ap, lds, tid, wave, lane); }
    grid.sync();
#define SEAM() do { const int g = 0; PHASE_BEGIN(); XcdBarrier b_; b_.bar = (unsigned*)(ws + WS_BAR); b_.x = xb_xcc_id(); b_.st = bar_st; xcd_barrier(b_, tid == 0); } while (0)

    for (int g = 0; g < 2; ++g) {
        { PHASE_BEGIN(); norm_mod_phase(xin, ap->in[6], mod, 0, seq_shift, WSP(WS_H), wave, lane); }
        SEAM();
        { PHASE_BEGIN(); run_gemm(lds, WSP(WS_H), D, WSP(WS_WGU1), 2 * FF, D, pg8::EpiSwiGLU{WSP(WS_ACT), FF}, tid); }
        SEAM();
        { PHASE_BEGIN(); run_gemm(lds, WSP(WS_ACT), FF, WSP(WS_WD1), D, FF, pg8::EpiResid{xin, out, mod + 2 * D, seq_shift, 0.5f}, tid); }
        SEAM();
        { PHASE_BEGIN(); norm_mod_phase(out, ap->in[10], mod, 3 * D, seq_shift, WSP(WS_H), wave, lane); }
        SEAM();
        { PHASE_BEGIN(); run_gemm(lds, WSP(WS_H), D, WSP(WS_WIN), ZW, D, pg8::EpiPlain{WSP(WS_Z), ZW}, tid); }
        SEAM();
        { PHASE_BEGIN(); post1_phase(WSP(WS_Z), S - 1, ap->in[12], ap->in[13], ap->in[15], ap->in[17], wave, lane); }
        SEAM();
        { PHASE_BEGIN(); run_gemm(lds, WSP(WS_Z) + 768, ZW, WSP(WS_WUQ), 768, 256, pg8::EpiPlain{WSP(WS_QB), 768}, tid); }
        { PHASE_BEGIN(); run_gemm(lds, WSP(WS_Z) + 1024, ZW, WSP(WS_WUKV), 1024, 256, pg8::EpiPlain{WSP(WS_KV), 1024}, tid); }
        SEAM();
        { PHASE_BEGIN(); post2_phase(WSP(WS_QB), WSP(WS_KV), WSP(WS_Z), WSP(WS_KB), S - 1, ap->in[19], ap->in[20], wave, lane); }
        SEAM();
        {
            PHASE_BEGIN();
            bf16_t* H = WSP(WS_H); bf16_t* Z = WSP(WS_Z); bf16_t* QB = WSP(WS_QB); bf16_t* KV = WSP(WS_KV); bf16_t* KB = WSP(WS_KB);
            const int nqb = S / 256, nunits = nseq * 8 * nqb;
            const int G = (int)gridDim.x, bx = (int)blockIdx.x;
            const int vcu = (G % 8 == 0) ? (bx % 8) * (G / 8) + bx / 8 : bx;
            for (int u = vcu; u < 2 * nunits; u += G) {
                const bool dense = u < nunits; const int uu = dense ? u : u - nunits;
                const int qb = uu % nqb, hd = (uu / nqb) & 7, s = uu / (nqb * 8);
                const size_t r0 = (size_t)s * S;
                if (dense)
                    attn_unit<96, false>(QB + r0 * 768 + hd * 96, 768, KB + r0 * 768 + hd * 96, 768, KV + r0 * 1024 + hd * 128 + 64, 1024,
                                         H + r0 * 1024 + 512 + hd * 64, 1024, S, qb * 256, 0.f, lds, tid, wave, lane);
                else
                    attn_unit<64, true>(Z + r0 * ZW + hd * 64, ZW, Z + r0 * ZW + 512 + (hd >> 2) * 64, ZW, Z + r0 * ZW + 640 + (hd >> 2) * 64, ZW,
                                        H + r0 * 1024 + hd * 64, 1024, S, qb * 256, ap->in[14][hd] * LOG2E, lds, tid, wave, lane);
            }
        }
        SEAM();
        { PHASE_BEGIN(); run_gemm(lds, WSP(WS_H), D, WSP(WS_WOUT), D, D, pg8::EpiResid{out, out, mod + 5 * D, seq_shift, 1.0f}, tid); }
        SEAM();
        { PHASE_BEGIN(); norm_mod_phase(out, ap->in[22], mod, 6 * D, seq_shift, WSP(WS_H), wave, lane); }
        SEAM();
        { PHASE_BEGIN(); run_gemm(lds, WSP(WS_H), D, WSP(WS_WGU2), 2 * FF, D, pg8::EpiSwiGLU{WSP(WS_ACT), FF}, tid); }
        SEAM();
        { PHASE_BEGIN(); run_gemm(lds, WSP(WS_ACT), FF, WSP(WS_WD2), D, FF, pg8::EpiResid{out, out, mod + 8 * D, seq_shift, 0.5f}, tid); }
        SEAM();
        { PHASE_BEGIN(); final_norm_phase(out, ap->in[26], wave, lane); }
    }
}

extern "C" void kernel_launch(void* const* d_in, const int* in_sizes, int n_in, void* d_out, int out_size, void* d_ws, size_t ws_size, hipStream_t stream) {
    static int grid = 0;
    if (grid == 0) {
        int dev = 0, cus = 0, per_cu = 0;
        hipGetDevice(&dev);
        hipDeviceGetAttribute(&cus, hipDeviceAttributeMultiprocessorCount, dev);
        hipFuncSetAttribute((const void*)fwd_kernel, hipFuncAttributeMaxDynamicSharedMemorySize, LDS_BYTES);
        hipOccupancyMaxActiveBlocksPerMultiprocessor(&per_cu, (const void*)fwd_kernel, NT, LDS_BYTES);
        if (per_cu < 1) per_cu = 1;
        if (per_cu > 1) per_cu = 1;
        grid = cus * per_cu;
        if (n_in != 27 || ws_size < WS_END) fprintf(stderr, "kernel_launch: unexpected n_in %d or ws_size %zu\n", n_in, ws_size);
    }
    hipMemsetAsync((char*)d_ws, 0, CTL_ZERO_BYTES, stream);
    Args a{};
    for (int i = 0; i < 27; ++i) a.in[i] = (const float*)d_in[i];
    a.out = (float*)d_out; a.ws = (unsigned char*)d_ws;
    void* args[] = {&a};
    hipError_t e = hipLaunchCooperativeKernel((const void*)fwd_kernel, dim3(grid), dim3(NT), args, LDS_BYTES, stream);
    if (e != hipSuccess) fprintf(stderr, "cooperative launch failed: %s (grid %d)\n", hipGetErrorString(e), grid);
}
```

```cpp
#include <hip/hip_runtime.h>
#include <hip/hip_cooperative_groups.h>
#include <cstdio>
#include <cstdint>
namespace cg = cooperative_groups;
namespace pg8 {
#define PG8_LAS __attribute__((address_space(3)))
typedef unsigned short bf16_t;
typedef short bf16x8 __attribute__((ext_vector_type(8)));
typedef float f32x4 __attribute__((ext_vector_type(4)));
typedef unsigned u32x4 __attribute__((ext_vector_type(4)));
constexpr int BM = 256, BK = 64, HALF = 128, HTB = HALF * BK * 2  , STAGE_BYTES = 8 * HTB, NXCD = 8, WGM = 8;

__host__ __device__ __forceinline__ int lds_byte(int r, int c) { const int st = (r >> 4) * 2 + (c >> 5), rr = r & 15, cc = c & 31, ob = rr * 64 + cc * 2; return st * 1024 + (ob ^ (((ob >> 9) & 1) << 5)); }
__host__ __device__ __forceinline__ void stage_rc(int b, int& R, int& C) { const int st = b / 1024, sb = b % 1024, swz = sb ^ (((sb >> 9) & 1) << 5); R = (st >> 1) * 16 + swz / 64; C = (st & 1) * 32 + (swz % 64) / 2; }
__host__ __device__ __forceinline__ int perm32(int rho) { const int n = rho >> 4, i = rho & 15; return 8 * (i >> 2) + 4 * n + (i & 3); }
struct Unit { int pm, pn; };
struct Gemm { const bf16_t* A; const bf16_t* Bt; int M, N, K, lda; };

struct StaticOrder {
    int nM, nN, nwg, G, c;
    __host__ __device__ void init(int M, int N, int G_, int c_) { nM = M / BM; nN = N / BM; nwg = nM * nN; G = G_; c = c_; }
    __host__ __device__ bool next(int i, Unit& u) const {
        const long L = (long)i * G + c; if (L >= nwg) return false;
        int wgid = (int)L; { const int q = nwg / NXCD, r = nwg % NXCD, xcd = wgid % NXCD, off = wgid / NXCD; wgid = (xcd < r ? xcd * (q + 1) : r * (q + 1) + (xcd - r) * q) + off; }
        const int nig = WGM * nN, gid = wgid / nig, fm = gid * WGM, gsz = (nM - fm) < WGM ? (nM - fm) : WGM;
        u.pm = fm + ((wgid % nig) % gsz); u.pn = (wgid % nig) / gsz; return true;
    }
    __device__ __forceinline__ void a_ready(const Unit&) const {}
    __device__ __forceinline__ void done(const Unit&) const {}
};
__device__ __forceinline__ unsigned cvt_pk_bf16(float lo, float hi) { unsigned r; asm volatile("v_cvt_pk_bf16_f32 %0, %1, %2" : "=v"(r) : "v"(lo), "v"(hi)); return r; }
typedef float f32x2 __attribute__((ext_vector_type(2)));
template <class Epi, class Sched, bool ALIGN_EPI = false, bool SP2 = false>
__device__ __forceinline__ void gemm_phase(PG8_LAS unsigned char* lds, const Gemm g, const Sched& S, const Epi& E, int tid_in) {
    int tid_l = tid_in; asm volatile("" : "+v"(tid_l));
    const int tid = tid_l, wid = __builtin_amdgcn_readfirstlane(tid >> 6), lane = tid & 63, wr = wid >> 2, wc = wid & 3, fr = lane & 15, fq = lane >> 4;
    const int K = g.K, nt = K / BK;
    unsigned voffA[2], voffB[2];
#pragma unroll
    for (int i = 0; i < 2; ++i) { int R, C; stage_rc(tid * 16 + i * 8192, R, C); const int Rb = Epi::PERM ? ((R & ~31) + perm32(R & 31)) : R;
        voffA[i] = (unsigned)(R * g.lda + C) * 2u; voffB[i] = (unsigned)(Rb * K + C) * 2u; }
    const size_t kstep = (size_t)(BK * 2);
    const size_t hstep = (size_t)HALF * K * 2;
    const size_t tstep = 2 * hstep;
    const size_t hstepA = (size_t)HALF * g.lda * 2, tstepA = 2 * hstepA;
    const unsigned ldsw = (unsigned)wid * 1024u;
    const int aoff = lds_byte(wr * 64 + fr, fq * 8), boff = lds_byte(wc * 32 + fr, fq * 8);
#define PG8_SA(b, h) (((b) * 2 + (h)) * HTB)
#define PG8_SB(b, h) ((4 + (b) * 2 + (h)) * HTB)
#define PG8_STAGE(bufoff, gbase, voff) do { _Pragma("unroll") for (int _i = 0; _i < 2; ++_i) \
        __builtin_amdgcn_global_load_lds((const unsigned*)((const char*)(gbase) + (voff)[_i]), (PG8_LAS unsigned*)(lds + (bufoff) + ldsw + _i * 8192), 16, 0, 0); } while (0)
#define PG8_LDA(dst, b, h) do { _Pragma("unroll") for (int m = 0; m < 4; ++m) _Pragma("unroll") for (int k = 0; k < 2; ++k) dst[m][k] = *(const PG8_LAS bf16x8*)(lds + PG8_SA(b, h) + aoff + m * 2048 + k * 1024); } while (0)
#define PG8_LDB(dst, b, h) do { _Pragma("unroll") for (int n = 0; n < 2; ++n) _Pragma("unroll") for (int k = 0; k < 2; ++k) dst[n][k] = *(const PG8_LAS bf16x8*)(lds + PG8_SB(b, h) + boff + n * 2048 + k * 1024); } while (0)
#define PG8_MMA(ai, bj, At, Bt) do { __builtin_amdgcn_s_setprio(1); _Pragma("unroll") for (int m = 0; m < 4; ++m) _Pragma("unroll") for (int n = 0; n < 2; ++n) _Pragma("unroll") for (int k = 0; k < 2; ++k) \
        acc[ai][bj][m][n] = __builtin_amdgcn_mfma_f32_16x16x32_bf16(Bt[n][k], At[m][k], acc[ai][bj][m][n], 0, 0, 0); __builtin_amdgcn_s_setprio(0); } while (0)
#define PG8_WAIT_V(n) asm volatile("s_waitcnt vmcnt(" #n ")" ::: "memory")
#define PG8_WAIT_L(n) asm volatile("s_waitcnt lgkmcnt(" #n ")" ::: "memory")
#define PG8_BAR __builtin_amdgcn_s_barrier()
#define PG8_SCHED __builtin_amdgcn_sched_barrier(0)
    Unit cur, nxt; int ui = 0;
    if (!S.next(0, cur)) return;
    f32x4 acc[2][2][4][2];
#pragma unroll
    for (int a = 0; a < 2; ++a)
#pragma unroll
        for (int b = 0; b < 2; ++b)
#pragma unroll
            for (int m = 0; m < 4; ++m)
#pragma unroll
                for (int n = 0; n < 2; ++n) acc[a][b][m][n] = (f32x4){0.f, 0.f, 0.f, 0.f};
    bf16x8 At[4][2], B0[2][2], B1[2][2];
    const char* cA = (const char*)g.A + (size_t)cur.pm * tstepA; const char* cB = (const char*)g.Bt + (size_t)cur.pn * tstep;
    S.a_ready(cur);
    if constexpr (SP2) {
        PG8_STAGE(PG8_SB(0, 0), cB, voffB); PG8_STAGE(PG8_SB(0, 1), cB + hstep, voffB); PG8_STAGE(PG8_SA(0, 0), cA, voffA); PG8_STAGE(PG8_SA(0, 1), cA + hstepA, voffA);
        if (wr == 1) PG8_BAR;
        PG8_WAIT_V(2); PG8_BAR;
        PG8_STAGE(PG8_SB(1, 0), cB + kstep, voffB); PG8_STAGE(PG8_SA(1, 0), cA + kstep, voffA); PG8_STAGE(PG8_SB(1, 1), cB + hstep + kstep, voffB);
        PG8_WAIT_V(6); PG8_BAR;
    } else {
        PG8_STAGE(PG8_SB(0, 0), cB, voffB); PG8_STAGE(PG8_SA(0, 0), cA, voffA); PG8_STAGE(PG8_SB(0, 1), cB + hstep, voffB); PG8_STAGE(PG8_SA(0, 1), cA + hstepA, voffA);
        if (wr == 1) PG8_BAR;
        PG8_WAIT_V(4); PG8_BAR;
        PG8_STAGE(PG8_SB(1, 0), cB + kstep, voffB); PG8_STAGE(PG8_SA(1, 0), cA + kstep, voffA); PG8_STAGE(PG8_SB(1, 1), cB + hstep + kstep, voffB);
        PG8_WAIT_V(6); PG8_BAR;
    }
    for (;;) {
        const bool has_next = S.next(ui + 1, nxt);
        const char* nA = has_next ? (const char*)g.A + (size_t)nxt.pm * tstepA : cA; const char* nB = has_next ? (const char*)g.Bt + (size_t)nxt.pn * tstep : cB;
        for (int t = 0; t < nt; t += 2) {
            const bool last = (t == nt - 2);
            const char* a1 = cA + (size_t)(t + 1) * kstep;
            const char* a2 = last ? nA : cA + (size_t)(t + 2) * kstep; const char* b2 = last ? nB : cB + (size_t)(t + 2) * kstep;
            const char* a3 = a2 + kstep; const char* b3 = b2 + kstep;
            if (last && has_next) S.a_ready(nxt);
            if constexpr (SP2) {
            PG8_LDB(B0, 0, 0); PG8_LDB(B1, 0, 1); PG8_SCHED; PG8_LDA(At, 0, 0); PG8_STAGE(PG8_SA(1, 1), a1 + hstepA, voffA);
            PG8_WAIT_V(8); PG8_WAIT_L(0); PG8_BAR; PG8_MMA(0, 0, At, B0); PG8_MMA(0, 1, At, B1); PG8_BAR; PG8_SCHED;
            PG8_LDA(At, 0, 1); PG8_STAGE(PG8_SB(0, 0), b2, voffB); PG8_STAGE(PG8_SB(0, 1), b2 + hstep, voffB); PG8_STAGE(PG8_SA(0, 0), a2, voffA);
            PG8_WAIT_V(8); PG8_WAIT_L(0); PG8_BAR; PG8_MMA(1, 0, At, B0); PG8_MMA(1, 1, At, B1); PG8_BAR; PG8_SCHED;
            PG8_LDB(B0, 1, 0); PG8_LDB(B1, 1, 1); PG8_SCHED; PG8_LDA(At, 1, 0); PG8_STAGE(PG8_SA(0, 1), a2 + hstepA, voffA);
            PG8_WAIT_V(8); PG8_WAIT_L(0); PG8_BAR; PG8_MMA(0, 0, At, B0); PG8_MMA(0, 1, At, B1); PG8_BAR; PG8_SCHED;
            PG8_LDA(At, 1, 1); PG8_STAGE(PG8_SB(1, 0), b3, voffB); PG8_STAGE(PG8_SB(1, 1), b3 + hstep, voffB); PG8_STAGE(PG8_SA(1, 0), a3, voffA);
            PG8_WAIT_V(8); PG8_WAIT_L(0); PG8_BAR; PG8_MMA(1, 0, At, B0); PG8_MMA(1, 1, At, B1); PG8_BAR; PG8_SCHED;
            } else {
            PG8_LDB(B0, 0, 0); PG8_SCHED; PG8_LDA(At, 0, 0); PG8_STAGE(PG8_SA(1, 1), a1 + hstepA, voffA);
            PG8_WAIT_L(8); PG8_BAR; PG8_WAIT_L(0); PG8_MMA(0, 0, At, B0); PG8_BAR; PG8_SCHED;
            PG8_LDB(B1, 0, 1); PG8_STAGE(PG8_SB(0, 0), b2, voffB);
            PG8_BAR; PG8_WAIT_L(0); PG8_MMA(0, 1, At, B1); PG8_BAR;
            PG8_LDA(At, 0, 1); PG8_STAGE(PG8_SA(0, 0), a2, voffA);
            PG8_BAR; PG8_WAIT_L(0); PG8_MMA(1, 0, At, B0); PG8_BAR; PG8_SCHED;
            PG8_STAGE(PG8_SB(0, 1), b2 + hstep, voffB);
            PG8_WAIT_V(6); PG8_BAR; PG8_MMA(1, 1, At, B1); PG8_BAR;
            PG8_LDB(B0, 1, 0); PG8_SCHED; PG8_LDA(At, 1, 0); PG8_STAGE(PG8_SA(0, 1), a2 + hstepA, voffA);
            PG8_WAIT_L(8); PG8_BAR; PG8_WAIT_L(0); PG8_MMA(0, 0, At, B0); PG8_BAR; PG8_SCHED;
            PG8_LDB(B1, 1, 1); PG8_STAGE(PG8_SB(1, 0), b3, voffB);
            PG8_BAR; PG8_WAIT_L(0); PG8_MMA(0, 1, At, B1); PG8_BAR;
            PG8_LDA(At, 1, 1); PG8_STAGE(PG8_SA(1, 0), a3, voffA);
            PG8_BAR; PG8_WAIT_L(0); PG8_MMA(1, 0, At, B0); PG8_BAR; PG8_SCHED;
            PG8_STAGE(PG8_SB(1, 1), b3 + hstep, voffB);
            PG8_WAIT_V(6); PG8_BAR; PG8_MMA(1, 1, At, B1); PG8_BAR;
            }
        }
        if constexpr (ALIGN_EPI) { if (wr == 0) PG8_BAR; }
        if constexpr (!Epi::AFTER_DRAIN) { E(acc, cur, wr, wc, fr, fq); S.done(cur); }
        if (!has_next) break;
#pragma unroll
        for (int a = 0; a < 2; ++a)
#pragma unroll
            for (int b = 0; b < 2; ++b)
#pragma unroll
                for (int m = 0; m < 4; ++m)
#pragma unroll
                    for (int n = 0; n < 2; ++n) acc[a][b][m][n] = (f32x4){0.f, 0.f, 0.f, 0.f};
        cur = nxt; cA = nA; cB = nB; ++ui;
        if constexpr (ALIGN_EPI) { if (wr == 1) PG8_BAR; }
    }
    PG8_WAIT_V(0);
    if constexpr (!ALIGN_EPI) { if (wr == 0) PG8_BAR; }
    PG8_BAR;
    if constexpr (Epi::AFTER_DRAIN) { E.fused(acc, cur, wr, wc, fr, fq, lds, wid, lane); S.done(cur); }
#undef PG8_SA
#undef PG8_SB
#undef PG8_STAGE
#undef PG8_LDA
#undef PG8_LDB
#undef PG8_MMA
#undef PG8_WAIT_V
#undef PG8_WAIT_L
#undef PG8_BAR
#undef PG8_SCHED
}
}

#define LAS __attribute__((address_space(3)))
typedef unsigned short bf16_t;
typedef short bf16x8 __attribute__((ext_vector_type(8)));
typedef float f32x4 __attribute__((ext_vector_type(4)));
typedef float f32x16 __attribute__((ext_vector_type(16)));
typedef unsigned u32x4 __attribute__((ext_vector_type(4)));
typedef unsigned u32x2 __attribute__((ext_vector_type(2)));
typedef short v4i16_t __attribute__((ext_vector_type(4)));
typedef float f32x2_t __attribute__((ext_vector_type(2)));
typedef __bf16 bf16x2_t __attribute__((ext_vector_type(2)));

constexpr int D = 1024, FF = 2816, NMOD = 9, MODW = NMOD * D;
constexpr int GM = 32768;
constexpr int ZW = 1280;
constexpr int INW = 1184;
constexpr int NWAVES = 8, NT = 512;
constexpr float EPS = 1e-6f;
constexpr float LOG2E = 1.4426950408889634f;
constexpr float LOG2_THETA = 13.287712379549449f;

constexpr size_t MiB = 1u << 20;
constexpr size_t WS_MOD = 0;
constexpr size_t MOD_BYTES = 12 * MODW * 4;
constexpr size_t WS_BAR = 768 * 1024;
constexpr size_t CTL_ZERO_BYTES = 1 * MiB;
constexpr size_t WS_WGU1 = 1 * MiB;
constexpr size_t WS_WD1 = WS_WGU1 + (size_t)5632 * 1024 * 2;
constexpr size_t WS_WGU2 = WS_WD1 + (size_t)1024 * 2816 * 2;
constexpr size_t WS_WD2 = WS_WGU2 + (size_t)5632 * 1024 * 2;
constexpr size_t WS_WIN = WS_WD2 + (size_t)1024 * 2816 * 2;
constexpr size_t WS_WUQ = WS_WIN + (size_t)1280 * 1024 * 2;
constexpr size_t WS_WUKV = WS_WUQ + (size_t)768 * 256 * 2;
constexpr size_t WS_WOUT = WS_WUKV + (size_t)1024 * 256 * 2;
constexpr size_t WS_WEND = WS_WOUT + (size_t)1024 * 1024 * 2;
static_assert(WS_WEND <= 40 * MiB, "weights region");
constexpr size_t WS_H = 40 * MiB;
constexpr size_t WS_B = 104 * MiB;
constexpr size_t WS_ACT = WS_B;
constexpr size_t WS_Z = WS_B;
constexpr size_t WS_QB = WS_Z + (size_t)GM * ZW * 2;
constexpr size_t WS_KV = WS_QB + (size_t)GM * 768 * 2;
constexpr size_t WS_KB = WS_KV + (size_t)GM * 1024 * 2;
constexpr size_t WS_XB = WS_KB + (size_t)GM * 768 * 2;
constexpr size_t WS_END = WS_XB + (size_t)GM * D * 2;
static_assert(WS_END <= 420 * MiB && WS_ACT + (size_t)GM * FF * 2 <= WS_XB, "ws map");

constexpr int LDS_BYTES = 131072 + 4096;

__device__ __forceinline__ unsigned f2bf(float f) { unsigned u = __builtin_bit_cast(unsigned, f); return (u + 0x7fffu + ((u >> 16) & 1u)) >> 16; }
__device__ __forceinline__ unsigned pk2(float lo, float hi) { f32x2_t v = {lo, hi}; bf16x2_t b = __builtin_convertvector(v, bf16x2_t); return __builtin_bit_cast(unsigned, b); }
__device__ __forceinline__ float bf2f(unsigned short b) { return __builtin_bit_cast(float, (unsigned)b << 16); }
__device__ __forceinline__ float bflo(unsigned w) { return __builtin_bit_cast(float, w << 16); }
__device__ __forceinline__ float bfhi(unsigned w) { return __builtin_bit_cast(float, w & 0xffff0000u); }
template <int M> __device__ __forceinline__ float swz_xor(float v) { return __builtin_bit_cast(float, __builtin_amdgcn_ds_swizzle(__builtin_bit_cast(int, v), (M << 10) | 0x1f)); }
__device__ __forceinline__ float half_sum(float v) { v += swz_xor<1>(v); v += swz_xor<2>(v); v += swz_xor<4>(v); v += swz_xor<8>(v); v += swz_xor<16>(v); return v; }
__device__ __forceinline__ void xhalf_pair(float v, float& lo, float& hi) { unsigned a = __builtin_bit_cast(unsigned, v), b = a;
    asm volatile("s_nop 1\n\tv_permlane32_swap_b32 %0, %1\n\ts_nop 1" : "+v"(a), "+v"(b)); lo = __builtin_bit_cast(float, a); hi = __builtin_bit_cast(float, b); }
__device__ __forceinline__ float xhalf_sum(float v) { float lo, hi; xhalf_pair(v, lo, hi); return lo + hi; }
__device__ __forceinline__ float xhalf_max(float v) { float lo, hi; xhalf_pair(v, lo, hi); return fmaxf(lo, hi); }
__device__ __forceinline__ float wave_sum(float v) { return xhalf_sum(half_sum(v)); }

namespace pg8 {
struct EpiPlain {
    static constexpr bool PERM = true, AFTER_DRAIN = false;
    bf16_t* O; int ldc;
    __device__ __forceinline__ void operator()(const f32x4 (&acc)[2][2][4][2], const Unit& u, int wr, int wc, int fr, int fq) const {
        const int row0 = u.pm * BM + wr * 64 + fr, col0 = u.pn * BM + wc * 32 + 8 * fq;
#pragma unroll
        for (int ai = 0; ai < 2; ++ai)
#pragma unroll
            for (int m = 0; m < 4; ++m) { bf16_t* rowp = O + (size_t)(row0 + ai * HALF + m * 16) * ldc + col0;
#pragma unroll
                for (int bj = 0; bj < 2; ++bj) { const f32x4 v0 = acc[ai][bj][m][0], v1 = acc[ai][bj][m][1];
                    u32x4 w; w.x = pk2(v0[0], v0[1]); w.y = pk2(v0[2], v0[3]); w.z = pk2(v1[0], v1[1]); w.w = pk2(v1[2], v1[3]);
                    *(u32x4*)(rowp + bj * HALF) = w; } }
    }
};
__device__ __forceinline__ float silu_mul(float g, float u) { return g * u * __builtin_amdgcn_rcpf(1.0f + __builtin_amdgcn_exp2f(-g * LOG2E)); }
struct EpiSwiGLU {
    static constexpr bool PERM = true, AFTER_DRAIN = false;
    bf16_t* O; int ldc;
    __device__ __forceinline__ void operator()(const f32x4 (&acc)[2][2][4][2], const Unit& u, int wr, int wc, int fr, int fq) const {
        const int row0 = u.pm * BM + wr * 64 + fr, col0 = u.pn * HALF + wc * 32 + 8 * fq;
#pragma unroll
        for (int ai = 0; ai < 2; ++ai)
#pragma unroll
            for (int m = 0; m < 4; ++m) { bf16_t* rowp = O + (size_t)(row0 + ai * HALF + m * 16) * ldc + col0;
                const f32x4 g0 = acc[ai][0][m][0], g1 = acc[ai][0][m][1], u0 = acc[ai][1][m][0], u1 = acc[ai][1][m][1];
                u32x4 w; w.x = pk2(silu_mul(g0[0], u0[0]), silu_mul(g0[1], u0[1])); w.y = pk2(silu_mul(g0[2], u0[2]), silu_mul(g0[3], u0[3]));
                w.z = pk2(silu_mul(g1[0], u1[0]), silu_mul(g1[1], u1[1])); w.w = pk2(silu_mul(g1[2], u1[2]), silu_mul(g1[3], u1[3]));
                *(u32x4*)rowp = w; }
    }
};
template <bool BASE_F32> struct EpiResid {
    static constexpr bool PERM = true, AFTER_DRAIN = false;
    const void* base; bf16_t* out; const float* gate  ; int seq_shift  ; float scale;
    __device__ __forceinline__ void operator()(const f32x4 (&acc)[2][2][4][2], const Unit& u, int wr, int wc, int fr, int fq) const {
        const int row0 = u.pm * BM + wr * 64 + fr, col0 = u.pn * BM + wc * 32 + 8 * fq;
        const float* gp = gate + (size_t)((u.pm * BM) >> seq_shift) * MODW + col0;
#pragma unroll
        for (int bj = 0; bj < 2; ++bj) { const f32x4 g0 = *(const f32x4*)(gp + bj * HALF) * scale, g1 = *(const f32x4*)(gp + bj * HALF + 4) * scale;
#pragma unroll
            for (int ai = 0; ai < 2; ++ai)
#pragma unroll
                for (int m = 0; m < 4; ++m) { const size_t off = (size_t)(row0 + ai * HALF + m * 16) * D + col0 + bj * HALF;
                    f32x4 b0, b1;
                    if (BASE_F32) { b0 = *(const f32x4*)((const float*)base + off); b1 = *(const f32x4*)((const float*)base + off + 4); }
                    else { const u32x4 w = *(const u32x4*)((const bf16_t*)base + off); b0 = (f32x4){bflo(w.x), bfhi(w.x), bflo(w.y), bfhi(w.y)}; b1 = (f32x4){bflo(w.z), bfhi(w.z), bflo(w.w), bfhi(w.w)}; }
                    const f32x4 v0 = b0 + g0 * acc[ai][bj][m][0], v1 = b1 + g1 * acc[ai][bj][m][1];
                    u32x4 o; o.x = pk2(v0[0], v0[1]); o.y = pk2(v0[2], v0[3]); o.z = pk2(v1[0], v1[1]); o.w = pk2(v1[2], v1[3]);
                    *(u32x4*)(out + off) = o; } }
    }
};
}

struct Args { const float* in[27]; float* out; unsigned char* ws; };

__device__ __forceinline__ void transpose_item(const float* W, int K, int N, bf16_t* WT, int mode, LAS float* scr, int item, int lane) {
    const int nblk = N / 32, kb = item / nblk, nb = item % nblk, k0 = 64 * kb, n0 = 32 * nb;
    int d0 = n0;
    if (mode == 1) d0 = (n0 >> 7) * 256 + (n0 & 127);
    else if (mode == 2) d0 = (n0 >> 7) * 256 + 128 + (n0 & 127);
#pragma unroll 8
    for (int i = 0; i < 32; ++i) { const int kk = 2 * i + (lane >> 5); scr[kk * 33 + (lane & 31)] = W[(size_t)(k0 + kk) * N + n0 + (lane & 31)]; }
    asm volatile("s_waitcnt lgkmcnt(0)" ::: "memory");
    const int c = lane & 7;
#pragma unroll
    for (int j = 0; j < 4; ++j) { const int n = (lane >> 3) + 8 * j; const LAS float* s = scr + (8 * c) * 33 + n;
        u32x4 o; o.x = pk2(s[0 * 33], s[1 * 33]); o.y = pk2(s[2 * 33], s[3 * 33]); o.z = pk2(s[4 * 33], s[5 * 33]); o.w = pk2(s[6 * 33], s[7 * 33]);
        *(u32x4*)(WT + (size_t)(d0 + n) * K + k0 + 8 * c) = o; }
    asm volatile("s_waitcnt lgkmcnt(0)" ::: "memory");
}

typedef const Args __attribute__((address_space(4)))* KArgs0;
__device__ __forceinline__ void phase0(KArgs0 ap, LAS unsigned char* lds, int tid, int wave, int lane) {
    unsigned char* ws = ap->ws;
    {
        LAS float* scr = (LAS float*)(lds + wave * 8704);
        const int gw = blockIdx.x * NWAVES + wave, NGW = gridDim.x * NWAVES;
        constexpr int I_G = (D / 64) * (FF / 32), I_D = (FF / 64) * (D / 32), I_IN = (D / 64) * (INW / 32), I_UQ = (256 / 64) * (768 / 32), I_UKV = (128 / 64) * (1024 / 32), I_OUT = (D / 64) * (D / 32);
        constexpr int NITEMS = 4 * I_G + 2 * I_D + I_IN + I_UQ + I_UKV + I_OUT;
        for (int it = gw; it < NITEMS; it += NGW) {
            int r = it;
            if (r < I_G) { transpose_item(ap->in[7], D, FF, (bf16_t*)(ws + WS_WGU1), 1, scr, r, lane); continue; } r -= I_G;
            if (r < I_G) { transpose_item(ap->in[8], D, FF, (bf16_t*)(ws + WS_WGU1), 2, scr, r, lane); continue; } r -= I_G;
            if (r < I_D) { transpose_item(ap->in[9], FF, D, (bf16_t*)(ws + WS_WD1), 0, scr, r, lane); continue; } r -= I_D;
            if (r < I_G) { transpose_item(ap->in[23], D, FF, (bf16_t*)(ws + WS_WGU2), 1, scr, r, lane); continue; } r -= I_G;
            if (r < I_G) { transpose_item(ap->in[24], D, FF, (bf16_t*)(ws + WS_WGU2), 2, scr, r, lane); continue; } r -= I_G;
            if (r < I_D) { transpose_item(ap->in[25], FF, D, (bf16_t*)(ws + WS_WD2), 0, scr, r, lane); continue; } r -= I_D;
            if (r < I_IN) { transpose_item(ap->in[11], D, INW, (bf16_t*)(ws + WS_WIN), 0, scr, r, lane); continue; } r -= I_IN;
            if (r < I_UQ) { transpose_item(ap->in[16], 256, 768, (bf16_t*)(ws + WS_WUQ), 0, scr, r, lane); continue; } r -= I_UQ;
            if (r < I_UKV) { transpose_item(ap->in[18], 256, 1024, (bf16_t*)(ws + WS_WUKV), 0, scr, r, lane); continue; } r -= I_UKV;
            transpose_item(ap->in[21], D, D, (bf16_t*)(ws + WS_WOUT), 0, scr, r, lane);
        }
        { for (int i = blockIdx.x * NT + tid; i < 1024 * 16; i += gridDim.x * NT) *(u32x4*)(ws + WS_WUKV + (size_t)(i >> 4) * 512 + 256 + (i & 15) * 16) = (u32x4){0u, 0u, 0u, 0u}; }
        { u32x4* p = (u32x4*)(ws + WS_WIN + (size_t)INW * D * 2); const int n16 = (ZW - INW) * D * 2 / 16;
          for (int i = blockIdx.x * NT + tid; i < n16; i += gridDim.x * NT) p[i] = (u32x4){0u, 0u, 0u, 0u}; }
    }
    __syncthreads();
    {
        LAS float* sc = (LAS float*)lds;
        float* mod = (float*)(ws + WS_MOD);
        const float* adaw = ap->in[4]; const float* adab = ap->in[5];
        for (int item = blockIdx.x; item < 18 * 16; item += gridDim.x) {
            const int cb = item % 18, kc = item / 18;
            __syncthreads();
            for (int i = tid; i < 12 * 64; i += NT) { const int s = i >> 6, kk = i & 63;
                const float c = (s < 4) ? ap->in[2][s * D + kc * 64 + kk] : ap->in[3][(s - 4) * D + kc * 64 + kk];
                sc[i] = c / (1.0f + __expf(-c)); }
            __syncthreads();
            const int col = cb * 512 + tid;
            float acc[12];
#pragma unroll
            for (int s = 0; s < 12; ++s) acc[s] = 0.f;
            const float* wp = adaw + (size_t)(kc * 64) * MODW + col;
#pragma unroll 8
            for (int kk = 0; kk < 64; ++kk) { const float w = wp[(size_t)kk * MODW];
#pragma unroll
                for (int s = 0; s < 12; ++s) acc[s] += sc[s * 64 + kk] * w; }
            const float b = (kc == 0) ? adab[col] : 0.f;
#pragma unroll
            for (int s = 0; s < 12; ++s) atomicAdd(mod + s * MODW + col, acc[s] + b);
        }
    }
}

__device__ __forceinline__ void load_row16(const float* x, int lane, float (&v)[16]) {
#pragma unroll
    for (int j = 0; j < 2; ++j) { const f32x4 a = *(const f32x4*)(x + 512 * j + 8 * lane), b = *(const f32x4*)(x + 512 * j + 8 * lane + 4);
        v[8 * j + 0] = a.x; v[8 * j + 1] = a.y; v[8 * j + 2] = a.z; v[8 * j + 3] = a.w; v[8 * j + 4] = b.x; v[8 * j + 5] = b.y; v[8 * j + 6] = b.z; v[8 * j + 7] = b.w; }
}
__device__ __forceinline__ void load_row16(const bf16_t* x, int lane, float (&v)[16]) {
#pragma unroll
    for (int j = 0; j < 2; ++j) { const u32x4 w = *(const u32x4*)(x + 512 * j + 8 * lane);
        v[8 * j + 0] = bflo(w.x); v[8 * j + 1] = bfhi(w.x); v[8 * j + 2] = bflo(w.y); v[8 * j + 3] = bfhi(w.y); v[8 * j + 4] = bflo(w.z); v[8 * j + 5] = bfhi(w.z); v[8 * j + 6] = bflo(w.w); v[8 * j + 7] = bfhi(w.w); }
}
template <class XT>
__device__ __forceinline__ void norm_mod_phase(const XT* x, const float* gain, const float* mod  , int shoff, int seq_shift, bf16_t* H, int wave, int lane) {
    const int gw = blockIdx.x * NWAVES + wave, NGW = gridDim.x * NWAVES;
    float gv[16]; load_row16(gain, lane, gv);
    for (int m = gw; m < GM; m += NGW) {
        float v[16]; load_row16(x + (size_t)m * D, lane, v);
        const float* mp = mod + (size_t)(m >> seq_shift) * MODW + shoff;
        float sh[16], sc[16]; load_row16(mp, lane, sh); load_row16(mp + D, lane, sc);
        float s = 0.f;
#pragma unroll
        for (int e = 0; e < 16; ++e) s += v[e] * v[e];
        const float rstd = 1.0f / sqrtf(wave_sum(s) * (1.0f / D) + EPS);
#pragma unroll
        for (int j = 0; j < 2; ++j) { float y[8];
#pragma unroll
            for (int e = 0; e < 8; ++e) y[e] = v[8 * j + e] * rstd * gv[8 * j + e] * (sc[8 * j + e] + 1.0f) + sh[8 * j + e];
            u32x4 w; w.x = pk2(y[0], y[1]); w.y = pk2(y[2], y[3]); w.z = pk2(y[4], y[5]); w.w = pk2(y[6], y[7]);
            *(u32x4*)(H + (size_t)m * D + 512 * j + 8 * lane) = w; }
    }
}
__device__ __forceinline__ void final_norm_phase(const bf16_t* xb, float* out, const float* gain, int wave, int lane) {
    const int gw = blockIdx.x * NWAVES + wave, NGW = gridDim.x * NWAVES;
    float gv[16]; load_row16(gain, lane, gv);
    for (int m = gw; m < GM; m += NGW) {
        float v[16]; load_row16(xb + (size_t)m * D, lane, v);
        float s = 0.f;
#pragma unroll
        for (int e = 0; e < 16; ++e) s += v[e] * v[e];
        const float rstd = 1.0f / sqrtf(wave_sum(s) * (1.0f / D) + EPS);
#pragma unroll
        for (int j = 0; j < 2; ++j) { float* o = out + (size_t)m * D + 512 * j + 8 * lane;
            *(f32x4*)o = (f32x4){v[8 * j + 0] * rstd * gv[8 * j + 0], v[8 * j + 1] * rstd * gv[8 * j + 1], v[8 * j + 2] * rstd * gv[8 * j + 2], v[8 * j + 3] * rstd * gv[8 * j + 3]};
            *(f32x4*)(o + 4) = (f32x4){v[8 * j + 4] * rstd * gv[8 * j + 4], v[8 * j + 5] * rstd * gv[8 * j + 5], v[8 * j + 6] * rstd * gv[8 * j + 6], v[8 * j + 7] * rstd * gv[8 * j + 7]}; }
    }
}

__device__ __forceinline__ float oct_sum(float v) { v += swz_xor<1>(v); v += swz_xor<2>(v); v += swz_xor<4>(v); return v; }

__device__ __forceinline__ void post1_phase(bf16_t* Z, int Smask, const float* gq, const float* gk, const float* gcq, const float* gckv, int wave, int lane) {
    const int gw = blockIdx.x * NWAVES + wave, NGW = gridDim.x * NWAVES;
    const int sub = lane & 7, hq = lane >> 3;
    float invf[4], gq0[4], gq1[4], gk0[4], gk1[4];
#pragma unroll
    for (int e = 0; e < 4; ++e) { const int i = 4 * sub + e; invf[e] = exp2f(-(float)i * (LOG2_THETA / 32.0f)); gq0[e] = gq[i]; gq1[e] = gq[i + 32]; gk0[e] = gk[i]; gk1[e] = gk[i + 32]; }
    const float gc0 = gcq[4 * lane], gc1 = gcq[4 * lane + 1], gc2 = gcq[4 * lane + 2], gc3 = gcq[4 * lane + 3];
    const float gv0 = gckv[2 * lane], gv1 = gckv[2 * lane + 1];
    const bool kact = lane < 16;
    for (int m = gw; m < GM; m += NGW) {
        bf16_t* z = Z + (size_t)m * ZW;
        u32x2* pq0 = (u32x2*)(z + hq * 64 + 4 * sub); u32x2* pq1 = (u32x2*)(z + hq * 64 + 32 + 4 * sub);
        u32x2* pk0 = (u32x2*)(z + 512 + (hq & 1) * 64 + 4 * sub); u32x2* pk1 = (u32x2*)(z + 512 + (hq & 1) * 64 + 32 + 4 * sub);
        u32x2* pc = (u32x2*)(z + 768) + lane; unsigned* pv = (unsigned*)(z + 1024) + lane;
        const u32x2 wq0 = *pq0, wq1 = *pq1, wk0 = *pk0, wk1 = *pk1, wc = *pc; const unsigned wv = *pv;
        const float pos = (float)(m & Smask);
        float sn[4], cs[4];
#pragma unroll
        for (int e = 0; e < 4; ++e) sincosf(pos * invf[e], &sn[e], &cs[e]);
        {
            const float a[4] = {bflo(wq0.x), bfhi(wq0.x), bflo(wq0.y), bfhi(wq0.y)}, b[4] = {bflo(wq1.x), bfhi(wq1.x), bflo(wq1.y), bfhi(wq1.y)};
            float ss = 0.f;
#pragma unroll
            for (int e = 0; e < 4; ++e) ss += a[e] * a[e] + b[e] * b[e];
            const float rstd = 1.0f / sqrtf(oct_sum(ss) * (1.0f / 64.0f) + EPS) * (0.125f * LOG2E);
            float o0[4], o1[4];
#pragma unroll
            for (int e = 0; e < 4; ++e) { const float y1 = a[e] * rstd * gq0[e], y2 = b[e] * rstd * gq1[e]; o0[e] = y1 * cs[e] - y2 * sn[e]; o1[e] = y2 * cs[e] + y1 * sn[e]; }
            u32x2 w; w.x = pk2(o0[0], o0[1]); w.y = pk2(o0[2], o0[3]); *pq0 = w; w.x = pk2(o1[0], o1[1]); w.y = pk2(o1[2], o1[3]); *pq1 = w;
        }
        {
            const float a[4] = {bflo(wk0.x), bfhi(wk0.x), bflo(wk0.y), bfhi(wk0.y)}, b[4] = {bflo(wk1.x), bfhi(wk1.x), bflo(wk1.y), bfhi(wk1.y)};
            float ss = 0.f;
#pragma unroll
            for (int e = 0; e < 4; ++e) ss += a[e] * a[e] + b[e] * b[e];
            const float rstd = 1.0f / sqrtf(oct_sum(ss) * (1.0f / 64.0f) + EPS);
            float o0[4], o1[4];
#pragma unroll
            for (int e = 0; e < 4; ++e) { const float y1 = a[e] * rstd * gk0[e], y2 = b[e] * rstd * gk1[e]; o0[e] = y1 * cs[e] - y2 * sn[e]; o1[e] = y2 * cs[e] + y1 * sn[e]; }
            if (kact) { u32x2 w; w.x = pk2(o0[0], o0[1]); w.y = pk2(o0[2], o0[3]); *pk0 = w; w.x = pk2(o1[0], o1[1]); w.y = pk2(o1[2], o1[3]); *pk1 = w; }
        }
        {
            const float a0 = bflo(wc.x), a1 = bfhi(wc.x), a2 = bflo(wc.y), a3 = bfhi(wc.y);
            const float rstd = 1.0f / sqrtf(wave_sum((a0 * a0 + a1 * a1) + (a2 * a2 + a3 * a3)) * (1.0f / 256.0f) + EPS);
            u32x2 o; o.x = pk2(a0 * rstd * gc0, a1 * rstd * gc1); o.y = pk2(a2 * rstd * gc2, a3 * rstd * gc3); *pc = o;
        }
        {
            const float a0 = bflo(wv), a1 = bfhi(wv);
            const float rstd = 1.0f / sqrtf(wave_sum(a0 * a0 + a1 * a1) * (1.0f / 128.0f) + EPS);
            *pv = pk2(a0 * rstd * gv0, a1 * rstd * gv1);
        }
    }
}

__device__ __forceinline__ void post2_phase(bf16_t* QB, const bf16_t* KV, const bf16_t* Z, bf16_t* KB, int Smask, const float* gq, const float* gk, int wave, int lane) {
    const int gw = blockIdx.x * NWAVES + wave, NGW = gridDim.x * NWAVES;
    const int sub = lane & 7, h = lane >> 3;
    float gqn[8], gkn[8], gqr[4], gkr[4], invf[2];
#pragma unroll
    for (int e = 0; e < 8; ++e) { gqn[e] = gq[8 * sub + e]; gkn[e] = gk[8 * sub + e]; }
#pragma unroll
    for (int e = 0; e < 2; ++e) { const int i = 2 * sub + e; invf[e] = exp2f(-(float)i * (LOG2_THETA / 16.0f)); gqr[e] = gq[64 + i]; gqr[2 + e] = gq[80 + i]; gkr[e] = gk[64 + i]; gkr[2 + e] = gk[80 + i]; }
    const float qscl = 0.10206207261596577f * LOG2E;
    for (int m = gw; m < GM; m += NGW) {
        bf16_t* q = QB + (size_t)m * 768 + h * 96; const bf16_t* kv = KV + (size_t)m * 1024 + h * 128; bf16_t* kb = KB + (size_t)m * 768 + h * 96;
        const bf16_t* kr = Z + (size_t)m * ZW + 1152;
        const u32x4 wq = *(const u32x4*)(q + 8 * sub); const unsigned wqa = *(const unsigned*)(q + 64 + 2 * sub), wqb = *(const unsigned*)(q + 80 + 2 * sub);
        const u32x4 wk = *(const u32x4*)(kv + 8 * sub); const unsigned wka = *(const unsigned*)(kr + 2 * sub), wkb = *(const unsigned*)(kr + 16 + 2 * sub);
        const float pos = (float)(m & Smask);
        float sn[2], cs[2];
#pragma unroll
        for (int e = 0; e < 2; ++e) sincosf(pos * invf[e], &sn[e], &cs[e]);
        {
            const float n[8] = {bflo(wq.x), bfhi(wq.x), bflo(wq.y), bfhi(wq.y), bflo(wq.z), bfhi(wq.z), bflo(wq.w), bfhi(wq.w)};
            const float r0[2] = {bflo(wqa), bfhi(wqa)}, r1[2] = {bflo(wqb), bfhi(wqb)};
            float ss = r0[0] * r0[0] + r0[1] * r0[1] + r1[0] * r1[0] + r1[1] * r1[1];
#pragma unroll
            for (int e = 0; e < 8; ++e) ss += n[e] * n[e];
            const float rstd = 1.0f / sqrtf(oct_sum(ss) * (1.0f / 96.0f) + EPS) * qscl;
            u32x4 o; o.x = pk2(n[0] * rstd * gqn[0], n[1] * rstd * gqn[1]); o.y = pk2(n[2] * rstd * gqn[2], n[3] * rstd * gqn[3]);
            o.z = pk2(n[4] * rstd * gqn[4], n[5] * rstd * gqn[5]); o.w = pk2(n[6] * rstd * gqn[6], n[7] * rstd * gqn[7]);
            float a[2], b[2];
#pragma unroll
            for (int e = 0; e < 2; ++e) { const float y0 = r0[e] * rstd * gqr[e], y1 = r1[e] * rstd * gqr[2 + e]; a[e] = y0 * cs[e] - y1 * sn[e]; b[e] = y1 * cs[e] + y0 * sn[e]; }
            *(u32x4*)(q + 8 * sub) = o; *(unsigned*)(q + 64 + 2 * sub) = pk2(a[0], a[1]); *(unsigned*)(q + 80 + 2 * sub) = pk2(b[0], b[1]);
        }
        {
            const float n[8] = {bflo(wk.x), bfhi(wk.x), bflo(wk.y), bfhi(wk.y), bflo(wk.z), bfhi(wk.z), bflo(wk.w), bfhi(wk.w)};
            const float r0[2] = {bflo(wka), bfhi(wka)}, r1[2] = {bflo(wkb), bfhi(wkb)};
            float ss = r0[0] * r0[0] + r0[1] * r0[1] + r1[0] * r1[0] + r1[1] * r1[1];
#pragma unroll
            for (int e = 0; e < 8; ++e) ss += n[e] * n[e];
            const float rstd = 1.0f / sqrtf(oct_sum(ss) * (1.0f / 96.0f) + EPS);
            u32x4 o; o.x = pk2(n[0] * rstd * gkn[0], n[1] * rstd * gkn[1]); o.y = pk2(n[2] * rstd * gkn[2], n[3] * rstd * gkn[3]);
            o.z = pk2(n[4] * rstd * gkn[4], n[5] * rstd * gkn[5]); o.w = pk2(n[6] * rstd * gkn[6], n[7] * rstd * gkn[7]);
            float a[2], b[2];
#pragma unroll
            for (int e = 0; e < 2; ++e) { const float y0 = r0[e] * rstd * gkr[e], y1 = r1[e] * rstd * gkr[2 + e]; a[e] = y0 * cs[e] - y1 * sn[e]; b[e] = y1 * cs[e] + y0 * sn[e]; }
            *(u32x4*)(kb + 8 * sub) = o; *(unsigned*)(kb + 64 + 2 * sub) = pk2(a[0], a[1]); *(unsigned*)(kb + 80 + 2 * sub) = pk2(b[0], b[1]);
        }
    }
}

#define XB_TMO      128
#define XB_XCNT(j)  (256  + 64 * (j))
#define XB_XSUB(j)  (1280 + 64 * (j))
#define XB_XGEN(j)  (2304 + 64 * (j))
#define XB_TOP      3328
#define XB_TOPGEN   3392
#define XCD_BAR_WORDS 3456
#define XB_SPIN_CAP (1u << 22)

__device__ __forceinline__ unsigned xb_ld(unsigned* p)              { return __hip_atomic_load(p, __ATOMIC_RELAXED, __HIP_MEMORY_SCOPE_AGENT); }
__device__ __forceinline__ unsigned xb_add(unsigned* p, unsigned v) { return __hip_atomic_fetch_add(p, v, __ATOMIC_RELAXED, __HIP_MEMORY_SCOPE_AGENT); }
__device__ __forceinline__ unsigned xb_xcc_id() { return (unsigned)__builtin_amdgcn_s_getreg((3 << 11) | 20) & 0xFu; }
#define XB_SPIN(cond, bar) do { unsigned _sp = 0; while (cond) { __builtin_amdgcn_s_sleep(1); \
    if ((++_sp & 255u) == 0u) { if (xb_ld(&(bar)[XB_TMO])) break; if (_sp > XB_SPIN_CAP) { atomicAdd(&(bar)[XB_TMO], 1u); break; } } } } while (0)

struct XcdBarrier {
    unsigned* bar; unsigned x;
    volatile LAS unsigned* st;
};

__device__ __forceinline__ XcdBarrier xcd_barrier_post(unsigned* bar, volatile LAS unsigned* st, bool leader) {
    XcdBarrier b; b.bar = bar; b.x = xb_xcc_id(); b.st = st;
    if (leader) (void)xb_add(&bar[XB_XCNT(b.x)], 1u);
    return b;
}
__device__ __forceinline__ void xcd_barrier_complete(unsigned* bar, unsigned x, unsigned& nloc, unsigned& nx) {
    const unsigned G = gridDim.x * gridDim.y * gridDim.z;
    unsigned sum, cnt, mine, sp = 0u;
    for (;;) {
        sum = 0u; cnt = 0u; mine = 0u;
#pragma unroll
        for (unsigned j = 0; j < 16; ++j) { const unsigned c = xb_ld(&bar[XB_XCNT(j)]); sum += c; cnt += (c > 0u) ? 1u : 0u; mine = (j == x) ? c : mine; }
        if (sum == G) break;
        __builtin_amdgcn_s_sleep(1);
        if ((++sp & 255u) == 0u) { if (xb_ld(&bar[XB_TMO])) break; if (sp > XB_SPIN_CAP) { atomicAdd(&bar[XB_TMO], 1u); break; } }
    }
    nloc = mine > 0u ? mine : 1u; nx = cnt > 0u ? cnt : 1u;
}

__device__ __forceinline__ void xcd_barrier(const XcdBarrier& b, bool leader) {
    asm volatile("s_waitcnt vmcnt(0)" ::: "memory");
    __syncthreads();
    if (leader) {
        unsigned* bar = b.bar;
        __builtin_amdgcn_s_waitcnt(0);
        unsigned nloc = b.st[0], nx = b.st[1];
        if (nloc == 0u) { xcd_barrier_complete(bar, b.x, nloc, nx); b.st[0] = nloc; b.st[1] = nx; }
        const unsigned old = xb_add(&bar[XB_XSUB(b.x)], 1u);
        const unsigned gen = old / nloc;
        if (old + 1u == (gen + 1u) * nloc) {
            __builtin_amdgcn_fence(__ATOMIC_RELEASE, "agent");
            asm volatile("s_waitcnt vmcnt(0)" ::: "memory");
            const unsigned og = xb_add(&bar[XB_TOP], 1u);
            const unsigned tg = og / nx;
            if (og + 1u == (tg + 1u) * nx) xb_add(&bar[XB_TOPGEN], 1u);
            else XB_SPIN(xb_ld(&bar[XB_TOPGEN]) == tg, bar);
            __builtin_amdgcn_fence(__ATOMIC_ACQUIRE, "agent");
            xb_add(&bar[XB_XGEN(b.x)], 1u);
            asm volatile("s_waitcnt vmcnt(0)" ::: "memory");
        } else {
            XB_SPIN(xb_ld(&bar[XB_XGEN(b.x)]) == gen, bar);
            __builtin_amdgcn_fence(__ATOMIC_ACQUIRE, "agent");
            asm volatile("s_waitcnt vmcnt(0)" ::: "memory");
        }
    }
    __syncthreads();
}

__device__ __forceinline__ int crow(int r, int hi) { return (r & 3) + 8 * (r >> 2) + 4 * hi; }
#define MFMA32(a, b, c) __builtin_amdgcn_mfma_f32_32x32x16_bf16((a), (b), (c), 0, 0, 0)
constexpr int ATT_VP = 192;
template <int DQ> struct AttnCfg { static constexpr int KP = DQ * 2 + 16, KBUF = 64 * KP, VBUF = 64 * ATT_VP, CPR = DQ / 8, NKCH = 64 * CPR; };

template <int DQ, bool SWA>
__device__ __forceinline__ void attn_unit(const bf16_t* Qp, int ldq, const bf16_t* Kp, int ldk, const bf16_t* Vp, int ldv, bf16_t* Op, int ldo,
                                          int S, int q0, float sink_l2, LAS unsigned char* lds, int tid, int wave, int lane) {
    typedef AttnCfg<DQ> C;
    constexpr int NKS = DQ / 16;
    LAS unsigned char* Kb = lds;
    LAS unsigned char* Vb = lds + 2 * C::KBUF;
    LAS float* scr = (LAS float*)(lds + 2 * C::KBUF + 2 * C::VBUF) + wave * 64;
    const int r = lane & 31, h = lane >> 5;
    const int qw = q0 + wave * 32;
    bf16x8 qf[NKS];
#pragma unroll
    for (int ks = 0; ks < NKS; ++ks) qf[ks] = *(const bf16x8*)(Qp + (size_t)(qw + r) * ldq + 16 * ks + 8 * h);
    int t_lo = 0, t_hi = S / 64;
    if (SWA) { const int lo = q0 - 128 < 0 ? 0 : q0 - 128, hi = q0 + 384 > S ? S : q0 + 384; t_lo = lo / 64; t_hi = hi / 64; }
    const int vrow = tid >> 3, vch = tid & 7;
    const int k0row = tid / C::CPR, k0ch = tid % C::CPR;
    const int k1idx = tid + 512; const bool k1on = k1idx < C::NKCH; const int k1row = k1idx / C::CPR, k1ch = k1idx % C::CPR;
    u32x4 rvA, rk0A, rk1A = (u32x4){0u, 0u, 0u, 0u};
    const unsigned vofs = (unsigned)(vrow * ldv + vch * 8), k0ofs = (unsigned)(k0row * ldk + k0ch * 8), k1ofs = (unsigned)(k1row * ldk + k1ch * 8);
#define ATT_GLOAD(X, t) do { const bf16_t* Vt_ = Vp + (size_t)(t) * 64 * ldv; const bf16_t* Kt_ = Kp + (size_t)(t) * 64 * ldk; \
        rv##X = *(const u32x4*)(Vt_ + vofs); \
        rk0##X = *(const u32x4*)(Kt_ + k0ofs); \
        if (k1on) rk1##X = *(const u32x4*)(Kt_ + k1ofs); } while (0)
#define ATT_LSTORE(X, b) do { *(LAS u32x4*)(Vb + (b) * C::VBUF + vrow * ATT_VP + vch * 16) = rv##X; \
        *(LAS u32x4*)(Kb + (b) * C::KBUF + k0row * C::KP + k0ch * 16) = rk0##X; \
        if (k1on) *(LAS u32x4*)(Kb + (b) * C::KBUF + k1row * C::KP + k1ch * 16) = rk1##X; } while (0)
    float mref = SWA ? sink_l2 : 0.0f;
    f32x16 o0, o1, o2, negm;
#pragma unroll
    for (int i = 0; i < 16; ++i) { o0[i] = 0.f; o1[i] = 0.f; o2[i] = 0.f; negm[i] = -mref; }
    const bf16x8 ones = (bf16x8){0x3F80, 0x3F80, 0x3F80, 0x3F80, 0x3F80, 0x3F80, 0x3F80, 0x3F80};
    const int koff = r * C::KP + 16 * h;
    const int voff = (4 * h + ((lane & 15) >> 2)) * ATT_VP + ((lane >> 4) & 1) * 32 + (lane & 3) * 8;
    ATT_GLOAD(A, t_lo); ATT_LSTORE(A, 0);
    if (t_lo + 1 < t_hi) ATT_GLOAD(A, t_lo + 1);
    __syncthreads();
    auto step = [&](const int t, const int cur, u32x4& rvX, u32x4& rk0X, u32x4& rk1X) __attribute__((always_inline)) {
        bool need = true;
        if (SWA) need = (64 * t + 63 >= qw - 128) && (64 * t <= qw + 31 + 128);
        if (need) {
            const LAS unsigned char* kb = Kb + cur * C::KBUF + koff;
            bf16x8 ka[NKS], kc[NKS];
#pragma unroll
            for (int ks = 0; ks < NKS; ++ks) { ka[ks] = *(const LAS bf16x8*)(kb + ks * 32); kc[ks] = *(const LAS bf16x8*)(kb + 32 * C::KP + ks * 32); }
            __builtin_amdgcn_sched_barrier(0);
            f32x16 p0 = negm, p1 = negm;
#pragma unroll
            for (int ks = 0; ks < NKS; ++ks) { p0 = MFMA32(ka[ks], qf[ks], p0); p1 = MFMA32(kc[ks], qf[ks], p1); }
            __builtin_amdgcn_sched_barrier(0);
            const LAS unsigned char* vb = Vb + cur * C::VBUF + voff;
            v4i16_t vl0[4], vh0[4], vl1[4], vh1[4];
#pragma unroll
            for (int s = 0; s < 4; ++s) {
                vl0[s] = __builtin_amdgcn_ds_read_tr16_b64_v4i16((LAS v4i16_t*)(vb + (16 * s) * ATT_VP));
                vh0[s] = __builtin_amdgcn_ds_read_tr16_b64_v4i16((LAS v4i16_t*)(vb + (16 * s + 8) * ATT_VP));
                vl1[s] = __builtin_amdgcn_ds_read_tr16_b64_v4i16((LAS v4i16_t*)(vb + (16 * s) * ATT_VP + 64));
                vh1[s] = __builtin_amdgcn_ds_read_tr16_b64_v4i16((LAS v4i16_t*)(vb + (16 * s + 8) * ATT_VP + 64));
            }
            __builtin_amdgcn_sched_barrier(0);
            if (SWA) {
                const int qpos = qw + r, kb0 = 64 * t + 4 * h;
#pragma unroll
                for (int i = 0; i < 16; ++i) { const int kp = kb0 + (i & 3) + 8 * (i >> 2); const int d0_ = kp - qpos, d1_ = d0_ + 32;
                    if (d0_ > 128 || d0_ < -128) p0[i] = -1e30f; if (d1_ > 128 || d1_ < -128) p1[i] = -1e30f; }
            }
            float mx = fmaxf(p0[0], p1[0]);
#pragma unroll
            for (int i = 1; i < 16; ++i) mx = fmaxf(mx, fmaxf(p0[i], p1[i]));
            mx = xhalf_max(mx);
            if (__any(mx > 8.0f)) {
                const float dl = fmaxf(mx, 0.0f), alpha = __builtin_amdgcn_exp2f(-dl);
                mref += dl;
#pragma unroll
                for (int i = 0; i < 16; ++i) { p0[i] -= dl; p1[i] -= dl; negm[i] = -mref; }
                if (h == 0) scr[r] = alpha;
                asm volatile("s_waitcnt lgkmcnt(0)" ::: "memory");
#pragma unroll
                for (int g = 0; g < 4; ++g) { const f32x4 av = *(const LAS f32x4*)(scr + 8 * g + 4 * h);
#pragma unroll
                    for (int j = 0; j < 4; ++j) { o0[4 * g + j] *= av[j]; o1[4 * g + j] *= av[j]; o2[4 * g + j] *= av[j]; } }
                asm volatile("s_waitcnt lgkmcnt(0)" ::: "memory");
            }
#pragma unroll
            for (int i = 0; i < 16; ++i) { p0[i] = __builtin_amdgcn_exp2f(p0[i]); p1[i] = __builtin_amdgcn_exp2f(p1[i]); }
            bf16x8 pf[4];
#pragma unroll
            for (int s2 = 0; s2 < 2; ++s2) {
                u32x4 w0, w1;
                w0.x = pk2(p0[8 * s2 + 0], p0[8 * s2 + 1]); w0.y = pk2(p0[8 * s2 + 2], p0[8 * s2 + 3]); w0.z = pk2(p0[8 * s2 + 4], p0[8 * s2 + 5]); w0.w = pk2(p0[8 * s2 + 6], p0[8 * s2 + 7]);
                w1.x = pk2(p1[8 * s2 + 0], p1[8 * s2 + 1]); w1.y = pk2(p1[8 * s2 + 2], p1[8 * s2 + 3]); w1.z = pk2(p1[8 * s2 + 4], p1[8 * s2 + 5]); w1.w = pk2(p1[8 * s2 + 6], p1[8 * s2 + 7]);
                pf[s2] = __builtin_bit_cast(bf16x8, w0); pf[2 + s2] = __builtin_bit_cast(bf16x8, w1);
            }
            __builtin_amdgcn_sched_barrier(0);
#pragma unroll
            for (int s = 0; s < 4; ++s) {
                const bf16x8 v0 = (bf16x8){vl0[s][0], vl0[s][1], vl0[s][2], vl0[s][3], vh0[s][0], vh0[s][1], vh0[s][2], vh0[s][3]};
                const bf16x8 v1 = (bf16x8){vl1[s][0], vl1[s][1], vl1[s][2], vl1[s][3], vh1[s][0], vh1[s][1], vh1[s][2], vh1[s][3]};
                o0 = MFMA32(pf[s], v0, o0);
                o1 = MFMA32(pf[s], v1, o1);
                o2 = MFMA32(pf[s], ones, o2);
            }
        }
        if (t + 1 < t_hi) { *(LAS u32x4*)(Vb + (cur ^ 1) * C::VBUF + vrow * ATT_VP + vch * 16) = rvX;
            *(LAS u32x4*)(Kb + (cur ^ 1) * C::KBUF + k0row * C::KP + k0ch * 16) = rk0X;
            if (k1on) *(LAS u32x4*)(Kb + (cur ^ 1) * C::KBUF + k1row * C::KP + k1ch * 16) = rk1X; }
        if (t + 2 < t_hi) { const bf16_t* Vt_ = Vp + (size_t)(t + 2) * 64 * ldv; const bf16_t* Kt_ = Kp + (size_t)(t + 2) * 64 * ldk;
            rvX = *(const u32x4*)(Vt_ + vofs);
            rk0X = *(const u32x4*)(Kt_ + k0ofs);
            if (k1on) rk1X = *(const u32x4*)(Kt_ + k1ofs); }
        __syncthreads();
    };
    for (int t = t_lo; t < t_hi; t += 2) { step(t, 0, rvA, rk0A, rk1A); step(t + 1, 1, rvA, rk0A, rk1A); }
    if (SWA) { if (h == 0) scr[r] = __builtin_amdgcn_exp2f(sink_l2 - mref); asm volatile("s_waitcnt lgkmcnt(0)" ::: "memory"); }
#pragma unroll
    for (int g = 0; g < 4; ++g) { f32x4 sv = (f32x4){0.f, 0.f, 0.f, 0.f}; if (SWA) sv = *(const LAS f32x4*)(scr + 8 * g + 4 * h);
#pragma unroll
        for (int j = 0; j < 4; ++j) { const int q = qw + 8 * g + 4 * h + j; bf16_t* op = Op + (size_t)q * ldo + r; const float rl = 1.0f / (o2[4 * g + j] + sv[j]);
            op[0] = (bf16_t)f2bf(o0[4 * g + j] * rl); op[32] = (bf16_t)f2bf(o1[4 * g + j] * rl); } }
    asm volatile("s_waitcnt lgkmcnt(0)" ::: "memory");
#undef ATT_GLOAD
#undef ATT_LSTORE
}

template <class Epi>
__device__ __forceinline__ void run_gemm(LAS unsigned char* lds, const bf16_t* A, int lda, const bf16_t* Bt, int N, int K, const Epi& E, int tid) {
    int bx = (int)blockIdx.x; asm volatile("" : "+s"(bx), "+s"(A), "+s"(Bt));
    pg8::Gemm g{A, Bt, GM, N, K, lda}; pg8::StaticOrder S; S.init(GM, N, (int)gridDim.x, bx);
    pg8::gemm_phase<Epi, pg8::StaticOrder, true, true>(lds, g, S, E, tid);
}

typedef const Args __attribute__((address_space(4)))* KArgs;
#define PHASE_BEGIN() KArgs ap = (KArgs)__builtin_amdgcn_kernarg_segment_ptr(); asm volatile("" : "+s"(ap)); \
    unsigned char* ws = ap->ws; (void)ws; \
    int lane; asm volatile("v_mbcnt_lo_u32_b32 %0, -1, 0\n\tv_mbcnt_hi_u32_b32 %0, -1, %0" : "=v"(lane)); const int wave = wave_s, tid = wave_s * 64 + lane; (void)tid; \
    const float* xin = ap->in[g]; (void)xin; float* out = ap->out + (size_t)g * GM * D; (void)out; \
    const float* mod = (const float*)(ws + WS_MOD) + (size_t)(g ? 4 : 0) * MODW; (void)mod; \
    const int S = g ? 4096 : 8192, seq_shift = g ? 12 : 13, nseq = g ? 8 : 4; (void)S; (void)seq_shift; (void)nseq
#define WSP(off) ((bf16_t*)(ws + (off)))

__global__ void __launch_bounds__(NT, 2) fwd_kernel(Args a) {
    extern __shared__ __attribute__((aligned(16))) unsigned char lds_raw[];
    cg::grid_group grid = cg::this_grid();
    LAS unsigned char* lds = (LAS unsigned char*)lds_raw;
    const int wave_s = __builtin_amdgcn_readfirstlane((int)threadIdx.x >> 6);
    volatile LAS unsigned* bar_st = (volatile LAS unsigned*)(lds + 131072);
    if (threadIdx.x < 2) bar_st[threadIdx.x] = 0u;
    __syncthreads();
    { const int g = 0; PHASE_BEGIN(); (void)xcd_barrier_post((unsigned*)(ws + WS_BAR), bar_st, tid == 0); phase0(ap, lds, tid, wave, lane); }
    grid.sync();
#define SEAM() do { const int g = 0; PHASE_BEGIN(); XcdBarrier b_; b_.bar = (unsigned*)(ws + WS_BAR); b_.x = xb_xcc_id(); b_.st = bar_st; xcd_barrier(b_, tid == 0); } while (0)

    for (int g = 0; g < 2; ++g) {
        { PHASE_BEGIN(); norm_mod_phase(xin, ap->in[6], mod, 0, seq_shift, WSP(WS_H), wave, lane); }
        SEAM();
        { PHASE_BEGIN(); run_gemm(lds, WSP(WS_H), D, WSP(WS_WGU1), 2 * FF, D, pg8::EpiSwiGLU{WSP(WS_ACT), FF}, tid); }
        SEAM();
        { PHASE_BEGIN(); run_gemm(lds, WSP(WS_ACT), FF, WSP(WS_WD1), D, FF, pg8::EpiResid<true>{xin, WSP(WS_XB), mod + 2 * D, seq_shift, 0.5f}, tid); }
        SEAM();
        { PHASE_BEGIN(); norm_mod_phase((const bf16_t*)WSP(WS_XB), ap->in[10], mod, 3 * D, seq_shift, WSP(WS_H), wave, lane); }
        SEAM();
        { PHASE_BEGIN(); run_gemm(lds, WSP(WS_H), D, WSP(WS_WIN), ZW, D, pg8::EpiPlain{WSP(WS_Z), ZW}, tid); }
        SEAM();
        { PHASE_BEGIN(); post1_phase(WSP(WS_Z), S - 1, ap->in[12], ap->in[13], ap->in[15], ap->in[17], wave, lane); }
        SEAM();
        { PHASE_BEGIN(); run_gemm(lds, WSP(WS_Z) + 768, ZW, WSP(WS_WUQ), 768, 256, pg8::EpiPlain{WSP(WS_QB), 768}, tid); }
        { PHASE_BEGIN(); run_gemm(lds, WSP(WS_Z) + 1024, ZW, WSP(WS_WUKV), 1024, 256, pg8::EpiPlain{WSP(WS_KV), 1024}, tid); }
        SEAM();
        { PHASE_BEGIN(); post2_phase(WSP(WS_QB), WSP(WS_KV), WSP(WS_Z), WSP(WS_KB), S - 1, ap->in[19], ap->in[20], wave, lane); }
        SEAM();
        {
            PHASE_BEGIN();
            bf16_t* H = WSP(WS_H); bf16_t* Z = WSP(WS_Z); bf16_t* QB = WSP(WS_QB); bf16_t* KV = WSP(WS_KV); bf16_t* KB = WSP(WS_KB);
            const int nqb = S / 256, nunits = nseq * 8 * nqb;
            const int G = (int)gridDim.x, bx = (int)blockIdx.x;
            const int vcu = (G % 8 == 0) ? (bx % 8) * (G / 8) + bx / 8 : bx;
            for (int u = vcu; u < 2 * nunits; u += G) {
                const bool dense = u < nunits; const int uu = dense ? u : u - nunits;
                const int qb = uu % nqb, hd = (uu / nqb) & 7, s = uu / (nqb * 8);
                const size_t r0 = (size_t)s * S;
                if (dense)
                    attn_unit<96, false>(QB + r0 * 768 + hd * 96, 768, KB + r0 * 768 + hd * 96, 768, KV + r0 * 1024 + hd * 128 + 64, 1024,
                                         H + r0 * 1024 + 512 + hd * 64, 1024, S, qb * 256, 0.f, lds, tid, wave, lane);
                else
                    attn_unit<64, true>(Z + r0 * ZW + hd * 64, ZW, Z + r0 * ZW + 512 + (hd >> 2) * 64, ZW, Z + r0 * ZW + 640 + (hd >> 2) * 64, ZW,
                                        H + r0 * 1024 + hd * 64, 1024, S, qb * 256, ap->in[14][hd] * LOG2E, lds, tid, wave, lane);
            }
        }
        SEAM();
        { PHASE_BEGIN(); run_gemm(lds, WSP(WS_H), D, WSP(WS_WOUT), D, D, pg8::EpiResid<false>{WSP(WS_XB), WSP(WS_XB), mod + 5 * D, seq_shift, 1.0f}, tid); }
        SEAM();
        { PHASE_BEGIN(); norm_mod_phase((const bf16_t*)WSP(WS_XB), ap->in[22], mod, 6 * D, seq_shift, WSP(WS_H), wave, lane); }
        SEAM();
        { PHASE_BEGIN(); run_gemm(lds, WSP(WS_H), D, WSP(WS_WGU2), 2 * FF, D, pg8::EpiSwiGLU{WSP(WS_ACT), FF}, tid); }
        SEAM();
        { PHASE_BEGIN(); run_gemm(lds, WSP(WS_ACT), FF, WSP(WS_WD2), D, FF, pg8::EpiResid<false>{WSP(WS_XB), WSP(WS_XB), mod + 8 * D, seq_shift, 0.5f}, tid); }
        SEAM();
        { PHASE_BEGIN(); final_norm_phase((const bf16_t*)WSP(WS_XB), out, ap->in[26], wave, lane); }
    }
}

extern "C" void kernel_launch(void* const* d_in, const int* in_sizes, int n_in, void* d_out, int out_size, void* d_ws, size_t ws_size, hipStream_t stream) {
    static int grid = 0;
    if (grid == 0) {
        int dev = 0, cus = 0, per_cu = 0;
        hipGetDevice(&dev);
        hipDeviceGetAttribute(&cus, hipDeviceAttributeMultiprocessorCount, dev);
        hipFuncSetAttribute((const void*)fwd_kernel, hipFuncAttributeMaxDynamicSharedMemorySize, LDS_BYTES);
        hipOccupancyMaxActiveBlocksPerMultiprocessor(&per_cu, (const void*)fwd_kernel, NT, LDS_BYTES);
        if (per_cu < 1) per_cu = 1;
        if (per_cu > 1) per_cu = 1;
        grid = cus * per_cu;
        if (n_in != 27 || ws_size < WS_END) fprintf(stderr, "kernel_launch: unexpected n_in %d or ws_size %zu\n", n_in, ws_size);
    }
    hipMemsetAsync((char*)d_ws, 0, CTL_ZERO_BYTES, stream);
    Args a{};
    for (int i = 0; i < 27; ++i) a.in[i] = (const float*)d_in[i];
    a.out = (float*)d_out; a.ws = (unsigned char*)d_ws;
    void* args[] = {&a};
    hipError_t e = hipLaunchCooperativeKernel((const void*)fwd_kernel, dim3(grid), dim3(NT), args, LDS_BYTES, stream);
    if (e != hipSuccess) fprintf(stderr, "cooperative launch failed: %s (grid %d)\n", hipGetErrorString(e), grid);
}
```

```cpp
#include <hip/hip_runtime.h>
#include <hip/hip_cooperative_groups.h>
#include <cstdio>
#include <cstdint>
namespace cg = cooperative_groups;
namespace pg8 {
#define PG8_LAS __attribute__((address_space(3)))
typedef unsigned short bf16_t;
typedef short bf16x8 __attribute__((ext_vector_type(8)));
typedef float f32x4 __attribute__((ext_vector_type(4)));
typedef unsigned u32x4 __attribute__((ext_vector_type(4)));
constexpr int BM = 256, BK = 64, HALF = 128, HTB = HALF * BK * 2  , STAGE_BYTES = 8 * HTB, NXCD = 8, WGM = 8;

__host__ __device__ __forceinline__ int lds_byte(int r, int c) { const int st = (r >> 4) * 2 + (c >> 5), rr = r & 15, cc = c & 31, ob = rr * 64 + cc * 2; return st * 1024 + (ob ^ (((ob >> 9) & 1) << 5)); }
__host__ __device__ __forceinline__ void stage_rc(int b, int& R, int& C) { const int st = b / 1024, sb = b % 1024, swz = sb ^ (((sb >> 9) & 1) << 5); R = (st >> 1) * 16 + swz / 64; C = (st & 1) * 32 + (swz % 64) / 2; }
__host__ __device__ __forceinline__ int perm32(int rho) { const int n = rho >> 4, i = rho & 15; return 8 * (i >> 2) + 4 * n + (i & 3); }
struct Unit { int pm, pn; };
struct Gemm { const bf16_t* A; const bf16_t* Bt; int M, N, K, lda; };

struct StaticOrder {
    int nM, nN, nwg, G, c;
    __host__ __device__ void init(int M, int N, int G_, int c_) { nM = M / BM; nN = N / BM; nwg = nM * nN; G = G_; c = c_; }
    __host__ __device__ bool next(int i, Unit& u) const {
        const long L = (long)i * G + c; if (L >= nwg) return false;
        int wgid = (int)L; { const int q = nwg / NXCD, r = nwg % NXCD, xcd = wgid % NXCD, off = wgid / NXCD; wgid = (xcd < r ? xcd * (q + 1) : r * (q + 1) + (xcd - r) * q) + off; }
        const int nig = WGM * nN, gid = wgid / nig, fm = gid * WGM, gsz = (nM - fm) < WGM ? (nM - fm) : WGM;
        u.pm = fm + ((wgid % nig) % gsz); u.pn = (wgid % nig) / gsz; return true;
    }
    __device__ __forceinline__ void a_ready(const Unit&) const {}
    __device__ __forceinline__ void done(const Unit&) const {}
};
__device__ __forceinline__ unsigned cvt_pk_bf16(float lo, float hi) { unsigned r; asm volatile("v_cvt_pk_bf16_f32 %0, %1, %2" : "=v"(r) : "v"(lo), "v"(hi)); return r; }
typedef float f32x2 __attribute__((ext_vector_type(2)));
template <class Epi, class Sched, bool ALIGN_EPI = false, bool SP2 = false>
__device__ __forceinline__ void gemm_phase(PG8_LAS unsigned char* lds, const Gemm g, const Sched& S, const Epi& E, int tid_in) {
    int tid_l = tid_in; asm volatile("" : "+v"(tid_l));
    const int tid = tid_l, wid = __builtin_amdgcn_readfirstlane(tid >> 6), lane = tid & 63, wr = wid >> 2, wc = wid & 3, fr = lane & 15, fq = lane >> 4;
    const int K = g.K, nt = K / BK;
    unsigned voffA[2], voffB[2];
#pragma unroll
    for (int i = 0; i < 2; ++i) { int R, C; stage_rc(tid * 16 + i * 8192, R, C); const int Rb = Epi::PERM ? ((R & ~31) + perm32(R & 31)) : R;
        voffA[i] = (unsigned)(R * g.lda + C) * 2u; voffB[i] = (unsigned)(Rb * K + C) * 2u; }
    const size_t kstep = (size_t)(BK * 2);
    const size_t hstep = (size_t)HALF * K * 2;
    const size_t tstep = 2 * hstep;
    const size_t hstepA = (size_t)HALF * g.lda * 2, tstepA = 2 * hstepA;
    const unsigned ldsw = (unsigned)wid * 1024u;
    const int aoff = lds_byte(wr * 64 + fr, fq * 8), boff = lds_byte(wc * 32 + fr, fq * 8);
#define PG8_SA(b, h) (((b) * 2 + (h)) * HTB)
#define PG8_SB(b, h) ((4 + (b) * 2 + (h)) * HTB)
#define PG8_STAGE(bufoff, gbase, voff) do { _Pragma("unroll") for (int _i = 0; _i < 2; ++_i) \
        __builtin_amdgcn_global_load_lds((const unsigned*)((const char*)(gbase) + (voff)[_i]), (PG8_LAS unsigned*)(lds + (bufoff) + ldsw + _i * 8192), 16, 0, 0); } while (0)
#define PG8_LDA(dst, b, h) do { _Pragma("unroll") for (int m = 0; m < 4; ++m) _Pragma("unroll") for (int k = 0; k < 2; ++k) dst[m][k] = *(const PG8_LAS bf16x8*)(lds + PG8_SA(b, h) + aoff + m * 2048 + k * 1024); } while (0)
#define PG8_LDB(dst, b, h) do { _Pragma("unroll") for (int n = 0; n < 2; ++n) _Pragma("unroll") for (int k = 0; k < 2; ++k) dst[n][k] = *(const PG8_LAS bf16x8*)(lds + PG8_SB(b, h) + boff + n * 2048 + k * 1024); } while (0)
#define PG8_MMA(ai, bj, At, Bt) do { __builtin_amdgcn_s_setprio(1); _Pragma("unroll") for (int m = 0; m < 4; ++m) _Pragma("unroll") for (int n = 0; n < 2; ++n) _Pragma("unroll") for (int k = 0; k < 2; ++k) \
        acc[ai][bj][m][n] = __builtin_amdgcn_mfma_f32_16x16x32_bf16(Bt[n][k], At[m][k], acc[ai][bj][m][n], 0, 0, 0); __builtin_amdgcn_s_setprio(0); } while (0)
#define PG8_WAIT_V(n) asm volatile("s_waitcnt vmcnt(" #n ")" ::: "memory")
#define PG8_WAIT_L(n) asm volatile("s_waitcnt lgkmcnt(" #n ")" ::: "memory")
#define PG8_BAR __builtin_amdgcn_s_barrier()
#define PG8_SCHED __builtin_amdgcn_sched_barrier(0)
    Unit cur, nxt; int ui = 0;
    if (!S.next(0, cur)) return;
    f32x4 acc[2][2][4][2];
#pragma unroll
    for (int a = 0; a < 2; ++a)
#pragma unroll
        for (int b = 0; b < 2; ++b)
#pragma unroll
            for (int m = 0; m < 4; ++m)
#pragma unroll
                for (int n = 0; n < 2; ++n) acc[a][b][m][n] = (f32x4){0.f, 0.f, 0.f, 0.f};
    bf16x8 At[4][2], B0[2][2], B1[2][2];
    const char* cA = (const char*)g.A + (size_t)cur.pm * tstepA; const char* cB = (const char*)g.Bt + (size_t)cur.pn * tstep;
    S.a_ready(cur);
    if constexpr (SP2) {
        PG8_STAGE(PG8_SB(0, 0), cB, voffB); PG8_STAGE(PG8_SB(0, 1), cB + hstep, voffB); PG8_STAGE(PG8_SA(0, 0), cA, voffA); PG8_STAGE(PG8_SA(0, 1), cA + hstepA, voffA);
        if (wr == 1) PG8_BAR;
        PG8_WAIT_V(2); PG8_BAR;
        PG8_STAGE(PG8_SB(1, 0), cB + kstep, voffB); PG8_STAGE(PG8_SA(1, 0), cA + kstep, voffA); PG8_STAGE(PG8_SB(1, 1), cB + hstep + kstep, voffB);
        PG8_WAIT_V(6); PG8_BAR;
    } else {
        PG8_STAGE(PG8_SB(0, 0), cB, voffB); PG8_STAGE(PG8_SA(0, 0), cA, voffA); PG8_STAGE(PG8_SB(0, 1), cB + hstep, voffB); PG8_STAGE(PG8_SA(0, 1), cA + hstepA, voffA);
        if (wr == 1) PG8_BAR;
        PG8_WAIT_V(4); PG8_BAR;
        PG8_STAGE(PG8_SB(1, 0), cB + kstep, voffB); PG8_STAGE(PG8_SA(1, 0), cA + kstep, voffA); PG8_STAGE(PG8_SB(1, 1), cB + hstep + kstep, voffB);
        PG8_WAIT_V(6); PG8_BAR;
    }
    for (;;) {
        const bool has_next = S.next(ui + 1, nxt);
        const char* nA = has_next ? (const char*)g.A + (size_t)nxt.pm * tstepA : cA; const char* nB = has_next ? (const char*)g.Bt + (size_t)nxt.pn * tstep : cB;
        for (int t = 0; t < nt; t += 2) {
            const bool last = (t == nt - 2);
            const char* a1 = cA + (size_t)(t + 1) * kstep;
            const char* a2 = last ? nA : cA + (size_t)(t + 2) * kstep; const char* b2 = last ? nB : cB + (size_t)(t + 2) * kstep;
            const char* a3 = a2 + kstep; const char* b3 = b2 + kstep;
            if (last && has_next) S.a_ready(nxt);
            if constexpr (SP2) {
            PG8_LDB(B0, 0, 0); PG8_LDB(B1, 0, 1); PG8_SCHED; PG8_LDA(At, 0, 0); PG8_STAGE(PG8_SA(1, 1), a1 + hstepA, voffA);
            PG8_WAIT_V(8); PG8_WAIT_L(0); PG8_BAR; PG8_MMA(0, 0, At, B0); PG8_MMA(0, 1, At, B1); PG8_BAR; PG8_SCHED;
            PG8_LDA(At, 0, 1); PG8_STAGE(PG8_SB(0, 0), b2, voffB); PG8_STAGE(PG8_SB(0, 1), b2 + hstep, voffB); PG8_STAGE(PG8_SA(0, 0), a2, voffA);
            PG8_WAIT_V(8); PG8_WAIT_L(0); PG8_BAR; PG8_MMA(1, 0, At, B0); PG8_MMA(1, 1, At, B1); PG8_BAR; PG8_SCHED;
            PG8_LDB(B0, 1, 0); PG8_LDB(B1, 1, 1); PG8_SCHED; PG8_LDA(At, 1, 0); PG8_STAGE(PG8_SA(0, 1), a2 + hstepA, voffA);
            PG8_WAIT_V(8); PG8_WAIT_L(0); PG8_BAR; PG8_MMA(0, 0, At, B0); PG8_MMA(0, 1, At, B1); PG8_BAR; PG8_SCHED;
            PG8_LDA(At, 1, 1); PG8_STAGE(PG8_SB(1, 0), b3, voffB); PG8_STAGE(PG8_SB(1, 1), b3 + hstep, voffB); PG8_STAGE(PG8_SA(1, 0), a3, voffA);
            PG8_WAIT_V(8); PG8_WAIT_L(0); PG8_BAR; PG8_MMA(1, 0, At, B0); PG8_MMA(1, 1, At, B1); PG8_BAR; PG8_SCHED;
            } else {
            PG8_LDB(B0, 0, 0); PG8_SCHED; PG8_LDA(At, 0, 0); PG8_STAGE(PG8_SA(1, 1), a1 + hstepA, voffA);
            PG8_WAIT_L(8); PG8_BAR; PG8_WAIT_L(0); PG8_MMA(0, 0, At, B0); PG8_BAR; PG8_SCHED;
            PG8_LDB(B1, 0, 1); PG8_STAGE(PG8_SB(0, 0), b2, voffB);
            PG8_BAR; PG8_WAIT_L(0); PG8_MMA(0, 1, At, B1); PG8_BAR;
            PG8_LDA(At, 0, 1); PG8_STAGE(PG8_SA(0, 0), a2, voffA);
            PG8_BAR; PG8_WAIT_L(0); PG8_MMA(1, 0, At, B0); PG8_BAR; PG8_SCHED;
            PG8_STAGE(PG8_SB(0, 1), b2 + hstep, voffB);
            PG8_WAIT_V(6); PG8_BAR; PG8_MMA(1, 1, At, B1); PG8_BAR;
            PG8_LDB(B0, 1, 0); PG8_SCHED; PG8_LDA(At, 1, 0); PG8_STAGE(PG8_SA(0, 1), a2 + hstepA, voffA);
            PG8_WAIT_L(8); PG8_BAR; PG8_WAIT_L(0); PG8_MMA(0, 0, At, B0); PG8_BAR; PG8_SCHED;
            PG8_LDB(B1, 1, 1); PG8_STAGE(PG8_SB(1, 0), b3, voffB);
            PG8_BAR; PG8_WAIT_L(0); PG8_MMA(0, 1, At, B1); PG8_BAR;
            PG8_LDA(At, 1, 1); PG8_STAGE(PG8_SA(1, 0), a3, voffA);
            PG8_BAR; PG8_WAIT_L(0); PG8_MMA(1, 0, At, B0); PG8_BAR; PG8_SCHED;
            PG8_STAGE(PG8_SB(1, 1), b3 + hstep, voffB);
            PG8_WAIT_V(6); PG8_BAR; PG8_MMA(1, 1, At, B1); PG8_BAR;
            }
        }
        if constexpr (ALIGN_EPI) { if (wr == 0) PG8_BAR; }
        if constexpr (!Epi::AFTER_DRAIN) { E(acc, cur, wr, wc, fr, fq); S.done(cur); }
        if (!has_next) break;
#pragma unroll
        for (int a = 0; a < 2; ++a)
#pragma unroll
            for (int b = 0; b < 2; ++b)
#pragma unroll
                for (int m = 0; m < 4; ++m)
#pragma unroll
                    for (int n = 0; n < 2; ++n) acc[a][b][m][n] = (f32x4){0.f, 0.f, 0.f, 0.f};
        cur = nxt; cA = nA; cB = nB; ++ui;
        if constexpr (ALIGN_EPI) { if (wr == 1) PG8_BAR; }
    }
    PG8_WAIT_V(0);
    if constexpr (!ALIGN_EPI) { if (wr == 0) PG8_BAR; }
    PG8_BAR;
    if constexpr (Epi::AFTER_DRAIN) { E.fused(acc, cur, wr, wc, fr, fq, lds, wid, lane); S.done(cur); }
#undef PG8_SA
#undef PG8_SB
#undef PG8_STAGE
#undef PG8_LDA
#undef PG8_LDB
#undef PG8_MMA
#undef PG8_WAIT_V
#undef PG8_WAIT_L
#undef PG8_BAR
#undef PG8_SCHED
}
}

#define LAS __attribute__((address_space(3)))
typedef unsigned short bf16_t;
typedef short bf16x8 __attribute__((ext_vector_type(8)));
typedef float f32x4 __attribute__((ext_vector_type(4)));
typedef float f32x16 __attribute__((ext_vector_type(16)));
typedef unsigned u32x4 __attribute__((ext_vector_type(4)));
typedef unsigned u32x2 __attribute__((ext_vector_type(2)));
typedef short v4i16_t __attribute__((ext_vector_type(4)));
typedef float f32x2_t __attribute__((ext_vector_type(2)));
typedef __bf16 bf16x2_t __attribute__((ext_vector_type(2)));

constexpr int D = 1024, FF = 2816, NMOD = 9, MODW = NMOD * D;
constexpr int GM = 32768;
constexpr int ZW = 1280;
constexpr int INW = 1184;
constexpr int NWAVES = 8, NT = 512;
constexpr float EPS = 1e-6f;
constexpr float LOG2E = 1.4426950408889634f;
constexpr float LOG2_THETA = 13.287712379549449f;

constexpr size_t MiB = 1u << 20;
constexpr size_t WS_MOD = 0;
constexpr size_t MOD_BYTES = 12 * MODW * 4;
constexpr size_t WS_BAR = 768 * 1024;
constexpr size_t CTL_ZERO_BYTES = 1 * MiB;
constexpr size_t WS_WGU1 = 1 * MiB;
constexpr size_t WS_WD1 = WS_WGU1 + (size_t)5632 * 1024 * 2;
constexpr size_t WS_WGU2 = WS_WD1 + (size_t)1024 * 2816 * 2;
constexpr size_t WS_WD2 = WS_WGU2 + (size_t)5632 * 1024 * 2;
constexpr size_t WS_WIN = WS_WD2 + (size_t)1024 * 2816 * 2;
constexpr size_t WS_WUQ = WS_WIN + (size_t)1280 * 1024 * 2;
constexpr size_t WS_WUKV = WS_WUQ + (size_t)768 * 256 * 2;
constexpr size_t WS_WOUT = WS_WUKV + (size_t)1024 * 256 * 2;
constexpr size_t WS_WEND = WS_WOUT + (size_t)1024 * 1024 * 2;
static_assert(WS_WEND <= 40 * MiB, "weights region");
constexpr size_t WS_H = 40 * MiB;
constexpr size_t WS_B = 104 * MiB;
constexpr size_t WS_ACT = WS_B;
constexpr size_t WS_Z = WS_B;
constexpr size_t WS_QB = WS_Z + (size_t)GM * ZW * 2;
constexpr size_t WS_KV = WS_QB + (size_t)GM * 768 * 2;
constexpr size_t WS_KB = WS_KV + (size_t)GM * 1024 * 2;
constexpr size_t WS_XB = WS_KB + (size_t)GM * 768 * 2;
constexpr size_t WS_END = WS_XB + (size_t)GM * D * 2;
static_assert(WS_END <= 420 * MiB && WS_ACT + (size_t)GM * FF * 2 <= WS_XB, "ws map");

constexpr int LDS_BYTES = 131072 + 4096;

__device__ __forceinline__ unsigned f2bf(float f) { unsigned u = __builtin_bit_cast(unsigned, f); return (u + 0x7fffu + ((u >> 16) & 1u)) >> 16; }
__device__ __forceinline__ unsigned pk2(float lo, float hi) { f32x2_t v = {lo, hi}; bf16x2_t b = __builtin_convertvector(v, bf16x2_t); return __builtin_bit_cast(unsigned, b); }
__device__ __forceinline__ float bf2f(unsigned short b) { return __builtin_bit_cast(float, (unsigned)b << 16); }
__device__ __forceinline__ float bflo(unsigned w) { return __builtin_bit_cast(float, w << 16); }
__device__ __forceinline__ float bfhi(unsigned w) { return __builtin_bit_cast(float, w & 0xffff0000u); }
template <int M> __device__ __forceinline__ float swz_xor(float v) { return __builtin_bit_cast(float, __builtin_amdgcn_ds_swizzle(__builtin_bit_cast(int, v), (M << 10) | 0x1f)); }
__device__ __forceinline__ float half_sum(float v) { v += swz_xor<1>(v); v += swz_xor<2>(v); v += swz_xor<4>(v); v += swz_xor<8>(v); v += swz_xor<16>(v); return v; }
__device__ __forceinline__ void xhalf_pair(float v, float& lo, float& hi) { unsigned a = __builtin_bit_cast(unsigned, v), b = a;
    asm volatile("s_nop 1\n\tv_permlane32_swap_b32 %0, %1\n\ts_nop 1" : "+v"(a), "+v"(b)); lo = __builtin_bit_cast(float, a); hi = __builtin_bit_cast(float, b); }
__device__ __forceinline__ float xhalf_sum(float v) { float lo, hi; xhalf_pair(v, lo, hi); return lo + hi; }
__device__ __forceinline__ float xhalf_max(float v) { float lo, hi; xhalf_pair(v, lo, hi); return fmaxf(lo, hi); }
__device__ __forceinline__ float wave_sum(float v) { return xhalf_sum(half_sum(v)); }

namespace pg8 {
struct EpiPlain {
    static constexpr bool PERM = true, AFTER_DRAIN = false;
    bf16_t* O; int ldc;
    __device__ __forceinline__ void operator()(const f32x4 (&acc)[2][2][4][2], const Unit& u, int wr, int wc, int fr, int fq) const {
        const int row0 = u.pm * BM + wr * 64 + fr, col0 = u.pn * BM + wc * 32 + 8 * fq;
#pragma unroll
        for (int ai = 0; ai < 2; ++ai)
#pragma unroll
            for (int m = 0; m < 4; ++m) { bf16_t* rowp = O + (size_t)(row0 + ai * HALF + m * 16) * ldc + col0;
#pragma unroll
                for (int bj = 0; bj < 2; ++bj) { const f32x4 v0 = acc[ai][bj][m][0], v1 = acc[ai][bj][m][1];
                    u32x4 w; w.x = pk2(v0[0], v0[1]); w.y = pk2(v0[2], v0[3]); w.z = pk2(v1[0], v1[1]); w.w = pk2(v1[2], v1[3]);
                    *(u32x4*)(rowp + bj * HALF) = w; } }
    }
};
__device__ __forceinline__ float silu_mul(float g, float u) { return g * u * __builtin_amdgcn_rcpf(1.0f + __builtin_amdgcn_exp2f(-g * LOG2E)); }
struct EpiSwiGLU {
    static constexpr bool PERM = true, AFTER_DRAIN = false;
    bf16_t* O; int ldc;
    __device__ __forceinline__ void operator()(const f32x4 (&acc)[2][2][4][2], const Unit& u, int wr, int wc, int fr, int fq) const {
        const int row0 = u.pm * BM + wr * 64 + fr, col0 = u.pn * HALF + wc * 32 + 8 * fq;
#pragma unroll
        for (int ai = 0; ai < 2; ++ai)
#pragma unroll
            for (int m = 0; m < 4; ++m) { bf16_t* rowp = O + (size_t)(row0 + ai * HALF + m * 16) * ldc + col0;
                const f32x4 g0 = acc[ai][0][m][0], g1 = acc[ai][0][m][1], u0 = acc[ai][1][m][0], u1 = acc[ai][1][m][1];
                u32x4 w; w.x = pk2(silu_mul(g0[0], u0[0]), silu_mul(g0[1], u0[1])); w.y = pk2(silu_mul(g0[2], u0[2]), silu_mul(g0[3], u0[3]));
                w.z = pk2(silu_mul(g1[0], u1[0]), silu_mul(g1[1], u1[1])); w.w = pk2(silu_mul(g1[2], u1[2]), silu_mul(g1[3], u1[3]));
                *(u32x4*)rowp = w; }
    }
};
template <bool BASE_F32> struct EpiResid {
    static constexpr bool PERM = true, AFTER_DRAIN = false;
    const void* base; bf16_t* out; const float* gate  ; int seq_shift  ; float scale;
    __device__ __forceinline__ void operator()(const f32x4 (&acc)[2][2][4][2], const Unit& u, int wr, int wc, int fr, int fq) const {
        const int row0 = u.pm * BM + wr * 64 + fr, col0 = u.pn * BM + wc * 32 + 8 * fq;
        const float* gp = gate + (size_t)((u.pm * BM) >> seq_shift) * MODW + col0;
#pragma unroll
        for (int bj = 0; bj < 2; ++bj) { const f32x4 g0 = *(const f32x4*)(gp + bj * HALF) * scale, g1 = *(const f32x4*)(gp + bj * HALF + 4) * scale;
#pragma unroll
            for (int ai = 0; ai < 2; ++ai)
#pragma unroll
                for (int m = 0; m < 4; ++m) { const size_t off = (size_t)(row0 + ai * HALF + m * 16) * D + col0 + bj * HALF;
                    f32x4 b0, b1;
                    if (BASE_F32) { b0 = *(const f32x4*)((const float*)base + off); b1 = *(const f32x4*)((const float*)base + off + 4); }
                    else { const u32x4 w = *(const u32x4*)((const bf16_t*)base + off); b0 = (f32x4){bflo(w.x), bfhi(w.x), bflo(w.y), bfhi(w.y)}; b1 = (f32x4){bflo(w.z), bfhi(w.z), bflo(w.w), bfhi(w.w)}; }
                    const f32x4 v0 = b0 + g0 * acc[ai][bj][m][0], v1 = b1 + g1 * acc[ai][bj][m][1];
                    u32x4 o; o.x = pk2(v0[0], v0[1]); o.y = pk2(v0[2], v0[3]); o.z = pk2(v1[0], v1[1]); o.w = pk2(v1[2], v1[3]);
                    *(u32x4*)(out + off) = o; } }
    }
};
}

struct Args { const float* in[27]; float* out; unsigned char* ws; };

__device__ __forceinline__ void transpose_item(const float* W, int K, int N, bf16_t* WT, int mode, LAS float* scr, int item, int lane) {
    const int nblk = N / 32, kb = item / nblk, nb = item % nblk, k0 = 64 * kb, n0 = 32 * nb;
    int d0 = n0;
    if (mode == 1) d0 = (n0 >> 7) * 256 + (n0 & 127);
    else if (mode == 2) d0 = (n0 >> 7) * 256 + 128 + (n0 & 127);
#pragma unroll 8
    for (int i = 0; i < 32; ++i) { const int kk = 2 * i + (lane >> 5); scr[kk * 33 + (lane & 31)] = W[(size_t)(k0 + kk) * N + n0 + (lane & 31)]; }
    asm volatile("s_waitcnt lgkmcnt(0)" ::: "memory");
    const int c = lane & 7;
#pragma unroll
    for (int j = 0; j < 4; ++j) { const int n = (lane >> 3) + 8 * j; const LAS float* s = scr + (8 * c) * 33 + n;
        u32x4 o; o.x = pk2(s[0 * 33], s[1 * 33]); o.y = pk2(s[2 * 33], s[3 * 33]); o.z = pk2(s[4 * 33], s[5 * 33]); o.w = pk2(s[6 * 33], s[7 * 33]);
        *(u32x4*)(WT + (size_t)(d0 + n) * K + k0 + 8 * c) = o; }
    asm volatile("s_waitcnt lgkmcnt(0)" ::: "memory");
}

typedef const Args __attribute__((address_space(4)))* KArgs0;
__device__ __forceinline__ void phase0(KArgs0 ap, LAS unsigned char* lds, int tid, int wave, int lane) {
    unsigned char* ws = ap->ws;
    {
        LAS float* scr = (LAS float*)(lds + wave * 8704);
        const int gw = blockIdx.x * NWAVES + wave, NGW = gridDim.x * NWAVES;
        constexpr int I_G = (D / 64) * (FF / 32), I_D = (FF / 64) * (D / 32), I_IN = (D / 64) * (INW / 32), I_UQ = (256 / 64) * (768 / 32), I_UKV = (128 / 64) * (1024 / 32), I_OUT = (D / 64) * (D / 32);
        constexpr int NITEMS = 4 * I_G + 2 * I_D + I_IN + I_UQ + I_UKV + I_OUT;
        for (int it = gw; it < NITEMS; it += NGW) {
            int r = it;
            if (r < I_G) { transpose_item(ap->in[7], D, FF, (bf16_t*)(ws + WS_WGU1), 1, scr, r, lane); continue; } r -= I_G;
            if (r < I_G) { transpose_item(ap->in[8], D, FF, (bf16_t*)(ws + WS_WGU1), 2, scr, r, lane); continue; } r -= I_G;
            if (r < I_D) { transpose_item(ap->in[9], FF, D, (bf16_t*)(ws + WS_WD1), 0, scr, r, lane); continue; } r -= I_D;
            if (r < I_G) { transpose_item(ap->in[23], D, FF, (bf16_t*)(ws + WS_WGU2), 1, scr, r, lane); continue; } r -= I_G;
            if (r < I_G) { transpose_item(ap->in[24], D, FF, (bf16_t*)(ws + WS_WGU2), 2, scr, r, lane); continue; } r -= I_G;
            if (r < I_D) { transpose_item(ap->in[25], FF, D, (bf16_t*)(ws + WS_WD2), 0, scr, r, lane); continue; } r -= I_D;
            if (r < I_IN) { transpose_item(ap->in[11], D, INW, (bf16_t*)(ws + WS_WIN), 0, scr, r, lane); continue; } r -= I_IN;
            if (r < I_UQ) { transpose_item(ap->in[16], 256, 768, (bf16_t*)(ws + WS_WUQ), 0, scr, r, lane); continue; } r -= I_UQ;
            if (r < I_UKV) { transpose_item(ap->in[18], 256, 1024, (bf16_t*)(ws + WS_WUKV), 0, scr, r, lane); continue; } r -= I_UKV;
            transpose_item(ap->in[21], D, D, (bf16_t*)(ws + WS_WOUT), 0, scr, r, lane);
        }
        { for (int i = blockIdx.x * NT + tid; i < 1024 * 16; i += gridDim.x * NT) *(u32x4*)(ws + WS_WUKV + (size_t)(i >> 4) * 512 + 256 + (i & 15) * 16) = (u32x4){0u, 0u, 0u, 0u}; }
        { u32x4* p = (u32x4*)(ws + WS_WIN + (size_t)INW * D * 2); const int n16 = (ZW - INW) * D * 2 / 16;
          for (int i = blockIdx.x * NT + tid; i < n16; i += gridDim.x * NT) p[i] = (u32x4){0u, 0u, 0u, 0u}; }
    }
    __syncthreads();
    {
        LAS float* sc = (LAS float*)lds;
        float* mod = (float*)(ws + WS_MOD);
        const float* adaw = ap->in[4]; const float* adab = ap->in[5];
        for (int item = blockIdx.x; item < 18 * 16; item += gridDim.x) {
            const int cb = item % 18, kc = item / 18;
            __syncthreads();
            for (int i = tid; i < 12 * 64; i += NT) { const int s = i >> 6, kk = i & 63;
                const float c = (s < 4) ? ap->in[2][s * D + kc * 64 + kk] : ap->in[3][(s - 4) * D + kc * 64 + kk];
                sc[i] = c / (1.0f + __expf(-c)); }
            __syncthreads();
            const int col = cb * 512 + tid;
            float acc[12];
#pragma unroll
            for (int s = 0; s < 12; ++s) acc[s] = 0.f;
            const float* wp = adaw + (size_t)(kc * 64) * MODW + col;
#pragma unroll 8
            for (int kk = 0; kk < 64; ++kk) { const float w = wp[(size_t)kk * MODW];
#pragma unroll
                for (int s = 0; s < 12; ++s) acc[s] += sc[s * 64 + kk] * w; }
            const float b = (kc == 0) ? adab[col] : 0.f;
#pragma unroll
            for (int s = 0; s < 12; ++s) atomicAdd(mod + s * MODW + col, acc[s] + b);
        }
    }
}

__device__ __forceinline__ void load_row16(const float* x, int lane, float (&v)[16]) {
#pragma unroll
    for (int j = 0; j < 2; ++j) { const f32x4 a = *(const f32x4*)(x + 512 * j + 8 * lane), b = *(const f32x4*)(x + 512 * j + 8 * lane + 4);
        v[8 * j + 0] = a.x; v[8 * j + 1] = a.y; v[8 * j + 2] = a.z; v[8 * j + 3] = a.w; v[8 * j + 4] = b.x; v[8 * j + 5] = b.y; v[8 * j + 6] = b.z; v[8 * j + 7] = b.w; }
}
__device__ __forceinline__ void load_row16(const bf16_t* x, int lane, float (&v)[16]) {
#pragma unroll
    for (int j = 0; j < 2; ++j) { const u32x4 w = *(const u32x4*)(x + 512 * j + 8 * lane);
        v[8 * j + 0] = bflo(w.x); v[8 * j + 1] = bfhi(w.x); v[8 * j + 2] = bflo(w.y); v[8 * j + 3] = bfhi(w.y); v[8 * j + 4] = bflo(w.z); v[8 * j + 5] = bfhi(w.z); v[8 * j + 6] = bflo(w.w); v[8 * j + 7] = bfhi(w.w); }
}
template <class XT>
__device__ __forceinline__ void norm_mod_phase(const XT* x, const float* gain, const float* mod  , int shoff, int seq_shift, bf16_t* H, int wave, int lane) {
    const int gw = blockIdx.x * NWAVES + wave, NGW = gridDim.x * NWAVES;
    float gv[16]; load_row16(gain, lane, gv);
    for (int m = gw; m < GM; m += NGW) {
        float v[16]; load_row16(x + (size_t)m * D, lane, v);
        const float* mp = mod + (size_t)(m >> seq_shift) * MODW + shoff;
        float sh[16], sc[16]; load_row16(mp, lane, sh); load_row16(mp + D, lane, sc);
        float s = 0.f;
#pragma unroll
        for (int e = 0; e < 16; ++e) s += v[e] * v[e];
        const float rstd = 1.0f / sqrtf(wave_sum(s) * (1.0f / D) + EPS);
#pragma unroll
        for (int j = 0; j < 2; ++j) { float y[8];
#pragma unroll
            for (int e = 0; e < 8; ++e) y[e] = v[8 * j + e] * rstd * gv[8 * j + e] * (sc[8 * j + e] + 1.0f) + sh[8 * j + e];
            u32x4 w; w.x = pk2(y[0], y[1]); w.y = pk2(y[2], y[3]); w.z = pk2(y[4], y[5]); w.w = pk2(y[6], y[7]);
            *(u32x4*)(H + (size_t)m * D + 512 * j + 8 * lane) = w; }
    }
}
__device__ __forceinline__ void final_norm_phase(const bf16_t* xb, float* out, const float* gain, int wave, int lane) {
    const int gw = blockIdx.x * NWAVES + wave, NGW = gridDim.x * NWAVES;
    float gv[16]; load_row16(gain, lane, gv);
    for (int m = gw; m < GM; m += NGW) {
        float v[16]; load_row16(xb + (size_t)m * D, lane, v);
        float s = 0.f;
#pragma unroll
        for (int e = 0; e < 16; ++e) s += v[e] * v[e];
        const float rstd = 1.0f / sqrtf(wave_sum(s) * (1.0f / D) + EPS);
#pragma unroll
        for (int j = 0; j < 2; ++j) { float* o = out + (size_t)m * D + 512 * j + 8 * lane;
            *(f32x4*)o = (f32x4){v[8 * j + 0] * rstd * gv[8 * j + 0], v[8 * j + 1] * rstd * gv[8 * j + 1], v[8 * j + 2] * rstd * gv[8 * j + 2], v[8 * j + 3] * rstd * gv[8 * j + 3]};
            *(f32x4*)(o + 4) = (f32x4){v[8 * j + 4] * rstd * gv[8 * j + 4], v[8 * j + 5] * rstd * gv[8 * j + 5], v[8 * j + 6] * rstd * gv[8 * j + 6], v[8 * j + 7] * rstd * gv[8 * j + 7]}; }
    }
}

__device__ __forceinline__ float oct_sum(float v) { v += swz_xor<1>(v); v += swz_xor<2>(v); v += swz_xor<4>(v); return v; }

__device__ __forceinline__ void post1_phase(bf16_t* Z, int Smask, const float* gq, const float* gk, const float* gcq, const float* gckv, int wave, int lane) {
    const int gw = blockIdx.x * NWAVES + wave, NGW = gridDim.x * NWAVES;
    const int sub = lane & 7, hq = lane >> 3;
    float invf[4], gq0[4], gq1[4], gk0[4], gk1[4];
#pragma unroll
    for (int e = 0; e < 4; ++e) { const int i = 4 * sub + e; invf[e] = exp2f(-(float)i * (LOG2_THETA / 32.0f)); gq0[e] = gq[i]; gq1[e] = gq[i + 32]; gk0[e] = gk[i]; gk1[e] = gk[i + 32]; }
    const float gc0 = gcq[4 * lane], gc1 = gcq[4 * lane + 1], gc2 = gcq[4 * lane + 2], gc3 = gcq[4 * lane + 3];
    const float gv0 = gckv[2 * lane], gv1 = gckv[2 * lane + 1];
    const bool kact = lane < 16;
    for (int m = gw; m < GM; m += NGW) {
        bf16_t* z = Z + (size_t)m * ZW;
        u32x2* pq0 = (u32x2*)(z + hq * 64 + 4 * sub); u32x2* pq1 = (u32x2*)(z + hq * 64 + 32 + 4 * sub);
        u32x2* pk0 = (u32x2*)(z + 512 + (hq & 1) * 64 + 4 * sub); u32x2* pk1 = (u32x2*)(z + 512 + (hq & 1) * 64 + 32 + 4 * sub);
        u32x2* pc = (u32x2*)(z + 768) + lane; unsigned* pv = (unsigned*)(z + 1024) + lane;
        const u32x2 wq0 = *pq0, wq1 = *pq1, wk0 = *pk0, wk1 = *pk1, wc = *pc; const unsigned wv = *pv;
        const float pos = (float)(m & Smask);
        float sn[4], cs[4];
#pragma unroll
        for (int e = 0; e < 4; ++e) sincosf(pos * invf[e], &sn[e], &cs[e]);
        {
            const float a[4] = {bflo(wq0.x), bfhi(wq0.x), bflo(wq0.y), bfhi(wq0.y)}, b[4] = {bflo(wq1.x), bfhi(wq1.x), bflo(wq1.y), bfhi(wq1.y)};
            float ss = 0.f;
#pragma unroll
            for (int e = 0; e < 4; ++e) ss += a[e] * a[e] + b[e] * b[e];
            const float rstd = 1.0f / sqrtf(oct_sum(ss) * (1.0f / 64.0f) + EPS) * (0.125f * LOG2E);
            float o0[4], o1[4];
#pragma unroll
            for (int e = 0; e < 4; ++e) { const float y1 = a[e] * rstd * gq0[e], y2 = b[e] * rstd * gq1[e]; o0[e] = y1 * cs[e] - y2 * sn[e]; o1[e] = y2 * cs[e] + y1 * sn[e]; }
            u32x2 w; w.x = pk2(o0[0], o0[1]); w.y = pk2(o0[2], o0[3]); *pq0 = w; w.x = pk2(o1[0], o1[1]); w.y = pk2(o1[2], o1[3]); *pq1 = w;
        }
        {
            const float a[4] = {bflo(wk0.x), bfhi(wk0.x), bflo(wk0.y), bfhi(wk0.y)}, b[4] = {bflo(wk1.x), bfhi(wk1.x), bflo(wk1.y), bfhi(wk1.y)};
            float ss = 0.f;
#pragma unroll
            for (int e = 0; e < 4; ++e) ss += a[e] * a[e] + b[e] * b[e];
            const float rstd = 1.0f / sqrtf(oct_sum(ss) * (1.0f / 64.0f) + EPS);
            float o0[4], o1[4];
#pragma unroll
            for (int e = 0; e < 4; ++e) { const float y1 = a[e] * rstd * gk0[e], y2 = b[e] * rstd * gk1[e]; o0[e] = y1 * cs[e] - y2 * sn[e]; o1[e] = y2 * cs[e] + y1 * sn[e]; }
            if (kact) { u32x2 w; w.x = pk2(o0[0], o0[1]); w.y = pk2(o0[2], o0[3]); *pk0 = w; w.x = pk2(o1[0], o1[1]); w.y = pk2(o1[2], o1[3]); *pk1 = w; }
        }
        {
            const float a0 = bflo(wc.x), a1 = bfhi(wc.x), a2 = bflo(wc.y), a3 = bfhi(wc.y);
            const float rstd = 1.0f / sqrtf(wave_sum((a0 * a0 + a1 * a1) + (a2 * a2 + a3 * a3)) * (1.0f / 256.0f) + EPS);
            u32x2 o; o.x = pk2(a0 * rstd * gc0, a1 * rstd * gc1); o.y = pk2(a2 * rstd * gc2, a3 * rstd * gc3); *pc = o;
        }
        {
            const float a0 = bflo(wv), a1 = bfhi(wv);
            const float rstd = 1.0f / sqrtf(wave_sum(a0 * a0 + a1 * a1) * (1.0f / 128.0f) + EPS);
            *pv = pk2(a0 * rstd * gv0, a1 * rstd * gv1);
        }
    }
}

__device__ __forceinline__ void post2_phase(bf16_t* QB, const bf16_t* KV, const bf16_t* Z, bf16_t* KB, int Smask, const float* gq, const float* gk, int wave, int lane) {
    const int gw = blockIdx.x * NWAVES + wave, NGW = gridDim.x * NWAVES;
    const int sub = lane & 7, h = lane >> 3;
    float gqn[8], gkn[8], gqr[4], gkr[4], invf[2];
#pragma unroll
    for (int e = 0; e < 8; ++e) { gqn[e] = gq[8 * sub + e]; gkn[e] = gk[8 * sub + e]; }
#pragma unroll
    for (int e = 0; e < 2; ++e) { const int i = 2 * sub + e; invf[e] = exp2f(-(float)i * (LOG2_THETA / 16.0f)); gqr[e] = gq[64 + i]; gqr[2 + e] = gq[80 + i]; gkr[e] = gk[64 + i]; gkr[2 + e] = gk[80 + i]; }
    const float qscl = 0.10206207261596577f * LOG2E;
    for (int m = gw; m < GM; m += NGW) {
        bf16_t* q = QB + (size_t)m * 768 + h * 96; const bf16_t* kv = KV + (size_t)m * 1024 + h * 128; bf16_t* kb = KB + (size_t)m * 768 + h * 96;
        const bf16_t* kr = Z + (size_t)m * ZW + 1152;
        const u32x4 wq = *(const u32x4*)(q + 8 * sub); const unsigned wqa = *(const unsigned*)(q + 64 + 2 * sub), wqb = *(const unsigned*)(q + 80 + 2 * sub);
        const u32x4 wk = *(const u32x4*)(kv + 8 * sub); const unsigned wka = *(const unsigned*)(kr + 2 * sub), wkb = *(const unsigned*)(kr + 16 + 2 * sub);
        const float pos = (float)(m & Smask);
        float sn[2], cs[2];
#pragma unroll
        for (int e = 0; e < 2; ++e) sincosf(pos * invf[e], &sn[e], &cs[e]);
        {
            const float n[8] = {bflo(wq.x), bfhi(wq.x), bflo(wq.y), bfhi(wq.y), bflo(wq.z), bfhi(wq.z), bflo(wq.w), bfhi(wq.w)};
            const float r0[2] = {bflo(wqa), bfhi(wqa)}, r1[2] = {bflo(wqb), bfhi(wqb)};
            float ss = r0[0] * r0[0] + r0[1] * r0[1] + r1[0] * r1[0] + r1[1] * r1[1];
#pragma unroll
            for (int e = 0; e < 8; ++e) ss += n[e] * n[e];
            const float rstd = 1.0f / sqrtf(oct_sum(ss) * (1.0f / 96.0f) + EPS) * qscl;
            u32x4 o; o.x = pk2(n[0] * rstd * gqn[0], n[1] * rstd * gqn[1]); o.y = pk2(n[2] * rstd * gqn[2], n[3] * rstd * gqn[3]);
            o.z = pk2(n[4] * rstd * gqn[4], n[5] * rstd * gqn[5]); o.w = pk2(n[6] * rstd * gqn[6], n[7] * rstd * gqn[7]);
            float a[2], b[2];
#pragma unroll
            for (int e = 0; e < 2; ++e) { const float y0 = r0[e] * rstd * gqr[e], y1 = r1[e] * rstd * gqr[2 + e]; a[e] = y0 * cs[e] - y1 * sn[e]; b[e] = y1 * cs[e] + y0 * sn[e]; }
            *(u32x4*)(q + 8 * sub) = o; *(unsigned*)(q + 64 + 2 * sub) = pk2(a[0], a[1]); *(unsigned*)(q + 80 + 2 * sub) = pk2(b[0], b[1]);
        }
        {
            const float n[8] = {bflo(wk.x), bfhi(wk.x), bflo(wk.y), bfhi(wk.y), bflo(wk.z), bfhi(wk.z), bflo(wk.w), bfhi(wk.w)};
            const float r0[2] = {bflo(wka), bfhi(wka)}, r1[2] = {bflo(wkb), bfhi(wkb)};
            float ss = r0[0] * r0[0] + r0[1] * r0[1] + r1[0] * r1[0] + r1[1] * r1[1];
#pragma unroll
            for (int e = 0; e < 8; ++e) ss += n[e] * n[e];
            const float rstd = 1.0f / sqrtf(oct_sum(ss) * (1.0f / 96.0f) + EPS);
            u32x4 o; o.x = pk2(n[0] * rstd * gkn[0], n[1] * rstd * gkn[1]); o.y = pk2(n[2] * rstd * gkn[2], n[3] * rstd * gkn[3]);
            o.z = pk2(n[4] * rstd * gkn[4], n[5] * rstd * gkn[5]); o.w = pk2(n[6] * rstd * gkn[6], n[7] * rstd * gkn[7]);
            float a[2], b[2];
#pragma unroll
            for (int e = 0; e < 2; ++e) { const float y0 = r0[e] * rstd * gkr[e], y1 = r1[e] * rstd * gkr[2 + e]; a[e] = y0 * cs[e] - y1 * sn[e]; b[e] = y1 * cs[e] + y0 * sn[e]; }
            *(u32x4*)(kb + 8 * sub) = o; *(unsigned*)(kb + 64 + 2 * sub) = pk2(a[0], a[1]); *(unsigned*)(kb + 80 + 2 * sub) = pk2(b[0], b[1]);
        }
    }
}

#define XB_TMO      128
#define XB_XCNT(j)  (256  + 64 * (j))
#define XB_XSUB(j)  (1280 + 64 * (j))
#define XB_XGEN(j)  (2304 + 64 * (j))
#define XB_TOP      3328
#define XB_TOPGEN   3392
#define XCD_BAR_WORDS 3456
#define XB_SPIN_CAP (1u << 22)

__device__ __forceinline__ unsigned xb_ld(unsigned* p)              { return __hip_atomic_load(p, __ATOMIC_RELAXED, __HIP_MEMORY_SCOPE_AGENT); }
__device__ __forceinline__ unsigned xb_add(unsigned* p, unsigned v) { return __hip_atomic_fetch_add(p, v, __ATOMIC_RELAXED, __HIP_MEMORY_SCOPE_AGENT); }
__device__ __forceinline__ unsigned xb_xcc_id() { return (unsigned)__builtin_amdgcn_s_getreg((3 << 11) | 20) & 0xFu; }
#define XB_SPIN(cond, bar) do { unsigned _sp = 0; while (cond) { __builtin_amdgcn_s_sleep(1); \
    if ((++_sp & 255u) == 0u) { if (xb_ld(&(bar)[XB_TMO])) break; if (_sp > XB_SPIN_CAP) { atomicAdd(&(bar)[XB_TMO], 1u); break; } } } } while (0)

struct XcdBarrier {
    unsigned* bar; unsigned x;
    volatile LAS unsigned* st;
};

__device__ __forceinline__ XcdBarrier xcd_barrier_post(unsigned* bar, volatile LAS unsigned* st, bool leader) {
    XcdBarrier b; b.bar = bar; b.x = xb_xcc_id(); b.st = st;
    if (leader) (void)xb_add(&bar[XB_XCNT(b.x)], 1u);
    return b;
}
__device__ __forceinline__ void xcd_barrier_complete(unsigned* bar, unsigned x, unsigned& nloc, unsigned& nx) {
    const unsigned G = gridDim.x * gridDim.y * gridDim.z;
    unsigned sum, cnt, mine, sp = 0u;
    for (;;) {
        sum = 0u; cnt = 0u; mine = 0u;
#pragma unroll
        for (unsigned j = 0; j < 16; ++j) { const unsigned c = xb_ld(&bar[XB_XCNT(j)]); sum += c; cnt += (c > 0u) ? 1u : 0u; mine = (j == x) ? c : mine; }
        if (sum == G) break;
        __builtin_amdgcn_s_sleep(1);
        if ((++sp & 255u) == 0u) { if (xb_ld(&bar[XB_TMO])) break; if (sp > XB_SPIN_CAP) { atomicAdd(&bar[XB_TMO], 1u); break; } }
    }
    nloc = mine > 0u ? mine : 1u; nx = cnt > 0u ? cnt : 1u;
}

__device__ __forceinline__ void xcd_barrier(const XcdBarrier& b, bool leader) {
    asm volatile("s_waitcnt vmcnt(0)" ::: "memory");
    __syncthreads();
    if (leader) {
        unsigned* bar = b.bar;
        __builtin_amdgcn_s_waitcnt(0);
        unsigned nloc = b.st[0], nx = b.st[1];
        if (nloc == 0u) { xcd_barrier_complete(bar, b.x, nloc, nx); b.st[0] = nloc; b.st[1] = nx; }
        const unsigned old = xb_add(&bar[XB_XSUB(b.x)], 1u);
        const unsigned gen = old / nloc;
        if (old + 1u == (gen + 1u) * nloc) {
            __builtin_amdgcn_fence(__ATOMIC_RELEASE, "agent");
            asm volatile("s_waitcnt vmcnt(0)" ::: "memory");
            const unsigned og = xb_add(&bar[XB_TOP], 1u);
            const unsigned tg = og / nx;
            if (og + 1u == (tg + 1u) * nx) xb_add(&bar[XB_TOPGEN], 1u);
            else XB_SPIN(xb_ld(&bar[XB_TOPGEN]) == tg, bar);
            __builtin_amdgcn_fence(__ATOMIC_ACQUIRE, "agent");
            xb_add(&bar[XB_XGEN(b.x)], 1u);
            asm volatile("s_waitcnt vmcnt(0)" ::: "memory");
        } else {
            XB_SPIN(xb_ld(&bar[XB_XGEN(b.x)]) == gen, bar);
            __builtin_amdgcn_fence(__ATOMIC_ACQUIRE, "agent");
            asm volatile("s_waitcnt vmcnt(0)" ::: "memory");
        }
    }
    __syncthreads();
}

__device__ __forceinline__ int crow(int r, int hi) { return (r & 3) + 8 * (r >> 2) + 4 * hi; }
#define MFMA32(a, b, c) __builtin_amdgcn_mfma_f32_32x32x16_bf16((a), (b), (c), 0, 0, 0)
constexpr int ATT_VP = 192;
template <int DQ> struct AttnCfg { static constexpr int KP = DQ * 2 + 16, KBUF = 64 * KP, VBUF = 64 * ATT_VP, CPR = DQ / 8, NKCH = 64 * CPR; };

template <int DQ, bool SWA>
__device__ __forceinline__ void attn_unit(const bf16_t* Qp, int ldq, const bf16_t* Kp, int ldk, const bf16_t* Vp, int ldv, bf16_t* Op, int ldo,
                                          int S, int q0, float sink_l2, LAS unsigned char* lds, int tid, int wave, int lane) {
    typedef AttnCfg<DQ> C;
    constexpr int NKS = DQ / 16;
    LAS unsigned char* Kb = lds;
    LAS unsigned char* Vb = lds + 2 * C::KBUF;
    LAS float* scr = (LAS float*)(lds + 2 * C::KBUF + 3 * C::VBUF) + wave * 64;
    const int r = lane & 31, h = lane >> 5;
    const int qw = q0 + wave * 32;
    const bool late = wave >= 4;
    bf16x8 qf[NKS];
#pragma unroll
    for (int ks = 0; ks < NKS; ++ks) qf[ks] = *(const bf16x8*)(Qp + (size_t)(qw + r) * ldq + 16 * ks + 8 * h);
    int t_lo = 0, t_hi = S / 64;
    if (SWA) { const int lo = q0 - 128 < 0 ? 0 : q0 - 128, hi = q0 + 384 > S ? S : q0 + 384; t_lo = lo / 64; t_hi = hi / 64; }
    const int vrow = tid >> 3, vch = tid & 7;
    const int k0row = tid / C::CPR, k0ch = tid % C::CPR;
    const int k1idx = tid + 512; const bool k1on = k1idx < C::NKCH; const int k1row = k1idx / C::CPR, k1ch = k1idx % C::CPR;
    u32x4 rv, rk0, rk1 = (u32x4){0u, 0u, 0u, 0u};
    const unsigned vofs = (unsigned)(vrow * ldv + vch * 8), k0ofs = (unsigned)(k0row * ldk + k0ch * 8), k1ofs = (unsigned)(k1row * ldk + k1ch * 8);
#define ATT_GLOAD(t) do { const bf16_t* Vt_ = Vp + (size_t)(t) * 64 * ldv; const bf16_t* Kt_ = Kp + (size_t)(t) * 64 * ldk; \
        rv = *(const u32x4*)(Vt_ + vofs); rk0 = *(const u32x4*)(Kt_ + k0ofs); if (k1on) rk1 = *(const u32x4*)(Kt_ + k1ofs); } while (0)
#define ATT_LSTORE(kbyte, vbyte) do { *(LAS u32x4*)(Vb + (vbyte) + vrow * ATT_VP + vch * 16) = rv; \
        *(LAS u32x4*)(Kb + (kbyte) + k0row * C::KP + k0ch * 16) = rk0; \
        if (k1on) *(LAS u32x4*)(Kb + (kbyte) + k1row * C::KP + k1ch * 16) = rk1; } while (0)
    float mref = SWA ? sink_l2 : 0.0f;
    f32x16 o0, o1, o2, negm;
#pragma unroll
    for (int i = 0; i < 16; ++i) { o0[i] = 0.f; o1[i] = 0.f; o2[i] = 0.f; negm[i] = -mref; }
    const bf16x8 ones = (bf16x8){0x3F80, 0x3F80, 0x3F80, 0x3F80, 0x3F80, 0x3F80, 0x3F80, 0x3F80};
    bf16x8 pf[4] = {ones, ones, ones, ones};
    bool pend = false;
    const int koff = r * C::KP + 16 * h;
    const int voff = (4 * h + ((lane & 15) >> 2)) * ATT_VP + ((lane >> 4) & 1) * 32 + (lane & 3) * 8;
    auto pv = [&](const int vbyte) __attribute__((always_inline)) {
        const LAS unsigned char* vb = Vb + vbyte + voff;
        v4i16_t vl0[4], vh0[4], vl1[4], vh1[4];
#pragma unroll
        for (int s = 0; s < 4; ++s) {
            vl0[s] = __builtin_amdgcn_ds_read_tr16_b64_v4i16((LAS v4i16_t*)(vb + (16 * s) * ATT_VP));
            vh0[s] = __builtin_amdgcn_ds_read_tr16_b64_v4i16((LAS v4i16_t*)(vb + (16 * s + 8) * ATT_VP));
            vl1[s] = __builtin_amdgcn_ds_read_tr16_b64_v4i16((LAS v4i16_t*)(vb + (16 * s) * ATT_VP + 64));
            vh1[s] = __builtin_amdgcn_ds_read_tr16_b64_v4i16((LAS v4i16_t*)(vb + (16 * s + 8) * ATT_VP + 64));
        }
        __builtin_amdgcn_sched_barrier(0);
#pragma unroll
        for (int s = 0; s < 4; ++s) {
            const bf16x8 v0 = (bf16x8){vl0[s][0], vl0[s][1], vl0[s][2], vl0[s][3], vh0[s][0], vh0[s][1], vh0[s][2], vh0[s][3]};
            const bf16x8 v1 = (bf16x8){vl1[s][0], vl1[s][1], vl1[s][2], vl1[s][3], vh1[s][0], vh1[s][1], vh1[s][2], vh1[s][3]};
            o0 = MFMA32(pf[s], v0, o0);
            o1 = MFMA32(pf[s], v1, o1);
            o2 = MFMA32(pf[s], ones, o2);
        }
        __builtin_amdgcn_sched_barrier(0);
    };
    ATT_GLOAD(t_lo); ATT_LSTORE(0, 0);
    if (t_lo + 1 < t_hi) ATT_GLOAD(t_lo + 1);
    __syncthreads();
    int vprev = 2 * C::VBUF, vcur = 0, vnext = C::VBUF;
    auto step = [&](const int t, const int kcur) __attribute__((always_inline)) {
        bool need = true;
        if (SWA) need = (64 * t + 63 >= qw - 128) && (64 * t <= qw + 31 + 128);
        if (late && pend) pv(vprev);
        pend = false;
        if (need) {
            const LAS unsigned char* kb = Kb + kcur * C::KBUF + koff;
            bf16x8 ka[NKS], kc[NKS];
#pragma unroll
            for (int ks = 0; ks < NKS; ++ks) { ka[ks] = *(const LAS bf16x8*)(kb + ks * 32); kc[ks] = *(const LAS bf16x8*)(kb + 32 * C::KP + ks * 32); }
            __builtin_amdgcn_sched_barrier(0);
            f32x16 p0 = negm, p1 = negm;
#pragma unroll
            for (int ks = 0; ks < NKS; ++ks) { p0 = MFMA32(ka[ks], qf[ks], p0); p1 = MFMA32(kc[ks], qf[ks], p1); }
            __builtin_amdgcn_sched_barrier(0);
            if (SWA) {
                const int qpos = qw + r, kb0 = 64 * t + 4 * h;
#pragma unroll
                for (int i = 0; i < 16; ++i) { const int kp = kb0 + (i & 3) + 8 * (i >> 2); const int d0_ = kp - qpos, d1_ = d0_ + 32;
                    if (d0_ > 128 || d0_ < -128) p0[i] = -1e30f; if (d1_ > 128 || d1_ < -128) p1[i] = -1e30f; }
            }
            float mx = fmaxf(p0[0], p1[0]);
#pragma unroll
            for (int i = 1; i < 16; ++i) mx = fmaxf(mx, fmaxf(p0[i], p1[i]));
            mx = xhalf_max(mx);
            if (__any(mx > 8.0f)) {
                const float dl = fmaxf(mx, 0.0f), alpha = __builtin_amdgcn_exp2f(-dl);
                mref += dl;
#pragma unroll
                for (int i = 0; i < 16; ++i) { p0[i] -= dl; p1[i] -= dl; negm[i] = -mref; }
                if (h == 0) scr[r] = alpha;
                asm volatile("s_waitcnt lgkmcnt(0)" ::: "memory");
#pragma unroll
                for (int g = 0; g < 4; ++g) { const f32x4 av = *(const LAS f32x4*)(scr + 8 * g + 4 * h);
#pragma unroll
                    for (int j = 0; j < 4; ++j) { o0[4 * g + j] *= av[j]; o1[4 * g + j] *= av[j]; o2[4 * g + j] *= av[j]; } }
                asm volatile("s_waitcnt lgkmcnt(0)" ::: "memory");
            }
#pragma unroll
            for (int i = 0; i < 16; ++i) { p0[i] = __builtin_amdgcn_exp2f(p0[i]); p1[i] = __builtin_amdgcn_exp2f(p1[i]); }
#pragma unroll
            for (int s2 = 0; s2 < 2; ++s2) {
                u32x4 w0, w1;
                w0.x = pk2(p0[8 * s2 + 0], p0[8 * s2 + 1]); w0.y = pk2(p0[8 * s2 + 2], p0[8 * s2 + 3]); w0.z = pk2(p0[8 * s2 + 4], p0[8 * s2 + 5]); w0.w = pk2(p0[8 * s2 + 6], p0[8 * s2 + 7]);
                w1.x = pk2(p1[8 * s2 + 0], p1[8 * s2 + 1]); w1.y = pk2(p1[8 * s2 + 2], p1[8 * s2 + 3]); w1.z = pk2(p1[8 * s2 + 4], p1[8 * s2 + 5]); w1.w = pk2(p1[8 * s2 + 6], p1[8 * s2 + 7]);
                pf[s2] = __builtin_bit_cast(bf16x8, w0); pf[2 + s2] = __builtin_bit_cast(bf16x8, w1);
            }
            __builtin_amdgcn_sched_barrier(0);
            if (!late) pv(vcur); else pend = true;
        }
        if (t + 1 < t_hi) ATT_LSTORE((kcur ^ 1) * C::KBUF, vnext);
        if (t + 2 < t_hi) ATT_GLOAD(t + 2);
        { const int tmp = vprev; vprev = vcur; vcur = vnext; vnext = tmp; }
        __syncthreads();
    };
    for (int t = t_lo; t < t_hi; t += 2) { step(t, 0); step(t + 1, 1); }
    if (late && pend) pv(vprev);
    if (SWA) { if (h == 0) scr[r] = __builtin_amdgcn_exp2f(sink_l2 - mref); asm volatile("s_waitcnt lgkmcnt(0)" ::: "memory"); }
#pragma unroll
    for (int g = 0; g < 4; ++g) { f32x4 sv = (f32x4){0.f, 0.f, 0.f, 0.f}; if (SWA) sv = *(const LAS f32x4*)(scr + 8 * g + 4 * h);
#pragma unroll
        for (int j = 0; j < 4; ++j) { const int q = qw + 8 * g + 4 * h + j; bf16_t* op = Op + (size_t)q * ldo + r; const float rl = 1.0f / (o2[4 * g + j] + sv[j]);
            op[0] = (bf16_t)f2bf(o0[4 * g + j] * rl); op[32] = (bf16_t)f2bf(o1[4 * g + j] * rl); } }
    asm volatile("s_waitcnt lgkmcnt(0)" ::: "memory");
    __syncthreads();
#undef ATT_GLOAD
#undef ATT_LSTORE
}

template <class Epi>
__device__ __forceinline__ void run_gemm(LAS unsigned char* lds, const bf16_t* A, int lda, const bf16_t* Bt, int N, int K, const Epi& E, int tid) {
    int bx = (int)blockIdx.x; asm volatile("" : "+s"(bx), "+s"(A), "+s"(Bt));
    pg8::Gemm g{A, Bt, GM, N, K, lda}; pg8::StaticOrder S; S.init(GM, N, (int)gridDim.x, bx);
    pg8::gemm_phase<Epi, pg8::StaticOrder, true, true>(lds, g, S, E, tid);
}

typedef const Args __attribute__((address_space(4)))* KArgs;
#define PHASE_BEGIN() KArgs ap = (KArgs)__builtin_amdgcn_kernarg_segment_ptr(); asm volatile("" : "+s"(ap)); \
    unsigned char* ws = ap->ws; (void)ws; \
    int lane; asm volatile("v_mbcnt_lo_u32_b32 %0, -1, 0\n\tv_mbcnt_hi_u32_b32 %0, -1, %0" : "=v"(lane)); const int wave = wave_s, tid = wave_s * 64 + lane; (void)tid; \
    const float* xin = ap->in[g]; (void)xin; float* out = ap->out + (size_t)g * GM * D; (void)out; \
    const float* mod = (const float*)(ws + WS_MOD) + (size_t)(g ? 4 : 0) * MODW; (void)mod; \
    const int S = g ? 4096 : 8192, seq_shift = g ? 12 : 13, nseq = g ? 8 : 4; (void)S; (void)seq_shift; (void)nseq
#define WSP(off) ((bf16_t*)(ws + (off)))

__global__ void __launch_bounds__(NT, 2) fwd_kernel(Args a) {
    extern __shared__ __attribute__((aligned(16))) unsigned char lds_raw[];
    cg::grid_group grid = cg::this_grid();
    LAS unsigned char* lds = (LAS unsigned char*)lds_raw;
    const int wave_s = __builtin_amdgcn_readfirstlane((int)threadIdx.x >> 6);
    volatile LAS unsigned* bar_st = (volatile LAS unsigned*)(lds + 131072);
    if (threadIdx.x < 2) bar_st[threadIdx.x] = 0u;
    __syncthreads();
    { const int g = 0; PHASE_BEGIN(); (void)xcd_barrier_post((unsigned*)(ws + WS_BAR), bar_st, tid == 0); phase0(ap, lds, tid, wave, lane); }
    grid.sync();
#define SEAM() do { const int g = 0; PHASE_BEGIN(); XcdBarrier b_; b_.bar = (unsigned*)(ws + WS_BAR); b_.x = xb_xcc_id(); b_.st = bar_st; xcd_barrier(b_, tid == 0); } while (0)

    for (int g = 0; g < 2; ++g) {
        { PHASE_BEGIN(); norm_mod_phase(xin, ap->in[6], mod, 0, seq_shift, WSP(WS_H), wave, lane); }
        SEAM();
        { PHASE_BEGIN(); run_gemm(lds, WSP(WS_H), D, WSP(WS_WGU1), 2 * FF, D, pg8::EpiSwiGLU{WSP(WS_ACT), FF}, tid); }
        SEAM();
        { PHASE_BEGIN(); run_gemm(lds, WSP(WS_ACT), FF, WSP(WS_WD1), D, FF, pg8::EpiResid<true>{xin, WSP(WS_XB), mod + 2 * D, seq_shift, 0.5f}, tid); }
        SEAM();
        { PHASE_BEGIN(); norm_mod_phase((const bf16_t*)WSP(WS_XB), ap->in[10], mod, 3 * D, seq_shift, WSP(WS_H), wave, lane); }
        SEAM();
        { PHASE_BEGIN(); run_gemm(lds, WSP(WS_H), D, WSP(WS_WIN), ZW, D, pg8::EpiPlain{WSP(WS_Z), ZW}, tid); }
        SEAM();
        { PHASE_BEGIN(); post1_phase(WSP(WS_Z), S - 1, ap->in[12], ap->in[13], ap->in[15], ap->in[17], wave, lane); }
        SEAM();
        { PHASE_BEGIN(); run_gemm(lds, WSP(WS_Z) + 768, ZW, WSP(WS_WUQ), 768, 256, pg8::EpiPlain{WSP(WS_QB), 768}, tid); }
        { PHASE_BEGIN(); run_gemm(lds, WSP(WS_Z) + 1024, ZW, WSP(WS_WUKV), 1024, 256, pg8::EpiPlain{WSP(WS_KV), 1024}, tid); }
        SEAM();
        { PHASE_BEGIN(); post2_phase(WSP(WS_QB), WSP(WS_KV), WSP(WS_Z), WSP(WS_KB), S - 1, ap->in[19], ap->in[20], wave, lane); }
        SEAM();
        {
            PHASE_BEGIN();
            bf16_t* H = WSP(WS_H); bf16_t* Z = WSP(WS_Z); bf16_t* QB = WSP(WS_QB); bf16_t* KV = WSP(WS_KV); bf16_t* KB = WSP(WS_KB);
            const int nqb = S / 256, nunits = nseq * 8 * nqb;
            const int G = (int)gridDim.x, bx = (int)blockIdx.x;
            const int vcu = (G % 8 == 0) ? (bx % 8) * (G / 8) + bx / 8 : bx;
            for (int u = vcu; u < 2 * nunits; u += G) {
                const bool dense = u < nunits; const int uu = dense ? u : u - nunits;
                const int qb = uu % nqb, hd = (uu / nqb) & 7, s = uu / (nqb * 8);
                const size_t r0 = (size_t)s * S;
                if (dense)
                    attn_unit<96, false>(QB + r0 * 768 + hd * 96, 768, KB + r0 * 768 + hd * 96, 768, KV + r0 * 1024 + hd * 128 + 64, 1024,
                                         H + r0 * 1024 + 512 + hd * 64, 1024, S, qb * 256, 0.f, lds, tid, wave, lane);
                else
                    attn_unit<64, true>(Z + r0 * ZW + hd * 64, ZW, Z + r0 * ZW + 512 + (hd >> 2) * 64, ZW, Z + r0 * ZW + 640 + (hd >> 2) * 64, ZW,
                                        H + r0 * 1024 + hd * 64, 1024, S, qb * 256, ap->in[14][hd] * LOG2E, lds, tid, wave, lane);
            }
        }
        SEAM();
        { PHASE_BEGIN(); run_gemm(lds, WSP(WS_H), D, WSP(WS_WOUT), D, D, pg8::EpiResid<false>{WSP(WS_XB), WSP(WS_XB), mod + 5 * D, seq_shift, 1.0f}, tid); }
        SEAM();
        { PHASE_BEGIN(); norm_mod_phase((const bf16_t*)WSP(WS_XB), ap->in[22], mod, 6 * D, seq_shift, WSP(WS_H), wave, lane); }
        SEAM();
        { PHASE_BEGIN(); run_gemm(lds, WSP(WS_H), D, WSP(WS_WGU2), 2 * FF, D, pg8::EpiSwiGLU{WSP(WS_ACT), FF}, tid); }
        SEAM();
        { PHASE_BEGIN(); run_gemm(lds, WSP(WS_ACT), FF, WSP(WS_WD2), D, FF, pg8::EpiResid<false>{WSP(WS_XB), WSP(WS_XB), mod + 8 * D, seq_shift, 0.5f}, tid); }
        SEAM();
        { PHASE_BEGIN(); final_norm_phase((const bf16_t*)WSP(WS_XB), out, ap->in[26], wave, lane); }
    }
}

extern "C" void kernel_launch(void* const* d_in, const int* in_sizes, int n_in, void* d_out, int out_size, void* d_ws, size_t ws_size, hipStream_t stream) {
    static int grid = 0;
    if (grid == 0) {
        int dev = 0, cus = 0, per_cu = 0;
        hipGetDevice(&dev);
        hipDeviceGetAttribute(&cus, hipDeviceAttributeMultiprocessorCount, dev);
        hipFuncSetAttribute((const void*)fwd_kernel, hipFuncAttributeMaxDynamicSharedMemorySize, LDS_BYTES);
        hipOccupancyMaxActiveBlocksPerMultiprocessor(&per_cu, (const void*)fwd_kernel, NT, LDS_BYTES);
        if (per_cu < 1) per_cu = 1;
        if (per_cu > 1) per_cu = 1;
        grid = cus * per_cu;
        if (n_in != 27 || ws_size < WS_END) fprintf(stderr, "kernel_launch: unexpected n_in %d or ws_size %zu\n", n_in, ws_size);
    }
    hipMemsetAsync((char*)d_ws, 0, CTL_ZERO_BYTES, stream);
    Args a{};
    for (int i = 0; i < 27; ++i) a.in[i] = (const float*)d_in[i];
    a.out = (float*)d_out; a.ws = (unsigned char*)d_ws;
    void* args[] = {&a};
    hipError_t e = hipLaunchCooperativeKernel((const void*)fwd_kernel, dim3(grid), dim3(NT), args, LDS_BYTES, stream);
    if (e != hipSuccess) fprintf(stderr, "cooperative launch failed: %s (grid %d)\n", hipGetErrorString(e), grid);
}
```

```cpp
#include <hip/hip_runtime.h>
#include <hip/hip_cooperative_groups.h>
#include <cstdio>
#include <cstdint>
namespace cg = cooperative_groups;
namespace pg8 {
#define PG8_LAS __attribute__((address_space(3)))
typedef unsigned short bf16_t;
typedef short bf16x8 __attribute__((ext_vector_type(8)));
typedef float f32x4 __attribute__((ext_vector_type(4)));
typedef unsigned u32x4 __attribute__((ext_vector_type(4)));
constexpr int BM = 256, BK = 64, HALF = 128, HTB = HALF * BK * 2  , STAGE_BYTES = 8 * HTB, NXCD = 8, WGM = 8;

__host__ __device__ __forceinline__ int lds_byte(int r, int c) { const int st = (r >> 4) * 2 + (c >> 5), rr = r & 15, cc = c & 31, ob = rr * 64 + cc * 2; return st * 1024 + (ob ^ (((ob >> 9) & 1) << 5)); }
__host__ __device__ __forceinline__ void stage_rc(int b, int& R, int& C) { const int st = b / 1024, sb = b % 1024, swz = sb ^ (((sb >> 9) & 1) << 5); R = (st >> 1) * 16 + swz / 64; C = (st & 1) * 32 + (swz % 64) / 2; }
__host__ __device__ __forceinline__ int perm32(int rho) { const int n = rho >> 4, i = rho & 15; return 8 * (i >> 2) + 4 * n + (i & 3); }
struct Unit { int pm, pn; };
struct Gemm { const bf16_t* A; const bf16_t* Bt; int M, N, K, lda; };

struct StaticOrder {
    int nM, nN, nwg, G, c;
    __host__ __device__ void init(int M, int N, int G_, int c_) { nM = M / BM; nN = N / BM; nwg = nM * nN; G = G_; c = c_; }
    __host__ __device__ bool next(int i, Unit& u) const {
        const long L = (long)i * G + c; if (L >= nwg) return false;
        int wgid = (int)L; { const int q = nwg / NXCD, r = nwg % NXCD, xcd = wgid % NXCD, off = wgid / NXCD; wgid = (xcd < r ? xcd * (q + 1) : r * (q + 1) + (xcd - r) * q) + off; }
        const int nig = WGM * nN, gid = wgid / nig, fm = gid * WGM, gsz = (nM - fm) < WGM ? (nM - fm) : WGM;
        u.pm = fm + ((wgid % nig) % gsz); u.pn = (wgid % nig) / gsz; return true;
    }
    __device__ __forceinline__ void a_ready(const Unit&) const {}
    __device__ __forceinline__ void done(const Unit&) const {}
};
__device__ __forceinline__ unsigned cvt_pk_bf16(float lo, float hi) { unsigned r; asm volatile("v_cvt_pk_bf16_f32 %0, %1, %2" : "=v"(r) : "v"(lo), "v"(hi)); return r; }
typedef float f32x2 __attribute__((ext_vector_type(2)));
template <class Epi, class Sched, bool ALIGN_EPI = false, bool SP2 = false>
__device__ __forceinline__ void gemm_phase(PG8_LAS unsigned char* lds, const Gemm g, const Sched& S, const Epi& E, int tid_in) {
    int tid_l = tid_in; asm volatile("" : "+v"(tid_l));
    const int tid = tid_l, wid = __builtin_amdgcn_readfirstlane(tid >> 6), lane = tid & 63, wr = wid >> 2, wc = wid & 3, fr = lane & 15, fq = lane >> 4;
    const int K = g.K, nt = K / BK;
    unsigned voffA[2], voffB[2];
#pragma unroll
    for (int i = 0; i < 2; ++i) { int R, C; stage_rc(tid * 16 + i * 8192, R, C); const int Rb = Epi::PERM ? ((R & ~31) + perm32(R & 31)) : R;
        voffA[i] = (unsigned)(R * g.lda + C) * 2u; voffB[i] = (unsigned)(Rb * K + C) * 2u; }
    const size_t kstep = (size_t)(BK * 2);
    const size_t hstep = (size_t)HALF * K * 2;
    const size_t tstep = 2 * hstep;
    const size_t hstepA = (size_t)HALF * g.lda * 2, tstepA = 2 * hstepA;
    const unsigned ldsw = (unsigned)wid * 1024u;
    const int aoff = lds_byte(wr * 64 + fr, fq * 8), boff = lds_byte(wc * 32 + fr, fq * 8);
#define PG8_SA(b, h) (((b) * 2 + (h)) * HTB)
#define PG8_SB(b, h) ((4 + (b) * 2 + (h)) * HTB)
#define PG8_STAGE(bufoff, gbase, voff) do { _Pragma("unroll") for (int _i = 0; _i < 2; ++_i) \
        __builtin_amdgcn_global_load_lds((const unsigned*)((const char*)(gbase) + (voff)[_i]), (PG8_LAS unsigned*)(lds + (bufoff) + ldsw + _i * 8192), 16, 0, 0); } while (0)
#define PG8_LDA(dst, b, h) do { _Pragma("unroll") for (int m = 0; m < 4; ++m) _Pragma("unroll") for (int k = 0; k < 2; ++k) dst[m][k] = *(const PG8_LAS bf16x8*)(lds + PG8_SA(b, h) + aoff + m * 2048 + k * 1024); } while (0)
#define PG8_LDB(dst, b, h) do { _Pragma("unroll") for (int n = 0; n < 2; ++n) _Pragma("unroll") for (int k = 0; k < 2; ++k) dst[n][k] = *(const PG8_LAS bf16x8*)(lds + PG8_SB(b, h) + boff + n * 2048 + k * 1024); } while (0)
#define PG8_MMA(ai, bj, At, Bt) do { __builtin_amdgcn_s_setprio(1); _Pragma("unroll") for (int m = 0; m < 4; ++m) _Pragma("unroll") for (int n = 0; n < 2; ++n) _Pragma("unroll") for (int k = 0; k < 2; ++k) \
        acc[ai][bj][m][n] = __builtin_amdgcn_mfma_f32_16x16x32_bf16(Bt[n][k], At[m][k], acc[ai][bj][m][n], 0, 0, 0); __builtin_amdgcn_s_setprio(0); } while (0)
#define PG8_WAIT_V(n) asm volatile("s_waitcnt vmcnt(" #n ")" ::: "memory")
#define PG8_WAIT_L(n) asm volatile("s_waitcnt lgkmcnt(" #n ")" ::: "memory")
#define PG8_BAR __builtin_amdgcn_s_barrier()
#define PG8_SCHED __builtin_amdgcn_sched_barrier(0)
    Unit cur, nxt; int ui = 0;
    if (!S.next(0, cur)) return;
    f32x4 acc[2][2][4][2];
#pragma unroll
    for (int a = 0; a < 2; ++a)
#pragma unroll
        for (int b = 0; b < 2; ++b)
#pragma unroll
            for (int m = 0; m < 4; ++m)
#pragma unroll
                for (int n = 0; n < 2; ++n) acc[a][b][m][n] = (f32x4){0.f, 0.f, 0.f, 0.f};
    bf16x8 At[4][2], B0[2][2], B1[2][2];
    const char* cA = (const char*)g.A + (size_t)cur.pm * tstepA; const char* cB = (const char*)g.Bt + (size_t)cur.pn * tstep;
    S.a_ready(cur);
    if constexpr (SP2) {
        PG8_STAGE(PG8_SB(0, 0), cB, voffB); PG8_STAGE(PG8_SB(0, 1), cB + hstep, voffB); PG8_STAGE(PG8_SA(0, 0), cA, voffA); PG8_STAGE(PG8_SA(0, 1), cA + hstepA, voffA);
        if (wr == 1) PG8_BAR;
        PG8_WAIT_V(2); PG8_BAR;
        PG8_STAGE(PG8_SB(1, 0), cB + kstep, voffB); PG8_STAGE(PG8_SA(1, 0), cA + kstep, voffA); PG8_STAGE(PG8_SB(1, 1), cB + hstep + kstep, voffB);
        PG8_WAIT_V(6); PG8_BAR;
    } else {
        PG8_STAGE(PG8_SB(0, 0), cB, voffB); PG8_STAGE(PG8_SA(0, 0), cA, voffA); PG8_STAGE(PG8_SB(0, 1), cB + hstep, voffB); PG8_STAGE(PG8_SA(0, 1), cA + hstepA, voffA);
        if (wr == 1) PG8_BAR;
        PG8_WAIT_V(4); PG8_BAR;
        PG8_STAGE(PG8_SB(1, 0), cB + kstep, voffB); PG8_STAGE(PG8_SA(1, 0), cA + kstep, voffA); PG8_STAGE(PG8_SB(1, 1), cB + hstep + kstep, voffB);
        PG8_WAIT_V(6); PG8_BAR;
    }
    for (;;) {
        const bool has_next = S.next(ui + 1, nxt);
        const char* nA = has_next ? (const char*)g.A + (size_t)nxt.pm * tstepA : cA; const char* nB = has_next ? (const char*)g.Bt + (size_t)nxt.pn * tstep : cB;
        for (int t = 0; t < nt; t += 2) {
            const bool last = (t == nt - 2);
            const char* a1 = cA + (size_t)(t + 1) * kstep;
            const char* a2 = last ? nA : cA + (size_t)(t + 2) * kstep; const char* b2 = last ? nB : cB + (size_t)(t + 2) * kstep;
            const char* a3 = a2 + kstep; const char* b3 = b2 + kstep;
            if (last && has_next) S.a_ready(nxt);
            if constexpr (SP2) {
            PG8_LDB(B0, 0, 0); PG8_LDB(B1, 0, 1); PG8_SCHED; PG8_LDA(At, 0, 0); PG8_STAGE(PG8_SA(1, 1), a1 + hstepA, voffA);
            PG8_WAIT_V(8); PG8_WAIT_L(0); PG8_BAR; PG8_MMA(0, 0, At, B0); PG8_MMA(0, 1, At, B1); PG8_BAR; PG8_SCHED;
            PG8_LDA(At, 0, 1); PG8_STAGE(PG8_SB(0, 0), b2, voffB); PG8_STAGE(PG8_SB(0, 1), b2 + hstep, voffB); PG8_STAGE(PG8_SA(0, 0), a2, voffA);
            PG8_WAIT_V(8); PG8_WAIT_L(0); PG8_BAR; PG8_MMA(1, 0, At, B0); PG8_MMA(1, 1, At, B1); PG8_BAR; PG8_SCHED;
            PG8_LDB(B0, 1, 0); PG8_LDB(B1, 1, 1); PG8_SCHED; PG8_LDA(At, 1, 0); PG8_STAGE(PG8_SA(0, 1), a2 + hstepA, voffA);
            PG8_WAIT_V(8); PG8_WAIT_L(0); PG8_BAR; PG8_MMA(0, 0, At, B0); PG8_MMA(0, 1, At, B1); PG8_BAR; PG8_SCHED;
            PG8_LDA(At, 1, 1); PG8_STAGE(PG8_SB(1, 0), b3, voffB); PG8_STAGE(PG8_SB(1, 1), b3 + hstep, voffB); PG8_STAGE(PG8_SA(1, 0), a3, voffA);
            PG8_WAIT_V(8); PG8_WAIT_L(0); PG8_BAR; PG8_MMA(1, 0, At, B0); PG8_MMA(1, 1, At, B1); PG8_BAR; PG8_SCHED;
            } else {
            PG8_LDB(B0, 0, 0); PG8_SCHED; PG8_LDA(At, 0, 0); PG8_STAGE(PG8_SA(1, 1), a1 + hstepA, voffA);
            PG8_WAIT_L(8); PG8_BAR; PG8_WAIT_L(0); PG8_MMA(0, 0, At, B0); PG8_BAR; PG8_SCHED;
            PG8_LDB(B1, 0, 1); PG8_STAGE(PG8_SB(0, 0), b2, voffB);
            PG8_BAR; PG8_WAIT_L(0); PG8_MMA(0, 1, At, B1); PG8_BAR;
            PG8_LDA(At, 0, 1); PG8_STAGE(PG8_SA(0, 0), a2, voffA);
            PG8_BAR; PG8_WAIT_L(0); PG8_MMA(1, 0, At, B0); PG8_BAR; PG8_SCHED;
            PG8_STAGE(PG8_SB(0, 1), b2 + hstep, voffB);
            PG8_WAIT_V(6); PG8_BAR; PG8_MMA(1, 1, At, B1); PG8_BAR;
            PG8_LDB(B0, 1, 0); PG8_SCHED; PG8_LDA(At, 1, 0); PG8_STAGE(PG8_SA(0, 1), a2 + hstepA, voffA);
            PG8_WAIT_L(8); PG8_BAR; PG8_WAIT_L(0); PG8_MMA(0, 0, At, B0); PG8_BAR; PG8_SCHED;
            PG8_LDB(B1, 1, 1); PG8_STAGE(PG8_SB(1, 0), b3, voffB);
            PG8_BAR; PG8_WAIT_L(0); PG8_MMA(0, 1, At, B1); PG8_BAR;
            PG8_LDA(At, 1, 1); PG8_STAGE(PG8_SA(1, 0), a3, voffA);
            PG8_BAR; PG8_WAIT_L(0); PG8_MMA(1, 0, At, B0); PG8_BAR; PG8_SCHED;
            PG8_STAGE(PG8_SB(1, 1), b3 + hstep, voffB);
            PG8_WAIT_V(6); PG8_BAR; PG8_MMA(1, 1, At, B1); PG8_BAR;
            }
        }
        if constexpr (ALIGN_EPI) { if (wr == 0) PG8_BAR; }
        if constexpr (!Epi::AFTER_DRAIN) { E(acc, cur, wr, wc, fr, fq); S.done(cur); }
        if (!has_next) break;
#pragma unroll
        for (int a = 0; a < 2; ++a)
#pragma unroll
            for (int b = 0; b < 2; ++b)
#pragma unroll
                for (int m = 0; m < 4; ++m)
#pragma unroll
                    for (int n = 0; n < 2; ++n) acc[a][b][m][n] = (f32x4){0.f, 0.f, 0.f, 0.f};
        cur = nxt; cA = nA; cB = nB; ++ui;
        if constexpr (ALIGN_EPI) { if (wr == 1) PG8_BAR; }
    }
    PG8_WAIT_V(0);
    if constexpr (!ALIGN_EPI) { if (wr == 0) PG8_BAR; }
    PG8_BAR;
    if constexpr (Epi::AFTER_DRAIN) { E.fused(acc, cur, wr, wc, fr, fq, lds, wid, lane); S.done(cur); }
#undef PG8_SA
#undef PG8_SB
#undef PG8_STAGE
#undef PG8_LDA
#undef PG8_LDB
#undef PG8_MMA
#undef PG8_WAIT_V
#undef PG8_WAIT_L
#undef PG8_BAR
#undef PG8_SCHED
}
}

#define LAS __attribute__((address_space(3)))
typedef unsigned short bf16_t;
typedef short bf16x8 __attribute__((ext_vector_type(8)));
typedef float f32x4 __attribute__((ext_vector_type(4)));
typedef float f32x16 __attribute__((ext_vector_type(16)));
typedef unsigned u32x4 __attribute__((ext_vector_type(4)));
typedef unsigned u32x2 __attribute__((ext_vector_type(2)));
typedef short v4i16_t __attribute__((ext_vector_type(4)));
typedef float f32x2_t __attribute__((ext_vector_type(2)));
typedef __bf16 bf16x2_t __attribute__((ext_vector_type(2)));

constexpr int D = 1024, FF = 2816, NMOD = 9, MODW = NMOD * D;
constexpr int GM = 32768;
constexpr int ZW = 1280;
constexpr int INW = 1184;
constexpr int NWAVES = 8, NT = 512;
constexpr float EPS = 1e-6f;
constexpr float LOG2E = 1.4426950408889634f;
constexpr float LOG2_THETA = 13.287712379549449f;

constexpr size_t MiB = 1u << 20;
constexpr size_t WS_MOD = 0;
constexpr size_t MOD_BYTES = 12 * MODW * 4;
constexpr size_t WS_BAR = 768 * 1024;
constexpr size_t CTL_ZERO_BYTES = 1 * MiB;
constexpr size_t WS_WGU1 = 1 * MiB;
constexpr size_t WS_WD1 = WS_WGU1 + (size_t)5632 * 1024 * 2;
constexpr size_t WS_WGU2 = WS_WD1 + (size_t)1024 * 2816 * 2;
constexpr size_t WS_WD2 = WS_WGU2 + (size_t)5632 * 1024 * 2;
constexpr size_t WS_WIN = WS_WD2 + (size_t)1024 * 2816 * 2;
constexpr size_t WS_WUQ = WS_WIN + (size_t)1280 * 1024 * 2;
constexpr size_t WS_WUKV = WS_WUQ + (size_t)768 * 256 * 2;
constexpr size_t WS_WOUT = WS_WUKV + (size_t)1024 * 256 * 2;
constexpr size_t WS_WEND = WS_WOUT + (size_t)1024 * 1024 * 2;
static_assert(WS_WEND <= 40 * MiB, "weights region");
constexpr size_t WS_H = 40 * MiB;
constexpr size_t WS_B = 104 * MiB;
constexpr size_t WS_ACT = WS_B;
constexpr size_t WS_Z = WS_B;
constexpr size_t WS_QB = WS_Z + (size_t)GM * ZW * 2;
constexpr size_t WS_KV = WS_QB + (size_t)GM * 768 * 2;
constexpr size_t WS_KB = WS_KV + (size_t)GM * 1024 * 2;
constexpr size_t WS_XB = WS_KB + (size_t)GM * 768 * 2;
constexpr size_t WS_END = WS_XB + (size_t)GM * D * 2;
static_assert(WS_END <= 420 * MiB && WS_ACT + (size_t)GM * FF * 2 <= WS_XB, "ws map");

constexpr int LDS_BYTES = 131072 + 4096;

__device__ __forceinline__ unsigned f2bf(float f) { unsigned u = __builtin_bit_cast(unsigned, f); return (u + 0x7fffu + ((u >> 16) & 1u)) >> 16; }
__device__ __forceinline__ unsigned pk2(float lo, float hi) { f32x2_t v = {lo, hi}; bf16x2_t b = __builtin_convertvector(v, bf16x2_t); return __builtin_bit_cast(unsigned, b); }
__device__ __forceinline__ float bf2f(unsigned short b) { return __builtin_bit_cast(float, (unsigned)b << 16); }
__device__ __forceinline__ float bflo(unsigned w) { return __builtin_bit_cast(float, w << 16); }
__device__ __forceinline__ float bfhi(unsigned w) { return __builtin_bit_cast(float, w & 0xffff0000u); }
template <int M> __device__ __forceinline__ float swz_xor(float v) { return __builtin_bit_cast(float, __builtin_amdgcn_ds_swizzle(__builtin_bit_cast(int, v), (M << 10) | 0x1f)); }
__device__ __forceinline__ float half_sum(float v) { v += swz_xor<1>(v); v += swz_xor<2>(v); v += swz_xor<4>(v); v += swz_xor<8>(v); v += swz_xor<16>(v); return v; }
__device__ __forceinline__ void xhalf_pair(float v, float& lo, float& hi) { unsigned a = __builtin_bit_cast(unsigned, v), b = a;
    asm volatile("s_nop 1\n\tv_permlane32_swap_b32 %0, %1\n\ts_nop 1" : "+v"(a), "+v"(b)); lo = __builtin_bit_cast(float, a); hi = __builtin_bit_cast(float, b); }
__device__ __forceinline__ float xhalf_sum(float v) { float lo, hi; xhalf_pair(v, lo, hi); return lo + hi; }
__device__ __forceinline__ float xhalf_max(float v) { float lo, hi; xhalf_pair(v, lo, hi); return fmaxf(lo, hi); }
__device__ __forceinline__ float wave_sum(float v) { return xhalf_sum(half_sum(v)); }

namespace pg8 {
struct EpiPlain {
    static constexpr bool PERM = true, AFTER_DRAIN = false;
    bf16_t* O; int ldc;
    __device__ __forceinline__ void operator()(const f32x4 (&acc)[2][2][4][2], const Unit& u, int wr, int wc, int fr, int fq) const {
        const int row0 = u.pm * BM + wr * 64 + fr, col0 = u.pn * BM + wc * 32 + 8 * fq;
#pragma unroll
        for (int ai = 0; ai < 2; ++ai)
#pragma unroll
            for (int m = 0; m < 4; ++m) { bf16_t* rowp = O + (size_t)(row0 + ai * HALF + m * 16) * ldc + col0;
#pragma unroll
                for (int bj = 0; bj < 2; ++bj) { const f32x4 v0 = acc[ai][bj][m][0], v1 = acc[ai][bj][m][1];
                    u32x4 w; w.x = pk2(v0[0], v0[1]); w.y = pk2(v0[2], v0[3]); w.z = pk2(v1[0], v1[1]); w.w = pk2(v1[2], v1[3]);
                    *(u32x4*)(rowp + bj * HALF) = w; } }
    }
};
__device__ __forceinline__ float silu_mul(float g, float u) { return g * u * __builtin_amdgcn_rcpf(1.0f + __builtin_amdgcn_exp2f(-g * LOG2E)); }
struct EpiSwiGLU {
    static constexpr bool PERM = true, AFTER_DRAIN = false;
    bf16_t* O; int ldc;
    __device__ __forceinline__ void operator()(const f32x4 (&acc)[2][2][4][2], const Unit& u, int wr, int wc, int fr, int fq) const {
        const int row0 = u.pm * BM + wr * 64 + fr, col0 = u.pn * HALF + wc * 32 + 8 * fq;
#pragma unroll
        for (int ai = 0; ai < 2; ++ai)
#pragma unroll
            for (int m = 0; m < 4; ++m) { bf16_t* rowp = O + (size_t)(row0 + ai * HALF + m * 16) * ldc + col0;
                const f32x4 g0 = acc[ai][0][m][0], g1 = acc[ai][0][m][1], u0 = acc[ai][1][m][0], u1 = acc[ai][1][m][1];
                u32x4 w; w.x = pk2(silu_mul(g0[0], u0[0]), silu_mul(g0[1], u0[1])); w.y = pk2(silu_mul(g0[2], u0[2]), silu_mul(g0[3], u0[3]));
                w.z = pk2(silu_mul(g1[0], u1[0]), silu_mul(g1[1], u1[1])); w.w = pk2(silu_mul(g1[2], u1[2]), silu_mul(g1[3], u1[3]));
                *(u32x4*)rowp = w; }
    }
};
template <bool BASE_F32> struct EpiResid {
    static constexpr bool PERM = true, AFTER_DRAIN = false;
    const void* base; bf16_t* out; const float* gate  ; int seq_shift  ; float scale;
    __device__ __forceinline__ void operator()(const f32x4 (&acc)[2][2][4][2], const Unit& u, int wr, int wc, int fr, int fq) const {
        const int row0 = u.pm * BM + wr * 64 + fr, col0 = u.pn * BM + wc * 32 + 8 * fq;
        const float* gp = gate + (size_t)((u.pm * BM) >> seq_shift) * MODW + col0;
#pragma unroll
        for (int bj = 0; bj < 2; ++bj) { const f32x4 g0 = *(const f32x4*)(gp + bj * HALF) * scale, g1 = *(const f32x4*)(gp + bj * HALF + 4) * scale;
#pragma unroll
            for (int ai = 0; ai < 2; ++ai)
#pragma unroll
                for (int m = 0; m < 4; ++m) { const size_t off = (size_t)(row0 + ai * HALF + m * 16) * D + col0 + bj * HALF;
                    f32x4 b0, b1;
                    if (BASE_F32) { b0 = *(const f32x4*)((const float*)base + off); b1 = *(const f32x4*)((const float*)base + off + 4); }
                    else { const u32x4 w = *(const u32x4*)((const bf16_t*)base + off); b0 = (f32x4){bflo(w.x), bfhi(w.x), bflo(w.y), bfhi(w.y)}; b1 = (f32x4){bflo(w.z), bfhi(w.z), bflo(w.w), bfhi(w.w)}; }
                    const f32x4 v0 = b0 + g0 * acc[ai][bj][m][0], v1 = b1 + g1 * acc[ai][bj][m][1];
                    u32x4 o; o.x = pk2(v0[0], v0[1]); o.y = pk2(v0[2], v0[3]); o.z = pk2(v1[0], v1[1]); o.w = pk2(v1[2], v1[3]);
                    *(u32x4*)(out + off) = o; } }
    }
};
}

struct Args { const float* in[27]; float* out; unsigned char* ws; };

__device__ __forceinline__ void transpose_item(const float* W, int K, int N, bf16_t* WT, int mode, LAS float* scr, int item, int lane) {
    const int nblk = N / 32, kb = item / nblk, nb = item % nblk, k0 = 64 * kb, n0 = 32 * nb;
    int d0 = n0;
    if (mode == 1) d0 = (n0 >> 7) * 256 + (n0 & 127);
    else if (mode == 2) d0 = (n0 >> 7) * 256 + 128 + (n0 & 127);
#pragma unroll 8
    for (int i = 0; i < 32; ++i) { const int kk = 2 * i + (lane >> 5); scr[kk * 33 + (lane & 31)] = W[(size_t)(k0 + kk) * N + n0 + (lane & 31)]; }
    asm volatile("s_waitcnt lgkmcnt(0)" ::: "memory");
    const int c = lane & 7;
#pragma unroll
    for (int j = 0; j < 4; ++j) { const int n = (lane >> 3) + 8 * j; const LAS float* s = scr + (8 * c) * 33 + n;
        u32x4 o; o.x = pk2(s[0 * 33], s[1 * 33]); o.y = pk2(s[2 * 33], s[3 * 33]); o.z = pk2(s[4 * 33], s[5 * 33]); o.w = pk2(s[6 * 33], s[7 * 33]);
        *(u32x4*)(WT + (size_t)(d0 + n) * K + k0 + 8 * c) = o; }
    asm volatile("s_waitcnt lgkmcnt(0)" ::: "memory");
}

typedef const Args __attribute__((address_space(4)))* KArgs0;
__device__ __forceinline__ void phase0(KArgs0 ap, LAS unsigned char* lds, int tid, int wave, int lane) {
    unsigned char* ws = ap->ws;
    {
        LAS float* scr = (LAS float*)(lds + wave * 8704);
        const int gw = blockIdx.x * NWAVES + wave, NGW = gridDim.x * NWAVES;
        constexpr int I_G = (D / 64) * (FF / 32), I_D = (FF / 64) * (D / 32), I_IN = (D / 64) * (INW / 32), I_UQ = (256 / 64) * (768 / 32), I_UKV = (128 / 64) * (1024 / 32), I_OUT = (D / 64) * (D / 32);
        constexpr int NITEMS = 4 * I_G + 2 * I_D + I_IN + I_UQ + I_UKV + I_OUT;
        for (int it = gw; it < NITEMS; it += NGW) {
            int r = it;
            if (r < I_G) { transpose_item(ap->in[7], D, FF, (bf16_t*)(ws + WS_WGU1), 1, scr, r, lane); continue; } r -= I_G;
            if (r < I_G) { transpose_item(ap->in[8], D, FF, (bf16_t*)(ws + WS_WGU1), 2, scr, r, lane); continue; } r -= I_G;
            if (r < I_D) { transpose_item(ap->in[9], FF, D, (bf16_t*)(ws + WS_WD1), 0, scr, r, lane); continue; } r -= I_D;
            if (r < I_G) { transpose_item(ap->in[23], D, FF, (bf16_t*)(ws + WS_WGU2), 1, scr, r, lane); continue; } r -= I_G;
            if (r < I_G) { transpose_item(ap->in[24], D, FF, (bf16_t*)(ws + WS_WGU2), 2, scr, r, lane); continue; } r -= I_G;
            if (r < I_D) { transpose_item(ap->in[25], FF, D, (bf16_t*)(ws + WS_WD2), 0, scr, r, lane); continue; } r -= I_D;
            if (r < I_IN) { transpose_item(ap->in[11], D, INW, (bf16_t*)(ws + WS_WIN), 0, scr, r, lane); continue; } r -= I_IN;
            if (r < I_UQ) { transpose_item(ap->in[16], 256, 768, (bf16_t*)(ws + WS_WUQ), 0, scr, r, lane); continue; } r -= I_UQ;
            if (r < I_UKV) { transpose_item(ap->in[18], 256, 1024, (bf16_t*)(ws + WS_WUKV), 0, scr, r, lane); continue; } r -= I_UKV;
            transpose_item(ap->in[21], D, D, (bf16_t*)(ws + WS_WOUT), 0, scr, r, lane);
        }
        { for (int i = blockIdx.x * NT + tid; i < 1024 * 16; i += gridDim.x * NT) *(u32x4*)(ws + WS_WUKV + (size_t)(i >> 4) * 512 + 256 + (i & 15) * 16) = (u32x4){0u, 0u, 0u, 0u}; }
        { u32x4* p = (u32x4*)(ws + WS_WIN + (size_t)INW * D * 2); const int n16 = (ZW - INW) * D * 2 / 16;
          for (int i = blockIdx.x * NT + tid; i < n16; i += gridDim.x * NT) p[i] = (u32x4){0u, 0u, 0u, 0u}; }
    }
    __syncthreads();
    {
        LAS float* sc = (LAS float*)lds;
        float* mod = (float*)(ws + WS_MOD);
        const float* adaw = ap->in[4]; const float* adab = ap->in[5];
        for (int item = blockIdx.x; item < 18 * 16; item += gridDim.x) {
            const int cb = item % 18, kc = item / 18;
            __syncthreads();
            for (int i = tid; i < 12 * 64; i += NT) { const int s = i >> 6, kk = i & 63;
                const float c = (s < 4) ? ap->in[2][s * D + kc * 64 + kk] : ap->in[3][(s - 4) * D + kc * 64 + kk];
                sc[i] = c / (1.0f + __expf(-c)); }
            __syncthreads();
            const int col = cb * 512 + tid;
            float acc[12];
#pragma unroll
            for (int s = 0; s < 12; ++s) acc[s] = 0.f;
            const float* wp = adaw + (size_t)(kc * 64) * MODW + col;
#pragma unroll 32
            for (int kk = 0; kk < 64; ++kk) { const float w = wp[(size_t)kk * MODW];
#pragma unroll
                for (int s = 0; s < 12; ++s) acc[s] += sc[s * 64 + kk] * w; }
            const float b = (kc == 0) ? adab[col] : 0.f;
#pragma unroll
            for (int s = 0; s < 12; ++s) atomicAdd(mod + s * MODW + col, acc[s] + b);
        }
    }
}

__device__ __forceinline__ void load_row16(const float* x, int lane, float (&v)[16]) {
#pragma unroll
    for (int j = 0; j < 2; ++j) { const f32x4 a = *(const f32x4*)(x + 512 * j + 8 * lane), b = *(const f32x4*)(x + 512 * j + 8 * lane + 4);
        v[8 * j + 0] = a.x; v[8 * j + 1] = a.y; v[8 * j + 2] = a.z; v[8 * j + 3] = a.w; v[8 * j + 4] = b.x; v[8 * j + 5] = b.y; v[8 * j + 6] = b.z; v[8 * j + 7] = b.w; }
}
__device__ __forceinline__ void load_row16(const bf16_t* x, int lane, float (&v)[16]) {
#pragma unroll
    for (int j = 0; j < 2; ++j) { const u32x4 w = *(const u32x4*)(x + 512 * j + 8 * lane);
        v[8 * j + 0] = bflo(w.x); v[8 * j + 1] = bfhi(w.x); v[8 * j + 2] = bflo(w.y); v[8 * j + 3] = bfhi(w.y); v[8 * j + 4] = bflo(w.z); v[8 * j + 5] = bfhi(w.z); v[8 * j + 6] = bflo(w.w); v[8 * j + 7] = bfhi(w.w); }
}
template <class XT>
__device__ __forceinline__ void norm_mod_phase(const XT* x, const float* gain, const float* mod  , int shoff, int seq_shift, bf16_t* H, int wave, int lane) {
    const int gw = blockIdx.x * NWAVES + wave, NGW = gridDim.x * NWAVES;
    float gv[16]; load_row16(gain, lane, gv);
    for (int m = gw; m < GM; m += NGW) {
        float v[16]; load_row16(x + (size_t)m * D, lane, v);
        const float* mp = mod + (size_t)(m >> seq_shift) * MODW + shoff;
        float sh[16], sc[16]; load_row16(mp, lane, sh); load_row16(mp + D, lane, sc);
        float s = 0.f;
#pragma unroll
        for (int e = 0; e < 16; ++e) s += v[e] * v[e];
        const float rstd = 1.0f / sqrtf(wave_sum(s) * (1.0f / D) + EPS);
#pragma unroll
        for (int j = 0; j < 2; ++j) { float y[8];
#pragma unroll
            for (int e = 0; e < 8; ++e) y[e] = v[8 * j + e] * rstd * gv[8 * j + e] * (sc[8 * j + e] + 1.0f) + sh[8 * j + e];
            u32x4 w; w.x = pk2(y[0], y[1]); w.y = pk2(y[2], y[3]); w.z = pk2(y[4], y[5]); w.w = pk2(y[6], y[7]);
            *(u32x4*)(H + (size_t)m * D + 512 * j + 8 * lane) = w; }
    }
}
__device__ __forceinline__ void final_norm_phase(const bf16_t* xb, float* out, const float* gain, int wave, int lane) {
    const int gw = blockIdx.x * NWAVES + wave, NGW = gridDim.x * NWAVES;
    float gv[16]; load_row16(gain, lane, gv);
    for (int m = gw; m < GM; m += NGW) {
        float v[16]; load_row16(xb + (size_t)m * D, lane, v);
        float s = 0.f;
#pragma unroll
        for (int e = 0; e < 16; ++e) s += v[e] * v[e];
        const float rstd = 1.0f / sqrtf(wave_sum(s) * (1.0f / D) + EPS);
#pragma unroll
        for (int j = 0; j < 2; ++j) { float* o = out + (size_t)m * D + 512 * j + 8 * lane;
            *(f32x4*)o = (f32x4){v[8 * j + 0] * rstd * gv[8 * j + 0], v[8 * j + 1] * rstd * gv[8 * j + 1], v[8 * j + 2] * rstd * gv[8 * j + 2], v[8 * j + 3] * rstd * gv[8 * j + 3]};
            *(f32x4*)(o + 4) = (f32x4){v[8 * j + 4] * rstd * gv[8 * j + 4], v[8 * j + 5] * rstd * gv[8 * j + 5], v[8 * j + 6] * rstd * gv[8 * j + 6], v[8 * j + 7] * rstd * gv[8 * j + 7]}; }
    }
}

__device__ __forceinline__ float oct_sum(float v) { v += swz_xor<1>(v); v += swz_xor<2>(v); v += swz_xor<4>(v); return v; }

__device__ __forceinline__ void post1_phase(bf16_t* Z, int Smask, const float* gq, const float* gk, const float* gcq, const float* gckv, int wave, int lane) {
    const int gw = blockIdx.x * NWAVES + wave, NGW = gridDim.x * NWAVES;
    const int sub = lane & 7, hq = lane >> 3;
    float invf[4], gq0[4], gq1[4], gk0[4], gk1[4];
#pragma unroll
    for (int e = 0; e < 4; ++e) { const int i = 4 * sub + e; invf[e] = exp2f(-(float)i * (LOG2_THETA / 32.0f)); gq0[e] = gq[i]; gq1[e] = gq[i + 32]; gk0[e] = gk[i]; gk1[e] = gk[i + 32]; }
    const float gc0 = gcq[4 * lane], gc1 = gcq[4 * lane + 1], gc2 = gcq[4 * lane + 2], gc3 = gcq[4 * lane + 3];
    const float gv0 = gckv[2 * lane], gv1 = gckv[2 * lane + 1];
    const bool kact = lane < 16;
    for (int m = gw; m < GM; m += NGW) {
        bf16_t* z = Z + (size_t)m * ZW;
        u32x2* pq0 = (u32x2*)(z + hq * 64 + 4 * sub); u32x2* pq1 = (u32x2*)(z + hq * 64 + 32 + 4 * sub);
        u32x2* pk0 = (u32x2*)(z + 512 + (hq & 1) * 64 + 4 * sub); u32x2* pk1 = (u32x2*)(z + 512 + (hq & 1) * 64 + 32 + 4 * sub);
        u32x2* pc = (u32x2*)(z + 768) + lane; unsigned* pv = (unsigned*)(z + 1024) + lane;
        const u32x2 wq0 = *pq0, wq1 = *pq1, wk0 = *pk0, wk1 = *pk1, wc = *pc; const unsigned wv = *pv;
        const float pos = (float)(m & Smask);
        float sn[4], cs[4];
#pragma unroll
        for (int e = 0; e < 4; ++e) sincosf(pos * invf[e], &sn[e], &cs[e]);
        {
            const float a[4] = {bflo(wq0.x), bfhi(wq0.x), bflo(wq0.y), bfhi(wq0.y)}, b[4] = {bflo(wq1.x), bfhi(wq1.x), bflo(wq1.y), bfhi(wq1.y)};
            float ss = 0.f;
#pragma unroll
            for (int e = 0; e < 4; ++e) ss += a[e] * a[e] + b[e] * b[e];
            const float rstd = 1.0f / sqrtf(oct_sum(ss) * (1.0f / 64.0f) + EPS) * (0.125f * LOG2E);
            float o0[4], o1[4];
#pragma unroll
            for (int e = 0; e < 4; ++e) { const float y1 = a[e] * rstd * gq0[e], y2 = b[e] * rstd * gq1[e]; o0[e] = y1 * cs[e] - y2 * sn[e]; o1[e] = y2 * cs[e] + y1 * sn[e]; }
            u32x2 w; w.x = pk2(o0[0], o0[1]); w.y = pk2(o0[2], o0[3]); *pq0 = w; w.x = pk2(o1[0], o1[1]); w.y = pk2(o1[2], o1[3]); *pq1 = w;
        }
        {
            const float a[4] = {bflo(wk0.x), bfhi(wk0.x), bflo(wk0.y), bfhi(wk0.y)}, b[4] = {bflo(wk1.x), bfhi(wk1.x), bflo(wk1.y), bfhi(wk1.y)};
            float ss = 0.f;
#pragma unroll
            for (int e = 0; e < 4; ++e) ss += a[e] * a[e] + b[e] * b[e];
            const float rstd = 1.0f / sqrtf(oct_sum(ss) * (1.0f / 64.0f) + EPS);
            float o0[4], o1[4];
#pragma unroll
            for (int e = 0; e < 4; ++e) { const float y1 = a[e] * rstd * gk0[e], y2 = b[e] * rstd * gk1[e]; o0[e] = y1 * cs[e] - y2 * sn[e]; o1[e] = y2 * cs[e] + y1 * sn[e]; }
            if (kact) { u32x2 w; w.x = pk2(o0[0], o0[1]); w.y = pk2(o0[2], o0[3]); *pk0 = w; w.x = pk2(o1[0], o1[1]); w.y = pk2(o1[2], o1[3]); *pk1 = w; }
        }
        {
            const float a0 = bflo(wc.x), a1 = bfhi(wc.x), a2 = bflo(wc.y), a3 = bfhi(wc.y);
            const float rstd = 1.0f / sqrtf(wave_sum((a0 * a0 + a1 * a1) + (a2 * a2 + a3 * a3)) * (1.0f / 256.0f) + EPS);
            u32x2 o; o.x = pk2(a0 * rstd * gc0, a1 * rstd * gc1); o.y = pk2(a2 * rstd * gc2, a3 * rstd * gc3); *pc = o;
        }
        {
            const float a0 = bflo(wv), a1 = bfhi(wv);
            const float rstd = 1.0f / sqrtf(wave_sum(a0 * a0 + a1 * a1) * (1.0f / 128.0f) + EPS);
            *pv = pk2(a0 * rstd * gv0, a1 * rstd * gv1);
        }
    }
}

__device__ __forceinline__ void post2_phase(bf16_t* QB, const bf16_t* KV, const bf16_t* Z, bf16_t* KB, int Smask, const float* gq, const float* gk, int wave, int lane) {
    const int gw = blockIdx.x * NWAVES + wave, NGW = gridDim.x * NWAVES;
    const int sub = lane & 7, h = lane >> 3;
    float gqn[8], gkn[8], gqr[4], gkr[4], invf[2];
#pragma unroll
    for (int e = 0; e < 8; ++e) { gqn[e] = gq[8 * sub + e]; gkn[e] = gk[8 * sub + e]; }
#pragma unroll
    for (int e = 0; e < 2; ++e) { const int i = 2 * sub + e; invf[e] = exp2f(-(float)i * (LOG2_THETA / 16.0f)); gqr[e] = gq[64 + i]; gqr[2 + e] = gq[80 + i]; gkr[e] = gk[64 + i]; gkr[2 + e] = gk[80 + i]; }
    const float qscl = 0.10206207261596577f * LOG2E;
    for (int m = gw; m < GM; m += NGW) {
        bf16_t* q = QB + (size_t)m * 768 + h * 96; const bf16_t* kv = KV + (size_t)m * 1024 + h * 128; bf16_t* kb = KB + (size_t)m * 768 + h * 96;
        const bf16_t* kr = Z + (size_t)m * ZW + 1152;
        const u32x4 wq = *(const u32x4*)(q + 8 * sub); const unsigned wqa = *(const unsigned*)(q + 64 + 2 * sub), wqb = *(const unsigned*)(q + 80 + 2 * sub);
        const u32x4 wk = *(const u32x4*)(kv + 8 * sub); const unsigned wka = *(const unsigned*)(kr + 2 * sub), wkb = *(const unsigned*)(kr + 16 + 2 * sub);
        const float pos = (float)(m & Smask);
        float sn[2], cs[2];
#pragma unroll
        for (int e = 0; e < 2; ++e) sincosf(pos * invf[e], &sn[e], &cs[e]);
        {
            const float n[8] = {bflo(wq.x), bfhi(wq.x), bflo(wq.y), bfhi(wq.y), bflo(wq.z), bfhi(wq.z), bflo(wq.w), bfhi(wq.w)};
            const float r0[2] = {bflo(wqa), bfhi(wqa)}, r1[2] = {bflo(wqb), bfhi(wqb)};
            float ss = r0[0] * r0[0] + r0[1] * r0[1] + r1[0] * r1[0] + r1[1] * r1[1];
#pragma unroll
            for (int e = 0; e < 8; ++e) ss += n[e] * n[e];
            const float rstd = 1.0f / sqrtf(oct_sum(ss) * (1.0f / 96.0f) + EPS) * qscl;
            u32x4 o; o.x = pk2(n[0] * rstd * gqn[0], n[1] * rstd * gqn[1]); o.y = pk2(n[2] * rstd * gqn[2], n[3] * rstd * gqn[3]);
            o.z = pk2(n[4] * rstd * gqn[4], n[5] * rstd * gqn[5]); o.w = pk2(n[6] * rstd * gqn[6], n[7] * rstd * gqn[7]);
            float a[2], b[2];
#pragma unroll
            for (int e = 0; e < 2; ++e) { const float y0 = r0[e] * rstd * gqr[e], y1 = r1[e] * rstd * gqr[2 + e]; a[e] = y0 * cs[e] - y1 * sn[e]; b[e] = y1 * cs[e] + y0 * sn[e]; }
            *(u32x4*)(q + 8 * sub) = o; *(unsigned*)(q + 64 + 2 * sub) = pk2(a[0], a[1]); *(unsigned*)(q + 80 + 2 * sub) = pk2(b[0], b[1]);
        }
        {
            const float n[8] = {bflo(wk.x), bfhi(wk.x), bflo(wk.y), bfhi(wk.y), bflo(wk.z), bfhi(wk.z), bflo(wk.w), bfhi(wk.w)};
            const float r0[2] = {bflo(wka), bfhi(wka)}, r1[2] = {bflo(wkb), bfhi(wkb)};
            float ss = r0[0] * r0[0] + r0[1] * r0[1] + r1[0] * r1[0] + r1[1] * r1[1];
#pragma unroll
            for (int e = 0; e < 8; ++e) ss += n[e] * n[e];
            const float rstd = 1.0f / sqrtf(oct_sum(ss) * (1.0f / 96.0f) + EPS);
            u32x4 o; o.x = pk2(n[0] * rstd * gkn[0], n[1] * rstd * gkn[1]); o.y = pk2(n[2] * rstd * gkn[2], n[3] * rstd * gkn[3]);
            o.z = pk2(n[4] * rstd * gkn[4], n[5] * rstd * gkn[5]); o.w = pk2(n[6] * rstd * gkn[6], n[7] * rstd * gkn[7]);
            float a[2], b[2];
#pragma unroll
            for (int e = 0; e < 2; ++e) { const float y0 = r0[e] * rstd * gkr[e], y1 = r1[e] * rstd * gkr[2 + e]; a[e] = y0 * cs[e] - y1 * sn[e]; b[e] = y1 * cs[e] + y0 * sn[e]; }
            *(u32x4*)(kb + 8 * sub) = o; *(unsigned*)(kb + 64 + 2 * sub) = pk2(a[0], a[1]); *(unsigned*)(kb + 80 + 2 * sub) = pk2(b[0], b[1]);
        }
    }
}

#define XB_TMO      128
#define XB_XCNT(j)  (256  + 64 * (j))
#define XB_XSUB(j)  (1280 + 64 * (j))
#define XB_XGEN(j)  (2304 + 64 * (j))
#define XB_TOP      3328
#define XB_TOPGEN   3392
#define XCD_BAR_WORDS 3456
#define XB_SPIN_CAP (1u << 22)

__device__ __forceinline__ unsigned xb_ld(unsigned* p)              { return __hip_atomic_load(p, __ATOMIC_RELAXED, __HIP_MEMORY_SCOPE_AGENT); }
__device__ __forceinline__ unsigned xb_add(unsigned* p, unsigned v) { return __hip_atomic_fetch_add(p, v, __ATOMIC_RELAXED, __HIP_MEMORY_SCOPE_AGENT); }
__device__ __forceinline__ unsigned xb_xcc_id() { return (unsigned)__builtin_amdgcn_s_getreg((3 << 11) | 20) & 0xFu; }
#define XB_SPIN(cond, bar) do { unsigned _sp = 0; while (cond) { __builtin_amdgcn_s_sleep(1); \
    if ((++_sp & 255u) == 0u) { if (xb_ld(&(bar)[XB_TMO])) break; if (_sp > XB_SPIN_CAP) { atomicAdd(&(bar)[XB_TMO], 1u); break; } } } } while (0)

struct XcdBarrier {
    unsigned* bar; unsigned x;
    volatile LAS unsigned* st;
};

__device__ __forceinline__ XcdBarrier xcd_barrier_post(unsigned* bar, volatile LAS unsigned* st, bool leader) {
    XcdBarrier b; b.bar = bar; b.x = xb_xcc_id(); b.st = st;
    if (leader) (void)xb_add(&bar[XB_XCNT(b.x)], 1u);
    return b;
}
__device__ __forceinline__ void xcd_barrier_complete(unsigned* bar, unsigned x, unsigned& nloc, unsigned& nx) {
    const unsigned G = gridDim.x * gridDim.y * gridDim.z;
    unsigned sum, cnt, mine, sp = 0u;
    for (;;) {
        sum = 0u; cnt = 0u; mine = 0u;
#pragma unroll
        for (unsigned j = 0; j < 16; ++j) { const unsigned c = xb_ld(&bar[XB_XCNT(j)]); sum += c; cnt += (c > 0u) ? 1u : 0u; mine = (j == x) ? c : mine; }
        if (sum == G) break;
        __builtin_amdgcn_s_sleep(1);
        if ((++sp & 255u) == 0u) { if (xb_ld(&bar[XB_TMO])) break; if (sp > XB_SPIN_CAP) { atomicAdd(&bar[XB_TMO], 1u); break; } }
    }
    nloc = mine > 0u ? mine : 1u; nx = cnt > 0u ? cnt : 1u;
}

__device__ __forceinline__ void xcd_barrier(const XcdBarrier& b, bool leader) {
    asm volatile("s_waitcnt vmcnt(0)" ::: "memory");
    __syncthreads();
    if (leader) {
        unsigned* bar = b.bar;
        __builtin_amdgcn_s_waitcnt(0);
        unsigned nloc = b.st[0], nx = b.st[1];
        if (nloc == 0u) { xcd_barrier_complete(bar, b.x, nloc, nx); b.st[0] = nloc; b.st[1] = nx; }
        const unsigned old = xb_add(&bar[XB_XSUB(b.x)], 1u);
        const unsigned gen = old / nloc;
        if (old + 1u == (gen + 1u) * nloc) {
            __builtin_amdgcn_fence(__ATOMIC_RELEASE, "agent");
            asm volatile("s_waitcnt vmcnt(0)" ::: "memory");
            const unsigned og = xb_add(&bar[XB_TOP], 1u);
            const unsigned tg = og / nx;
            if (og + 1u == (tg + 1u) * nx) xb_add(&bar[XB_TOPGEN], 1u);
            else XB_SPIN(xb_ld(&bar[XB_TOPGEN]) == tg, bar);
            __builtin_amdgcn_fence(__ATOMIC_ACQUIRE, "agent");
            xb_add(&bar[XB_XGEN(b.x)], 1u);
            asm volatile("s_waitcnt vmcnt(0)" ::: "memory");
        } else {
            XB_SPIN(xb_ld(&bar[XB_XGEN(b.x)]) == gen, bar);
            __builtin_amdgcn_fence(__ATOMIC_ACQUIRE, "agent");
            asm volatile("s_waitcnt vmcnt(0)" ::: "memory");
        }
    }
    __syncthreads();
}

__device__ __forceinline__ int crow(int r, int hi) { return (r & 3) + 8 * (r >> 2) + 4 * hi; }
#define MFMA32(a, b, c) __builtin_amdgcn_mfma_f32_32x32x16_bf16((a), (b), (c), 0, 0, 0)
constexpr int ATT_VP = 192;
template <int DQ> struct AttnCfg { static constexpr int KP = DQ * 2 + 16, KBUF = 64 * KP, VBUF = 64 * ATT_VP, CPR = DQ / 8, NKCH = 64 * CPR; };

template <int DQ, bool SWA>
__device__ __forceinline__ void attn_unit(const bf16_t* Qp, int ldq, const bf16_t* Kp, int ldk, const bf16_t* Vp, int ldv, bf16_t* Op, int ldo,
                                          int S, int q0, float sink_l2, LAS unsigned char* lds, int tid, int wave, int lane) {
    typedef AttnCfg<DQ> C;
    constexpr int NKS = DQ / 16;
    LAS unsigned char* Kb = lds;
    LAS unsigned char* Vb = lds + 2 * C::KBUF;
    LAS float* scr = (LAS float*)(lds + 2 * C::KBUF + 3 * C::VBUF) + wave * 64;
    const int r = lane & 31, h = lane >> 5;
    const int qw = q0 + wave * 32;
    const bool late = wave >= 4;
    bf16x8 qf[NKS];
#pragma unroll
    for (int ks = 0; ks < NKS; ++ks) qf[ks] = *(const bf16x8*)(Qp + (size_t)(qw + r) * ldq + 16 * ks + 8 * h);
    int t_lo = 0, t_hi = S / 64;
    if (SWA) { const int lo = q0 - 128 < 0 ? 0 : q0 - 128, hi = q0 + 384 > S ? S : q0 + 384; t_lo = lo / 64; t_hi = hi / 64; }
    const int vrow = tid >> 3, vch = tid & 7;
    const int k0row = tid / C::CPR, k0ch = tid % C::CPR;
    const int k1idx = tid + 512; const bool k1on = k1idx < C::NKCH; const int k1row = k1idx / C::CPR, k1ch = k1idx % C::CPR;
    u32x4 rv, rk0, rk1 = (u32x4){0u, 0u, 0u, 0u};
    const unsigned vofs = (unsigned)(vrow * ldv + vch * 8), k0ofs = (unsigned)(k0row * ldk + k0ch * 8), k1ofs = (unsigned)(k1row * ldk + k1ch * 8);
#define ATT_GLOAD(t) do { const bf16_t* Vt_ = Vp + (size_t)(t) * 64 * ldv; const bf16_t* Kt_ = Kp + (size_t)(t) * 64 * ldk; \
        rv = *(const u32x4*)(Vt_ + vofs); rk0 = *(const u32x4*)(Kt_ + k0ofs); if (k1on) rk1 = *(const u32x4*)(Kt_ + k1ofs); } while (0)
#define ATT_LSTORE(kbyte, vbyte) do { *(LAS u32x4*)(Vb + (vbyte) + vrow * ATT_VP + vch * 16) = rv; \
        *(LAS u32x4*)(Kb + (kbyte) + k0row * C::KP + k0ch * 16) = rk0; \
        if (k1on) *(LAS u32x4*)(Kb + (kbyte) + k1row * C::KP + k1ch * 16) = rk1; } while (0)
    float mref = SWA ? sink_l2 : 0.0f;
    f32x16 o0, o1, o2, negm;
#pragma unroll
    for (int i = 0; i < 16; ++i) { o0[i] = 0.f; o1[i] = 0.f; o2[i] = 0.f; negm[i] = -mref; }
    const bf16x8 ones = (bf16x8){0x3F80, 0x3F80, 0x3F80, 0x3F80, 0x3F80, 0x3F80, 0x3F80, 0x3F80};
    bf16x8 pf[4] = {ones, ones, ones, ones};
    bool pend = false;
    const int koff = r * C::KP + 16 * h;
    const int voff = (4 * h + ((lane & 15) >> 2)) * ATT_VP + ((lane >> 4) & 1) * 32 + (lane & 3) * 8;
    auto pv = [&](const int vbyte) __attribute__((always_inline)) {
        const LAS unsigned char* vb = Vb + vbyte + voff;
        v4i16_t vl0[4], vh0[4], vl1[4], vh1[4];
#pragma unroll
        for (int s = 0; s < 4; ++s) {
            vl0[s] = __builtin_amdgcn_ds_read_tr16_b64_v4i16((LAS v4i16_t*)(vb + (16 * s) * ATT_VP));
            vh0[s] = __builtin_amdgcn_ds_read_tr16_b64_v4i16((LAS v4i16_t*)(vb + (16 * s + 8) * ATT_VP));
            vl1[s] = __builtin_amdgcn_ds_read_tr16_b64_v4i16((LAS v4i16_t*)(vb + (16 * s) * ATT_VP + 64));
            vh1[s] = __builtin_amdgcn_ds_read_tr16_b64_v4i16((LAS v4i16_t*)(vb + (16 * s + 8) * ATT_VP + 64));
        }
        __builtin_amdgcn_sched_barrier(0);
#pragma unroll
        for (int s = 0; s < 4; ++s) {
            const bf16x8 v0 = (bf16x8){vl0[s][0], vl0[s][1], vl0[s][2], vl0[s][3], vh0[s][0], vh0[s][1], vh0[s][2], vh0[s][3]};
            const bf16x8 v1 = (bf16x8){vl1[s][0], vl1[s][1], vl1[s][2], vl1[s][3], vh1[s][0], vh1[s][1], vh1[s][2], vh1[s][3]};
            o0 = MFMA32(pf[s], v0, o0);
            o1 = MFMA32(pf[s], v1, o1);
            o2 = MFMA32(pf[s], ones, o2);
        }
        __builtin_amdgcn_sched_barrier(0);
    };
    ATT_GLOAD(t_lo); ATT_LSTORE(0, 0);
    if (t_lo + 1 < t_hi) ATT_GLOAD(t_lo + 1);
    __syncthreads();
    int vprev = 2 * C::VBUF, vcur = 0, vnext = C::VBUF;
    auto step = [&](const int t, const int kcur) __attribute__((always_inline)) {
        bool need = true;
        if (SWA) need = (64 * t + 63 >= qw - 128) && (64 * t <= qw + 31 + 128);
        if (late && pend) pv(vprev);
        pend = false;
        if (need) {
            const LAS unsigned char* kb = Kb + kcur * C::KBUF + koff;
            bf16x8 ka[NKS], kc[NKS];
#pragma unroll
            for (int ks = 0; ks < NKS; ++ks) { ka[ks] = *(const LAS bf16x8*)(kb + ks * 32); kc[ks] = *(const LAS bf16x8*)(kb + 32 * C::KP + ks * 32); }
            __builtin_amdgcn_sched_barrier(0);
            f32x16 p0 = MFMA32(ka[0], qf[0], negm), p1 = MFMA32(kc[0], qf[0], negm);
#pragma unroll
            for (int ks = 1; ks < NKS; ++ks) { p0 = MFMA32(ka[ks], qf[ks], p0); p1 = MFMA32(kc[ks], qf[ks], p1); }
            __builtin_amdgcn_sched_barrier(0);
            if (SWA) {
                const int qpos = qw + r, kb0 = 64 * t + 4 * h;
#pragma unroll
                for (int i = 0; i < 16; ++i) { const int kp = kb0 + (i & 3) + 8 * (i >> 2); const int d0_ = kp - qpos, d1_ = d0_ + 32;
                    if (d0_ > 128 || d0_ < -128) p0[i] = -1e30f; if (d1_ > 128 || d1_ < -128) p1[i] = -1e30f; }
            }
            int im = 0;
#pragma unroll
            for (int i = 0; i < 16; ++i) { const int a_ = __builtin_bit_cast(int, p0[i]), b_ = __builtin_bit_cast(int, p1[i]); im = max(im, max(a_, b_)); }
            { float lo_, hi_; xhalf_pair(__builtin_bit_cast(float, im), lo_, hi_); im = max(__builtin_bit_cast(int, lo_), __builtin_bit_cast(int, hi_)); }
            const float mx = __builtin_bit_cast(float, im);
            if (__any(mx > 8.0f)) {
                const float dl = mx, alpha = __builtin_amdgcn_exp2f(-dl);
                mref += dl;
#pragma unroll
                for (int i = 0; i < 16; ++i) { p0[i] -= dl; p1[i] -= dl; negm[i] = -mref; }
                if (h == 0) scr[r] = alpha;
                asm volatile("s_waitcnt lgkmcnt(0)" ::: "memory");
#pragma unroll
                for (int g = 0; g < 4; ++g) { const f32x4 av = *(const LAS f32x4*)(scr + 8 * g + 4 * h);
#pragma unroll
                    for (int j = 0; j < 4; ++j) { o0[4 * g + j] *= av[j]; o1[4 * g + j] *= av[j]; o2[4 * g + j] *= av[j]; } }
                asm volatile("s_waitcnt lgkmcnt(0)" ::: "memory");
            }
#pragma unroll
            for (int i = 0; i < 16; ++i) { p0[i] = __builtin_amdgcn_exp2f(p0[i]); p1[i] = __builtin_amdgcn_exp2f(p1[i]); }
#pragma unroll
            for (int s2 = 0; s2 < 2; ++s2) {
                u32x4 w0, w1;
                w0.x = pk2(p0[8 * s2 + 0], p0[8 * s2 + 1]); w0.y = pk2(p0[8 * s2 + 2], p0[8 * s2 + 3]); w0.z = pk2(p0[8 * s2 + 4], p0[8 * s2 + 5]); w0.w = pk2(p0[8 * s2 + 6], p0[8 * s2 + 7]);
                w1.x = pk2(p1[8 * s2 + 0], p1[8 * s2 + 1]); w1.y = pk2(p1[8 * s2 + 2], p1[8 * s2 + 3]); w1.z = pk2(p1[8 * s2 + 4], p1[8 * s2 + 5]); w1.w = pk2(p1[8 * s2 + 6], p1[8 * s2 + 7]);
                pf[s2] = __builtin_bit_cast(bf16x8, w0); pf[2 + s2] = __builtin_bit_cast(bf16x8, w1);
            }
            __builtin_amdgcn_sched_barrier(0);
            if (!late) pv(vcur); else pend = true;
        }
        if (t + 1 < t_hi) ATT_LSTORE((kcur ^ 1) * C::KBUF, vnext);
        if (t + 2 < t_hi) ATT_GLOAD(t + 2);
        { const int tmp = vprev; vprev = vcur; vcur = vnext; vnext = tmp; }
        __syncthreads();
    };
    for (int t = t_lo; t < t_hi; t += 2) { step(t, 0); step(t + 1, 1); }
    if (late && pend) pv(vprev);
    if (SWA) { if (h == 0) scr[r] = __builtin_amdgcn_exp2f(sink_l2 - mref); asm volatile("s_waitcnt lgkmcnt(0)" ::: "memory"); }
#pragma unroll
    for (int g = 0; g < 4; ++g) { f32x4 sv = (f32x4){0.f, 0.f, 0.f, 0.f}; if (SWA) sv = *(const LAS f32x4*)(scr + 8 * g + 4 * h);
#pragma unroll
        for (int j = 0; j < 4; ++j) { const int q = qw + 8 * g + 4 * h + j; bf16_t* op = Op + (size_t)q * ldo + r; const float rl = 1.0f / (o2[4 * g + j] + sv[j]);
            op[0] = (bf16_t)f2bf(o0[4 * g + j] * rl); op[32] = (bf16_t)f2bf(o1[4 * g + j] * rl); } }
    asm volatile("s_waitcnt lgkmcnt(0)" ::: "memory");
    __syncthreads();
#undef ATT_GLOAD
#undef ATT_LSTORE
}

template <class Epi>
__device__ __forceinline__ void run_gemm(LAS unsigned char* lds, const bf16_t* A, int lda, const bf16_t* Bt, int N, int K, const Epi& E, int tid) {
    int bx = (int)blockIdx.x; asm volatile("" : "+s"(bx), "+s"(A), "+s"(Bt));
    pg8::Gemm g{A, Bt, GM, N, K, lda}; pg8::StaticOrder S; S.init(GM, N, (int)gridDim.x, bx);
    pg8::gemm_phase<Epi, pg8::StaticOrder, true, true>(lds, g, S, E, tid);
}

typedef const Args __attribute__((address_space(4)))* KArgs;
#define PHASE_BEGIN() KArgs ap = (KArgs)__builtin_amdgcn_kernarg_segment_ptr(); asm volatile("" : "+s"(ap)); \
    unsigned char* ws = ap->ws; (void)ws; \
    int lane; asm volatile("v_mbcnt_lo_u32_b32 %0, -1, 0\n\tv_mbcnt_hi_u32_b32 %0, -1, %0" : "=v"(lane)); const int wave = wave_s, tid = wave_s * 64 + lane; (void)tid; \
    const float* xin = ap->in[g]; (void)xin; float* out = ap->out + (size_t)g * GM * D; (void)out; \
    const float* mod = (const float*)(ws + WS_MOD) + (size_t)(g ? 4 : 0) * MODW; (void)mod; \
    const int S = g ? 4096 : 8192, seq_shift = g ? 12 : 13, nseq = g ? 8 : 4; (void)S; (void)seq_shift; (void)nseq
#define WSP(off) ((bf16_t*)(ws + (off)))

__global__ void __launch_bounds__(NT, 2) fwd_kernel(Args a) {
    extern __shared__ __attribute__((aligned(16))) unsigned char lds_raw[];
    cg::grid_group grid = cg::this_grid();
    LAS unsigned char* lds = (LAS unsigned char*)lds_raw;
    const int wave_s = __builtin_amdgcn_readfirstlane((int)threadIdx.x >> 6);
    volatile LAS unsigned* bar_st = (volatile LAS unsigned*)(lds + 131072);
    if (threadIdx.x < 2) bar_st[threadIdx.x] = 0u;
    __syncthreads();
    { const int g = 0; PHASE_BEGIN(); (void)xcd_barrier_post((unsigned*)(ws + WS_BAR), bar_st, tid == 0); phase0(ap, lds, tid, wave, lane); }
    grid.sync();
#define SEAM() do { const int g = 0; PHASE_BEGIN(); XcdBarrier b_; b_.bar = (unsigned*)(ws + WS_BAR); b_.x = xb_xcc_id(); b_.st = bar_st; xcd_barrier(b_, tid == 0); } while (0)

    for (int g = 0; g < 2; ++g) {
        { PHASE_BEGIN(); norm_mod_phase(xin, ap->in[6], mod, 0, seq_shift, WSP(WS_H), wave, lane); }
        SEAM();
        { PHASE_BEGIN(); run_gemm(lds, WSP(WS_H), D, WSP(WS_WGU1), 2 * FF, D, pg8::EpiSwiGLU{WSP(WS_ACT), FF}, tid); }
        SEAM();
        { PHASE_BEGIN(); run_gemm(lds, WSP(WS_ACT), FF, WSP(WS_WD1), D, FF, pg8::EpiResid<true>{xin, WSP(WS_XB), mod + 2 * D, seq_shift, 0.5f}, tid); }
        SEAM();
        { PHASE_BEGIN(); norm_mod_phase((const bf16_t*)WSP(WS_XB), ap->in[10], mod, 3 * D, seq_shift, WSP(WS_H), wave, lane); }
        SEAM();
        { PHASE_BEGIN(); run_gemm(lds, WSP(WS_H), D, WSP(WS_WIN), ZW, D, pg8::EpiPlain{WSP(WS_Z), ZW}, tid); }
        SEAM();
        { PHASE_BEGIN(); post1_phase(WSP(WS_Z), S - 1, ap->in[12], ap->in[13], ap->in[15], ap->in[17], wave, lane); }
        SEAM();
        { PHASE_BEGIN(); run_gemm(lds, WSP(WS_Z) + 768, ZW, WSP(WS_WUQ), 768, 256, pg8::EpiPlain{WSP(WS_QB), 768}, tid); }
        { PHASE_BEGIN(); run_gemm(lds, WSP(WS_Z) + 1024, ZW, WSP(WS_WUKV), 1024, 256, pg8::EpiPlain{WSP(WS_KV), 1024}, tid); }
        SEAM();
        { PHASE_BEGIN(); post2_phase(WSP(WS_QB), WSP(WS_KV), WSP(WS_Z), WSP(WS_KB), S - 1, ap->in[19], ap->in[20], wave, lane); }
        SEAM();
        {
            PHASE_BEGIN();
            bf16_t* H = WSP(WS_H); bf16_t* Z = WSP(WS_Z); bf16_t* QB = WSP(WS_QB); bf16_t* KV = WSP(WS_KV); bf16_t* KB = WSP(WS_KB);
            const int nqb = S / 256, nunits = nseq * 8 * nqb;
            const int G = (int)gridDim.x, bx = (int)blockIdx.x;
            const int vcu = (G % 8 == 0) ? (bx % 8) * (G / 8) + bx / 8 : bx;
            for (int u = vcu; u < 2 * nunits; u += G) {
                const bool dense = u < nunits; const int uu = dense ? u : u - nunits;
                const int qb = uu % nqb, hd = (uu / nqb) & 7, s = uu / (nqb * 8);
                const size_t r0 = (size_t)s * S;
                if (dense)
                    attn_unit<96, false>(QB + r0 * 768 + hd * 96, 768, KB + r0 * 768 + hd * 96, 768, KV + r0 * 1024 + hd * 128 + 64, 1024,
                                         H + r0 * 1024 + 512 + hd * 64, 1024, S, qb * 256, 0.f, lds, tid, wave, lane);
                else
                    attn_unit<64, true>(Z + r0 * ZW + hd * 64, ZW, Z + r0 * ZW + 512 + (hd >> 2) * 64, ZW, Z + r0 * ZW + 640 + (hd >> 2) * 64, ZW,
                                        H + r0 * 1024 + hd * 64, 1024, S, qb * 256, ap->in[14][hd] * LOG2E, lds, tid, wave, lane);
            }
        }
        SEAM();
        { PHASE_BEGIN(); run_gemm(lds, WSP(WS_H), D, WSP(WS_WOUT), D, D, pg8::EpiResid<false>{WSP(WS_XB), WSP(WS_XB), mod + 5 * D, seq_shift, 1.0f}, tid); }
        SEAM();
        { PHASE_BEGIN(); norm_mod_phase((const bf16_t*)WSP(WS_XB), ap->in[22], mod, 6 * D, seq_shift, WSP(WS_H), wave, lane); }
        SEAM();
        { PHASE_BEGIN(); run_gemm(lds, WSP(WS_H), D, WSP(WS_WGU2), 2 * FF, D, pg8::EpiSwiGLU{WSP(WS_ACT), FF}, tid); }
        SEAM();
        { PHASE_BEGIN(); run_gemm(lds, WSP(WS_ACT), FF, WSP(WS_WD2), D, FF, pg8::EpiResid<false>{WSP(WS_XB), WSP(WS_XB), mod + 8 * D, seq_shift, 0.5f}, tid); }
        SEAM();
        { PHASE_BEGIN(); final_norm_phase((const bf16_t*)WSP(WS_XB), out, ap->in[26], wave, lane); }
    }
}

extern "C" void kernel_launch(void* const* d_in, const int* in_sizes, int n_in, void* d_out, int out_size, void* d_ws, size_t ws_size, hipStream_t stream) {
    static int grid = 0;
    if (grid == 0) {
        int dev = 0, cus = 0, per_cu = 0;
        hipGetDevice(&dev);
        hipDeviceGetAttribute(&cus, hipDeviceAttributeMultiprocessorCount, dev);
        hipFuncSetAttribute((const void*)fwd_kernel, hipFuncAttributeMaxDynamicSharedMemorySize, LDS_BYTES);
        hipOccupancyMaxActiveBlocksPerMultiprocessor(&per_cu, (const void*)fwd_kernel, NT, LDS_BYTES);
        if (per_cu < 1) per_cu = 1;
        if (per_cu > 1) per_cu = 1;
        grid = cus * per_cu;
        if (n_in != 27 || ws_size < WS_END) fprintf(stderr, "kernel_launch: unexpected n_in %d or ws_size %zu\n", n_in, ws_size);
    }
    hipMemsetAsync((char*)d_ws, 0, CTL_ZERO_BYTES, stream);
    Args a{};
    for (int i = 0; i < 27; ++i) a.in[i] = (const float*)d_in[i];
    a.out = (float*)d_out; a.ws = (unsigned char*)d_ws;
    void* args[] = {&a};
    hipError_t e = hipLaunchCooperativeKernel((const void*)fwd_kernel, dim3(grid), dim3(NT), args, LDS_BYTES, stream);
    if (e != hipSuccess) fprintf(stderr, "cooperative launch failed: %s (grid %d)\n", hipGetErrorString(e), grid);
}
```

```cpp
#include <hip/hip_runtime.h>
#include <hip/hip_cooperative_groups.h>
#include <cstdio>
#include <cstdint>
namespace cg = cooperative_groups;
namespace pg8 {
#define PG8_LAS __attribute__((address_space(3)))
typedef unsigned short bf16_t;
typedef short bf16x8 __attribute__((ext_vector_type(8)));
typedef float f32x4 __attribute__((ext_vector_type(4)));
typedef unsigned u32x4 __attribute__((ext_vector_type(4)));
constexpr int BM = 256, BK = 64, HALF = 128, HTB = HALF * BK * 2  , STAGE_BYTES = 8 * HTB, NXCD = 8, WGM = 8;

__host__ __device__ __forceinline__ int lds_byte(int r, int c) { const int st = (r >> 4) * 2 + (c >> 5), rr = r & 15, cc = c & 31, ob = rr * 64 + cc * 2; return st * 1024 + (ob ^ (((ob >> 9) & 1) << 5)); }
__host__ __device__ __forceinline__ void stage_rc(int b, int& R, int& C) { const int st = b / 1024, sb = b % 1024, swz = sb ^ (((sb >> 9) & 1) << 5); R = (st >> 1) * 16 + swz / 64; C = (st & 1) * 32 + (swz % 64) / 2; }
__host__ __device__ __forceinline__ int perm32(int rho) { const int n = rho >> 4, i = rho & 15; return 8 * (i >> 2) + 4 * n + (i & 3); }
struct Unit { int pm, pn; };
struct Gemm { const bf16_t* A; const bf16_t* Bt; int M, N, K, lda; };

struct StaticOrder {
    int nM, nN, nwg, G, c;
    __host__ __device__ void init(int M, int N, int G_, int c_) { nM = M / BM; nN = N / BM; nwg = nM * nN; G = G_; c = c_; }
    __host__ __device__ bool next(int i, Unit& u) const {
        const long L = (long)i * G + c; if (L >= nwg) return false;
        int wgid = (int)L; { const int q = nwg / NXCD, r = nwg % NXCD, xcd = wgid % NXCD, off = wgid / NXCD; wgid = (xcd < r ? xcd * (q + 1) : r * (q + 1) + (xcd - r) * q) + off; }
        const int nig = WGM * nN, gid = wgid / nig, fm = gid * WGM, gsz = (nM - fm) < WGM ? (nM - fm) : WGM;
        u.pm = fm + ((wgid % nig) % gsz); u.pn = (wgid % nig) / gsz; return true;
    }
    __device__ __forceinline__ void a_ready(const Unit&) const {}
    __device__ __forceinline__ void done(const Unit&) const {}
};
__device__ __forceinline__ unsigned cvt_pk_bf16(float lo, float hi) { unsigned r; asm volatile("v_cvt_pk_bf16_f32 %0, %1, %2" : "=v"(r) : "v"(lo), "v"(hi)); return r; }
typedef float f32x2 __attribute__((ext_vector_type(2)));
template <class Epi, class Sched, bool ALIGN_EPI = false, bool SP2 = false>
__device__ __forceinline__ void gemm_phase(PG8_LAS unsigned char* lds, const Gemm g, const Sched& S, const Epi& E, int tid_in) {
    int tid_l = tid_in; asm volatile("" : "+v"(tid_l));
    const int tid = tid_l, wid = __builtin_amdgcn_readfirstlane(tid >> 6), lane = tid & 63, wr = wid >> 2, wc = wid & 3, fr = lane & 15, fq = lane >> 4;
    const int K = g.K, nt = K / BK;
    unsigned voffA[2], voffB[2];
#pragma unroll
    for (int i = 0; i < 2; ++i) { int R, C; stage_rc(tid * 16 + i * 8192, R, C); const int Rb = Epi::PERM ? ((R & ~31) + perm32(R & 31)) : R;
        voffA[i] = (unsigned)(R * g.lda + C) * 2u; voffB[i] = (unsigned)(Rb * K + C) * 2u; }
    const size_t kstep = (size_t)(BK * 2);
    const size_t hstep = (size_t)HALF * K * 2;
    const size_t tstep = 2 * hstep;
    const size_t hstepA = (size_t)HALF * g.lda * 2, tstepA = 2 * hstepA;
    const unsigned ldsw = (unsigned)wid * 1024u;
    const int aoff = lds_byte(wr * 64 + fr, fq * 8), boff = lds_byte(wc * 32 + fr, fq * 8);
#define PG8_SA(b, h) (((b) * 2 + (h)) * HTB)
#define PG8_SB(b, h) ((4 + (b) * 2 + (h)) * HTB)
#define PG8_STAGE(bufoff, gbase, voff) do { _Pragma("unroll") for (int _i = 0; _i < 2; ++_i) \
        __builtin_amdgcn_global_load_lds((const unsigned*)((const char*)(gbase) + (voff)[_i]), (PG8_LAS unsigned*)(lds + (bufoff) + ldsw + _i * 8192), 16, 0, 0); } while (0)
#define PG8_LDA(dst, b, h) do { _Pragma("unroll") for (int m = 0; m < 4; ++m) _Pragma("unroll") for (int k = 0; k < 2; ++k) dst[m][k] = *(const PG8_LAS bf16x8*)(lds + PG8_SA(b, h) + aoff + m * 2048 + k * 1024); } while (0)
#define PG8_LDB(dst, b, h) do { _Pragma("unroll") for (int n = 0; n < 2; ++n) _Pragma("unroll") for (int k = 0; k < 2; ++k) dst[n][k] = *(const PG8_LAS bf16x8*)(lds + PG8_SB(b, h) + boff + n * 2048 + k * 1024); } while (0)
#define PG8_MMA(ai, bj, At, Bt) do { __builtin_amdgcn_s_setprio(1); _Pragma("unroll") for (int m = 0; m < 4; ++m) _Pragma("unroll") for (int n = 0; n < 2; ++n) _Pragma("unroll") for (int k = 0; k < 2; ++k) \
        acc[ai][bj][m][n] = __builtin_amdgcn_mfma_f32_16x16x32_bf16(Bt[n][k], At[m][k], acc[ai][bj][m][n], 0, 0, 0); __builtin_amdgcn_s_setprio(0); } while (0)
#define PG8_WAIT_V(n) asm volatile("s_waitcnt vmcnt(" #n ")" ::: "memory")
#define PG8_WAIT_L(n) asm volatile("s_waitcnt lgkmcnt(" #n ")" ::: "memory")
#define PG8_BAR __builtin_amdgcn_s_barrier()
#define PG8_SCHED __builtin_amdgcn_sched_barrier(0)
    Unit cur, nxt; int ui = 0;
    if (!S.next(0, cur)) return;
    f32x4 acc[2][2][4][2];
#pragma unroll
    for (int a = 0; a < 2; ++a)
#pragma unroll
        for (int b = 0; b < 2; ++b)
#pragma unroll
            for (int m = 0; m < 4; ++m)
#pragma unroll
                for (int n = 0; n < 2; ++n) acc[a][b][m][n] = (f32x4){0.f, 0.f, 0.f, 0.f};
    bf16x8 At[4][2], B0[2][2], B1[2][2];
    const char* cA = (const char*)g.A + (size_t)cur.pm * tstepA; const char* cB = (const char*)g.Bt + (size_t)cur.pn * tstep;
    S.a_ready(cur);
    if constexpr (SP2) {
        PG8_STAGE(PG8_SB(0, 0), cB, voffB); PG8_STAGE(PG8_SB(0, 1), cB + hstep, voffB); PG8_STAGE(PG8_SA(0, 0), cA, voffA); PG8_STAGE(PG8_SA(0, 1), cA + hstepA, voffA);
        if (wr == 1) PG8_BAR;
        PG8_WAIT_V(2); PG8_BAR;
        PG8_STAGE(PG8_SB(1, 0), cB + kstep, voffB); PG8_STAGE(PG8_SA(1, 0), cA + kstep, voffA); PG8_STAGE(PG8_SB(1, 1), cB + hstep + kstep, voffB);
        PG8_WAIT_V(6); PG8_BAR;
    } else {
        PG8_STAGE(PG8_SB(0, 0), cB, voffB); PG8_STAGE(PG8_SA(0, 0), cA, voffA); PG8_STAGE(PG8_SB(0, 1), cB + hstep, voffB); PG8_STAGE(PG8_SA(0, 1), cA + hstepA, voffA);
        if (wr == 1) PG8_BAR;
        PG8_WAIT_V(4); PG8_BAR;
        PG8_STAGE(PG8_SB(1, 0), cB + kstep, voffB); PG8_STAGE(PG8_SA(1, 0), cA + kstep, voffA); PG8_STAGE(PG8_SB(1, 1), cB + hstep + kstep, voffB);
        PG8_WAIT_V(6); PG8_BAR;
    }
    for (;;) {
        const bool has_next = S.next(ui + 1, nxt);
        const char* nA = has_next ? (const char*)g.A + (size_t)nxt.pm * tstepA : cA; const char* nB = has_next ? (const char*)g.Bt + (size_t)nxt.pn * tstep : cB;
        for (int t = 0; t < nt; t += 2) {
            const bool last = (t == nt - 2);
            const char* a1 = cA + (size_t)(t + 1) * kstep;
            const char* a2 = last ? nA : cA + (size_t)(t + 2) * kstep; const char* b2 = last ? nB : cB + (size_t)(t + 2) * kstep;
            const char* a3 = a2 + kstep; const char* b3 = b2 + kstep;
            if (last && has_next) S.a_ready(nxt);
            if constexpr (SP2) {
            PG8_LDB(B0, 0, 0); PG8_LDB(B1, 0, 1); PG8_SCHED; PG8_LDA(At, 0, 0); PG8_STAGE(PG8_SA(1, 1), a1 + hstepA, voffA);
            PG8_WAIT_V(8); PG8_WAIT_L(0); PG8_BAR; PG8_MMA(0, 0, At, B0); PG8_MMA(0, 1, At, B1); PG8_BAR; PG8_SCHED;
            PG8_LDA(At, 0, 1); PG8_STAGE(PG8_SB(0, 0), b2, voffB); PG8_STAGE(PG8_SB(0, 1), b2 + hstep, voffB); PG8_STAGE(PG8_SA(0, 0), a2, voffA);
            PG8_WAIT_V(8); PG8_WAIT_L(0); PG8_BAR; PG8_MMA(1, 0, At, B0); PG8_MMA(1, 1, At, B1); PG8_BAR; PG8_SCHED;
            PG8_LDB(B0, 1, 0); PG8_LDB(B1, 1, 1); PG8_SCHED; PG8_LDA(At, 1, 0); PG8_STAGE(PG8_SA(0, 1), a2 + hstepA, voffA);
            PG8_WAIT_V(8); PG8_WAIT_L(0); PG8_BAR; PG8_MMA(0, 0, At, B0); PG8_MMA(0, 1, At, B1); PG8_BAR; PG8_SCHED;
            PG8_LDA(At, 1, 1); PG8_STAGE(PG8_SB(1, 0), b3, voffB); PG8_STAGE(PG8_SB(1, 1), b3 + hstep, voffB); PG8_STAGE(PG8_SA(1, 0), a3, voffA);
            PG8_WAIT_V(8); PG8_WAIT_L(0); PG8_BAR; PG8_MMA(1, 0, At, B0); PG8_MMA(1, 1, At, B1); PG8_BAR; PG8_SCHED;
            } else {
            PG8_LDB(B0, 0, 0); PG8_SCHED; PG8_LDA(At, 0, 0); PG8_STAGE(PG8_SA(1, 1), a1 + hstepA, voffA);
            PG8_WAIT_L(8); PG8_BAR; PG8_WAIT_L(0); PG8_MMA(0, 0, At, B0); PG8_BAR; PG8_SCHED;
            PG8_LDB(B1, 0, 1); PG8_STAGE(PG8_SB(0, 0), b2, voffB);
            PG8_BAR; PG8_WAIT_L(0); PG8_MMA(0, 1, At, B1); PG8_BAR;
            PG8_LDA(At, 0, 1); PG8_STAGE(PG8_SA(0, 0), a2, voffA);
            PG8_BAR; PG8_WAIT_L(0); PG8_MMA(1, 0, At, B0); PG8_BAR; PG8_SCHED;
            PG8_STAGE(PG8_SB(0, 1), b2 + hstep, voffB);
            PG8_WAIT_V(6); PG8_BAR; PG8_MMA(1, 1, At, B1); PG8_BAR;
            PG8_LDB(B0, 1, 0); PG8_SCHED; PG8_LDA(At, 1, 0); PG8_STAGE(PG8_SA(0, 1), a2 + hstepA, voffA);
            PG8_WAIT_L(8); PG8_BAR; PG8_WAIT_L(0); PG8_MMA(0, 0, At, B0); PG8_BAR; PG8_SCHED;
            PG8_LDB(B1, 1, 1); PG8_STAGE(PG8_SB(1, 0), b3, voffB);
            PG8_BAR; PG8_WAIT_L(0); PG8_MMA(0, 1, At, B1); PG8_BAR;
            PG8_LDA(At, 1, 1); PG8_STAGE(PG8_SA(1, 0), a3, voffA);
            PG8_BAR; PG8_WAIT_L(0); PG8_MMA(1, 0, At, B0); PG8_BAR; PG8_SCHED;
            PG8_STAGE(PG8_SB(1, 1), b3 + hstep, voffB);
            PG8_WAIT_V(6); PG8_BAR; PG8_MMA(1, 1, At, B1); PG8_BAR;
            }
        }
        if constexpr (ALIGN_EPI) { if (wr == 0) PG8_BAR; }
        if constexpr (!Epi::AFTER_DRAIN) { E(acc, cur, wr, wc, fr, fq); S.done(cur); }
        if (!has_next) break;
#pragma unroll
        for (int a = 0; a < 2; ++a)
#pragma unroll
            for (int b = 0; b < 2; ++b)
#pragma unroll
                for (int m = 0; m < 4; ++m)
#pragma unroll
                    for (int n = 0; n < 2; ++n) acc[a][b][m][n] = (f32x4){0.f, 0.f, 0.f, 0.f};
        cur = nxt; cA = nA; cB = nB; ++ui;
        if constexpr (ALIGN_EPI) { if (wr == 1) PG8_BAR; }
    }
    PG8_WAIT_V(0);
    if constexpr (!ALIGN_EPI) { if (wr == 0) PG8_BAR; }
    PG8_BAR;
    if constexpr (Epi::AFTER_DRAIN) { E.fused(acc, cur, wr, wc, fr, fq, lds, wid, lane); S.done(cur); }
#undef PG8_SA
#undef PG8_SB
#undef PG8_STAGE
#undef PG8_LDA
#undef PG8_LDB
#undef PG8_MMA
#undef PG8_WAIT_V
#undef PG8_WAIT_L
#undef PG8_BAR
#undef PG8_SCHED
}
}

#define LAS __attribute__((address_space(3)))
typedef unsigned short bf16_t;
typedef short bf16x8 __attribute__((ext_vector_type(8)));
typedef float f32x4 __attribute__((ext_vector_type(4)));
typedef float f32x16 __attribute__((ext_vector_type(16)));
typedef unsigned u32x4 __attribute__((ext_vector_type(4)));
typedef unsigned u32x2 __attribute__((ext_vector_type(2)));
typedef short v4i16_t __attribute__((ext_vector_type(4)));
typedef float f32x2_t __attribute__((ext_vector_type(2)));
typedef __bf16 bf16x2_t __attribute__((ext_vector_type(2)));

constexpr int D = 1024, FF = 2816, NMOD = 9, MODW = NMOD * D;
constexpr int GM = 32768;
constexpr int ZW = 1280;
constexpr int INW = 1184;
constexpr int NWAVES = 8, NT = 512;
constexpr float EPS = 1e-6f;
constexpr float LOG2E = 1.4426950408889634f;
constexpr float LOG2_THETA = 13.287712379549449f;

constexpr size_t MiB = 1u << 20;
constexpr size_t WS_MOD = 0;
constexpr size_t MOD_BYTES = 12 * MODW * 4;
constexpr size_t WS_BAR = 768 * 1024;
constexpr size_t CTL_ZERO_BYTES = 1 * MiB;
constexpr size_t WS_WGU1 = 1 * MiB;
constexpr size_t WS_WD1 = WS_WGU1 + (size_t)5632 * 1024 * 2;
constexpr size_t WS_WGU2 = WS_WD1 + (size_t)1024 * 2816 * 2;
constexpr size_t WS_WD2 = WS_WGU2 + (size_t)5632 * 1024 * 2;
constexpr size_t WS_WIN = WS_WD2 + (size_t)1024 * 2816 * 2;
constexpr size_t WS_WUQ = WS_WIN + (size_t)1280 * 1024 * 2;
constexpr size_t WS_WUKV = WS_WUQ + (size_t)768 * 256 * 2;
constexpr size_t WS_WOUT = WS_WUKV + (size_t)1024 * 256 * 2;
constexpr size_t WS_WEND = WS_WOUT + (size_t)1024 * 1024 * 2;
static_assert(WS_WEND <= 40 * MiB, "weights region");
constexpr size_t WS_H = 40 * MiB;
constexpr size_t WS_B = 104 * MiB;
constexpr size_t WS_ACT = WS_B;
constexpr size_t WS_Z = WS_B;
constexpr size_t WS_QB = WS_Z + (size_t)GM * ZW * 2;
constexpr size_t WS_KV = WS_QB + (size_t)GM * 768 * 2;
constexpr size_t WS_KB = WS_KV + (size_t)GM * 1024 * 2;
constexpr size_t WS_XB = WS_KB + (size_t)GM * 768 * 2;
constexpr size_t WS_END = WS_XB + (size_t)GM * D * 2;
static_assert(WS_END <= 420 * MiB && WS_ACT + (size_t)GM * FF * 2 <= WS_XB, "ws map");

constexpr int LDS_BYTES = 131072 + 4096;

__device__ __forceinline__ unsigned f2bf(float f) { unsigned u = __builtin_bit_cast(unsigned, f); return (u + 0x7fffu + ((u >> 16) & 1u)) >> 16; }
__device__ __forceinline__ unsigned pk2(float lo, float hi) { f32x2_t v = {lo, hi}; bf16x2_t b = __builtin_convertvector(v, bf16x2_t); return __builtin_bit_cast(unsigned, b); }
__device__ __forceinline__ float bf2f(unsigned short b) { return __builtin_bit_cast(float, (unsigned)b << 16); }
__device__ __forceinline__ float bflo(unsigned w) { return __builtin_bit_cast(float, w << 16); }
__device__ __forceinline__ float bfhi(unsigned w) { return __builtin_bit_cast(float, w & 0xffff0000u); }
template <int M> __device__ __forceinline__ float swz_xor(float v) { return __builtin_bit_cast(float, __builtin_amdgcn_ds_swizzle(__builtin_bit_cast(int, v), (M << 10) | 0x1f)); }
__device__ __forceinline__ float half_sum(float v) { v += swz_xor<1>(v); v += swz_xor<2>(v); v += swz_xor<4>(v); v += swz_xor<8>(v); v += swz_xor<16>(v); return v; }
__device__ __forceinline__ void xhalf_pair(float v, float& lo, float& hi) { unsigned a = __builtin_bit_cast(unsigned, v), b = a;
    asm volatile("s_nop 1\n\tv_permlane32_swap_b32 %0, %1\n\ts_nop 1" : "+v"(a), "+v"(b)); lo = __builtin_bit_cast(float, a); hi = __builtin_bit_cast(float, b); }
__device__ __forceinline__ float xhalf_sum(float v) { float lo, hi; xhalf_pair(v, lo, hi); return lo + hi; }
__device__ __forceinline__ float xhalf_max(float v) { float lo, hi; xhalf_pair(v, lo, hi); return fmaxf(lo, hi); }
__device__ __forceinline__ float wave_sum(float v) { return xhalf_sum(half_sum(v)); }

namespace pg8 {
struct EpiPlain {
    static constexpr bool PERM = true, AFTER_DRAIN = false;
    bf16_t* O; int ldc;
    __device__ __forceinline__ void operator()(const f32x4 (&acc)[2][2][4][2], const Unit& u, int wr, int wc, int fr, int fq) const {
        const int row0 = u.pm * BM + wr * 64 + fr, col0 = u.pn * BM + wc * 32 + 8 * fq;
#pragma unroll
        for (int ai = 0; ai < 2; ++ai)
#pragma unroll
            for (int m = 0; m < 4; ++m) { bf16_t* rowp = O + (size_t)(row0 + ai * HALF + m * 16) * ldc + col0;
#pragma unroll
                for (int bj = 0; bj < 2; ++bj) { const f32x4 v0 = acc[ai][bj][m][0], v1 = acc[ai][bj][m][1];
                    u32x4 w; w.x = pk2(v0[0], v0[1]); w.y = pk2(v0[2], v0[3]); w.z = pk2(v1[0], v1[1]); w.w = pk2(v1[2], v1[3]);
                    *(u32x4*)(rowp + bj * HALF) = w; } }
    }
};
__device__ __forceinline__ float silu_mul(float g, float u) { return g * u * __builtin_amdgcn_rcpf(1.0f + __builtin_amdgcn_exp2f(-g * LOG2E)); }
struct EpiSwiGLU {
    static constexpr bool PERM = true, AFTER_DRAIN = false;
    bf16_t* O; int ldc;
    __device__ __forceinline__ void operator()(const f32x4 (&acc)[2][2][4][2], const Unit& u, int wr, int wc, int fr, int fq) const {
        const int row0 = u.pm * BM + wr * 64 + fr, col0 = u.pn * HALF + wc * 32 + 8 * fq;
#pragma unroll
        for (int ai = 0; ai < 2; ++ai)
#pragma unroll
            for (int m = 0; m < 4; ++m) { bf16_t* rowp = O + (size_t)(row0 + ai * HALF + m * 16) * ldc + col0;
                const f32x4 g0 = acc[ai][0][m][0], g1 = acc[ai][0][m][1], u0 = acc[ai][1][m][0], u1 = acc[ai][1][m][1];
                u32x4 w; w.x = pk2(silu_mul(g0[0], u0[0]), silu_mul(g0[1], u0[1])); w.y = pk2(silu_mul(g0[2], u0[2]), silu_mul(g0[3], u0[3]));
                w.z = pk2(silu_mul(g1[0], u1[0]), silu_mul(g1[1], u1[1])); w.w = pk2(silu_mul(g1[2], u1[2]), silu_mul(g1[3], u1[3]));
                *(u32x4*)rowp = w; }
    }
};
template <bool BASE_F32> struct EpiResid {
    static constexpr bool PERM = true, AFTER_DRAIN = false;
    const void* base; bf16_t* out; const float* gate  ; int seq_shift  ; float scale;
    __device__ __forceinline__ void operator()(const f32x4 (&acc)[2][2][4][2], const Unit& u, int wr, int wc, int fr, int fq) const {
        const int row0 = u.pm * BM + wr * 64 + fr, col0 = u.pn * BM + wc * 32 + 8 * fq;
        const float* gp = gate + (size_t)((u.pm * BM) >> seq_shift) * MODW + col0;
#pragma unroll
        for (int bj = 0; bj < 2; ++bj) { const f32x4 g0 = *(const f32x4*)(gp + bj * HALF) * scale, g1 = *(const f32x4*)(gp + bj * HALF + 4) * scale;
#pragma unroll
            for (int ai = 0; ai < 2; ++ai)
#pragma unroll
                for (int m = 0; m < 4; ++m) { const size_t off = (size_t)(row0 + ai * HALF + m * 16) * D + col0 + bj * HALF;
                    f32x4 b0, b1;
                    if (BASE_F32) { b0 = *(const f32x4*)((const float*)base + off); b1 = *(const f32x4*)((const float*)base + off + 4); }
                    else { const u32x4 w = *(const u32x4*)((const bf16_t*)base + off); b0 = (f32x4){bflo(w.x), bfhi(w.x), bflo(w.y), bfhi(w.y)}; b1 = (f32x4){bflo(w.z), bfhi(w.z), bflo(w.w), bfhi(w.w)}; }
                    const f32x4 v0 = b0 + g0 * acc[ai][bj][m][0], v1 = b1 + g1 * acc[ai][bj][m][1];
                    u32x4 o; o.x = pk2(v0[0], v0[1]); o.y = pk2(v0[2], v0[3]); o.z = pk2(v1[0], v1[1]); o.w = pk2(v1[2], v1[3]);
                    *(u32x4*)(out + off) = o; } }
    }
};
}

struct Args { const float* in[27]; float* out; unsigned char* ws; };

__device__ __forceinline__ void transpose_item(const float* W, int K, int N, bf16_t* WT, int mode, LAS float* scr, int item, int lane) {
    const int nblk = N / 32, kb = item / nblk, nb = item % nblk, k0 = 64 * kb, n0 = 32 * nb;
    int d0 = n0;
    if (mode == 1) d0 = (n0 >> 7) * 256 + (n0 & 127);
    else if (mode == 2) d0 = (n0 >> 7) * 256 + 128 + (n0 & 127);
#pragma unroll 8
    for (int i = 0; i < 32; ++i) { const int kk = 2 * i + (lane >> 5); scr[kk * 33 + (lane & 31)] = W[(size_t)(k0 + kk) * N + n0 + (lane & 31)]; }
    asm volatile("s_waitcnt lgkmcnt(0)" ::: "memory");
    const int c = lane & 7;
#pragma unroll
    for (int j = 0; j < 4; ++j) { const int n = (lane >> 3) + 8 * j; const LAS float* s = scr + (8 * c) * 33 + n;
        u32x4 o; o.x = pk2(s[0 * 33], s[1 * 33]); o.y = pk2(s[2 * 33], s[3 * 33]); o.z = pk2(s[4 * 33], s[5 * 33]); o.w = pk2(s[6 * 33], s[7 * 33]);
        *(u32x4*)(WT + (size_t)(d0 + n) * K + k0 + 8 * c) = o; }
    asm volatile("s_waitcnt lgkmcnt(0)" ::: "memory");
}

typedef const Args __attribute__((address_space(4)))* KArgs0;
__device__ __forceinline__ void phase0(KArgs0 ap, LAS unsigned char* lds, int tid, int wave, int lane) {
    unsigned char* ws = ap->ws;
    {
        LAS float* scr = (LAS float*)(lds + wave * 8704);
        const int gw = blockIdx.x * NWAVES + wave, NGW = gridDim.x * NWAVES;
        constexpr int I_G = (D / 64) * (FF / 32), I_D = (FF / 64) * (D / 32), I_IN = (D / 64) * (INW / 32), I_UQ = (256 / 64) * (768 / 32), I_UKV = (128 / 64) * (1024 / 32), I_OUT = (D / 64) * (D / 32);
        constexpr int NITEMS = 4 * I_G + 2 * I_D + I_IN + I_UQ + I_UKV + I_OUT;
        for (int it = gw; it < NITEMS; it += NGW) {
            int r = it;
            if (r < I_G) { transpose_item(ap->in[7], D, FF, (bf16_t*)(ws + WS_WGU1), 1, scr, r, lane); continue; } r -= I_G;
            if (r < I_G) { transpose_item(ap->in[8], D, FF, (bf16_t*)(ws + WS_WGU1), 2, scr, r, lane); continue; } r -= I_G;
            if (r < I_D) { transpose_item(ap->in[9], FF, D, (bf16_t*)(ws + WS_WD1), 0, scr, r, lane); continue; } r -= I_D;
            if (r < I_G) { transpose_item(ap->in[23], D, FF, (bf16_t*)(ws + WS_WGU2), 1, scr, r, lane); continue; } r -= I_G;
            if (r < I_G) { transpose_item(ap->in[24], D, FF, (bf16_t*)(ws + WS_WGU2), 2, scr, r, lane); continue; } r -= I_G;
            if (r < I_D) { transpose_item(ap->in[25], FF, D, (bf16_t*)(ws + WS_WD2), 0, scr, r, lane); continue; } r -= I_D;
            if (r < I_IN) { transpose_item(ap->in[11], D, INW, (bf16_t*)(ws + WS_WIN), 0, scr, r, lane); continue; } r -= I_IN;
            if (r < I_UQ) { transpose_item(ap->in[16], 256, 768, (bf16_t*)(ws + WS_WUQ), 0, scr, r, lane); continue; } r -= I_UQ;
            if (r < I_UKV) { transpose_item(ap->in[18], 256, 1024, (bf16_t*)(ws + WS_WUKV), 0, scr, r, lane); continue; } r -= I_UKV;
            transpose_item(ap->in[21], D, D, (bf16_t*)(ws + WS_WOUT), 0, scr, r, lane);
        }
        { for (int i = blockIdx.x * NT + tid; i < 1024 * 16; i += gridDim.x * NT) *(u32x4*)(ws + WS_WUKV + (size_t)(i >> 4) * 512 + 256 + (i & 15) * 16) = (u32x4){0u, 0u, 0u, 0u}; }
        { u32x4* p = (u32x4*)(ws + WS_WIN + (size_t)INW * D * 2); const int n16 = (ZW - INW) * D * 2 / 16;
          for (int i = blockIdx.x * NT + tid; i < n16; i += gridDim.x * NT) p[i] = (u32x4){0u, 0u, 0u, 0u}; }
    }
    __syncthreads();
    {
        LAS float* sc = (LAS float*)lds;
        float* mod = (float*)(ws + WS_MOD);
        const float* adaw = ap->in[4]; const float* adab = ap->in[5];
        for (int item = blockIdx.x; item < 18 * 16; item += gridDim.x) {
            const int cb = item % 18, kc = item / 18;
            __syncthreads();
            for (int i = tid; i < 12 * 64; i += NT) { const int s = i >> 6, kk = i & 63;
                const float c = (s < 4) ? ap->in[2][s * D + kc * 64 + kk] : ap->in[3][(s - 4) * D + kc * 64 + kk];
                sc[i] = c / (1.0f + __expf(-c)); }
            __syncthreads();
            const int col = cb * 512 + tid;
            float acc[12];
#pragma unroll
            for (int s = 0; s < 12; ++s) acc[s] = 0.f;
            const float* wp = adaw + (size_t)(kc * 64) * MODW + col;
#pragma unroll 32
            for (int kk = 0; kk < 64; ++kk) { const float w = wp[(size_t)kk * MODW];
#pragma unroll
                for (int s = 0; s < 12; ++s) acc[s] += sc[s * 64 + kk] * w; }
            const float b = (kc == 0) ? adab[col] : 0.f;
#pragma unroll
            for (int s = 0; s < 12; ++s) atomicAdd(mod + s * MODW + col, acc[s] + b);
        }
    }
}

__device__ __forceinline__ void load_row16(const float* x, int lane, float (&v)[16]) {
#pragma unroll
    for (int j = 0; j < 2; ++j) { const f32x4 a = *(const f32x4*)(x + 512 * j + 8 * lane), b = *(const f32x4*)(x + 512 * j + 8 * lane + 4);
        v[8 * j + 0] = a.x; v[8 * j + 1] = a.y; v[8 * j + 2] = a.z; v[8 * j + 3] = a.w; v[8 * j + 4] = b.x; v[8 * j + 5] = b.y; v[8 * j + 6] = b.z; v[8 * j + 7] = b.w; }
}
__device__ __forceinline__ void load_row16(const bf16_t* x, int lane, float (&v)[16]) {
#pragma unroll
    for (int j = 0; j < 2; ++j) { const u32x4 w = *(const u32x4*)(x + 512 * j + 8 * lane);
        v[8 * j + 0] = bflo(w.x); v[8 * j + 1] = bfhi(w.x); v[8 * j + 2] = bflo(w.y); v[8 * j + 3] = bfhi(w.y); v[8 * j + 4] = bflo(w.z); v[8 * j + 5] = bfhi(w.z); v[8 * j + 6] = bflo(w.w); v[8 * j + 7] = bfhi(w.w); }
}
template <class XT>
__device__ __forceinline__ void norm_mod_phase(const XT* x, const float* gain, const float* mod  , int shoff, int seq_shift, bf16_t* H, int wave, int lane) {
    const int gw = blockIdx.x * NWAVES + wave, NGW = gridDim.x * NWAVES;
    float gv[16]; load_row16(gain, lane, gv);
    for (int m = gw; m < GM; m += NGW) {
        float v[16]; load_row16(x + (size_t)m * D, lane, v);
        const float* mp = mod + (size_t)(m >> seq_shift) * MODW + shoff;
        float sh[16], sc[16]; load_row16(mp, lane, sh); load_row16(mp + D, lane, sc);
        float s = 0.f;
#pragma unroll
        for (int e = 0; e < 16; ++e) s += v[e] * v[e];
        const float rstd = 1.0f / sqrtf(wave_sum(s) * (1.0f / D) + EPS);
#pragma unroll
        for (int j = 0; j < 2; ++j) { float y[8];
#pragma unroll
            for (int e = 0; e < 8; ++e) y[e] = v[8 * j + e] * rstd * gv[8 * j + e] * (sc[8 * j + e] + 1.0f) + sh[8 * j + e];
            u32x4 w; w.x = pk2(y[0], y[1]); w.y = pk2(y[2], y[3]); w.z = pk2(y[4], y[5]); w.w = pk2(y[6], y[7]);
            *(u32x4*)(H + (size_t)m * D + 512 * j + 8 * lane) = w; }
    }
}
__device__ __forceinline__ void final_norm_phase(const bf16_t* xb, float* out, const float* gain, int wave, int lane) {
    const int gw = blockIdx.x * NWAVES + wave, NGW = gridDim.x * NWAVES;
    float gv[16]; load_row16(gain, lane, gv);
    for (int m = gw; m < GM; m += NGW) {
        float v[16]; load_row16(xb + (size_t)m * D, lane, v);
        float s = 0.f;
#pragma unroll
        for (int e = 0; e < 16; ++e) s += v[e] * v[e];
        const float rstd = 1.0f / sqrtf(wave_sum(s) * (1.0f / D) + EPS);
#pragma unroll
        for (int j = 0; j < 2; ++j) { float* o = out + (size_t)m * D + 512 * j + 8 * lane;
            *(f32x4*)o = (f32x4){v[8 * j + 0] * rstd * gv[8 * j + 0], v[8 * j + 1] * rstd * gv[8 * j + 1], v[8 * j + 2] * rstd * gv[8 * j + 2], v[8 * j + 3] * rstd * gv[8 * j + 3]};
            *(f32x4*)(o + 4) = (f32x4){v[8 * j + 4] * rstd * gv[8 * j + 4], v[8 * j + 5] * rstd * gv[8 * j + 5], v[8 * j + 6] * rstd * gv[8 * j + 6], v[8 * j + 7] * rstd * gv[8 * j + 7]}; }
    }
}

__device__ __forceinline__ float oct_sum(float v) { v += swz_xor<1>(v); v += swz_xor<2>(v); v += swz_xor<4>(v); return v; }

__device__ __forceinline__ void post1_phase(bf16_t* Z, int Smask, const float* gq, const float* gk, const float* gcq, const float* gckv, int wave, int lane) {
    const int gw = blockIdx.x * NWAVES + wave, NGW = gridDim.x * NWAVES;
    const int sub = lane & 7, hq = lane >> 3;
    float invf[4], gq0[4], gq1[4], gk0[4], gk1[4];
#pragma unroll
    for (int e = 0; e < 4; ++e) { const int i = 4 * sub + e; invf[e] = exp2f(-(float)i * (LOG2_THETA / 32.0f)); gq0[e] = gq[i]; gq1[e] = gq[i + 32]; gk0[e] = gk[i]; gk1[e] = gk[i + 32]; }
    const float gc0 = gcq[4 * lane], gc1 = gcq[4 * lane + 1], gc2 = gcq[4 * lane + 2], gc3 = gcq[4 * lane + 3];
    const float gv0 = gckv[2 * lane], gv1 = gckv[2 * lane + 1];
    const bool kact = lane < 16;
    for (int m = gw; m < GM; m += NGW) {
        bf16_t* z = Z + (size_t)m * ZW;
        u32x2* pq0 = (u32x2*)(z + hq * 64 + 4 * sub); u32x2* pq1 = (u32x2*)(z + hq * 64 + 32 + 4 * sub);
        u32x2* pk0 = (u32x2*)(z + 512 + (hq & 1) * 64 + 4 * sub); u32x2* pk1 = (u32x2*)(z + 512 + (hq & 1) * 64 + 32 + 4 * sub);
        u32x2* pc = (u32x2*)(z + 768) + lane; unsigned* pv = (unsigned*)(z + 1024) + lane;
        const u32x2 wq0 = *pq0, wq1 = *pq1, wk0 = *pk0, wk1 = *pk1, wc = *pc; const unsigned wv = *pv;
        const float pos = (float)(m & Smask);
        float sn[4], cs[4];
#pragma unroll
        for (int e = 0; e < 4; ++e) sincosf(pos * invf[e], &sn[e], &cs[e]);
        {
            const float a[4] = {bflo(wq0.x), bfhi(wq0.x), bflo(wq0.y), bfhi(wq0.y)}, b[4] = {bflo(wq1.x), bfhi(wq1.x), bflo(wq1.y), bfhi(wq1.y)};
            float ss = 0.f;
#pragma unroll
            for (int e = 0; e < 4; ++e) ss += a[e] * a[e] + b[e] * b[e];
            const float rstd = 1.0f / sqrtf(oct_sum(ss) * (1.0f / 64.0f) + EPS) * (0.125f * LOG2E);
            float o0[4], o1[4];
#pragma unroll
            for (int e = 0; e < 4; ++e) { const float y1 = a[e] * rstd * gq0[e], y2 = b[e] * rstd * gq1[e]; o0[e] = y1 * cs[e] - y2 * sn[e]; o1[e] = y2 * cs[e] + y1 * sn[e]; }
            u32x2 w; w.x = pk2(o0[0], o0[1]); w.y = pk2(o0[2], o0[3]); *pq0 = w; w.x = pk2(o1[0], o1[1]); w.y = pk2(o1[2], o1[3]); *pq1 = w;
        }
        {
            const float a[4] = {bflo(wk0.x), bfhi(wk0.x), bflo(wk0.y), bfhi(wk0.y)}, b[4] = {bflo(wk1.x), bfhi(wk1.x), bflo(wk1.y), bfhi(wk1.y)};
            float ss = 0.f;
#pragma unroll
            for (int e = 0; e < 4; ++e) ss += a[e] * a[e] + b[e] * b[e];
            const float rstd = 1.0f / sqrtf(oct_sum(ss) * (1.0f / 64.0f) + EPS);
            float o0[4], o1[4];
#pragma unroll
            for (int e = 0; e < 4; ++e) { const float y1 = a[e] * rstd * gk0[e], y2 = b[e] * rstd * gk1[e]; o0[e] = y1 * cs[e] - y2 * sn[e]; o1[e] = y2 * cs[e] + y1 * sn[e]; }
            if (kact) { u32x2 w; w.x = pk2(o0[0], o0[1]); w.y = pk2(o0[2], o0[3]); *pk0 = w; w.x = pk2(o1[0], o1[1]); w.y = pk2(o1[2], o1[3]); *pk1 = w; }
        }
        {
            const float a0 = bflo(wc.x), a1 = bfhi(wc.x), a2 = bflo(wc.y), a3 = bfhi(wc.y);
            const float rstd = 1.0f / sqrtf(wave_sum((a0 * a0 + a1 * a1) + (a2 * a2 + a3 * a3)) * (1.0f / 256.0f) + EPS);
            u32x2 o; o.x = pk2(a0 * rstd * gc0, a1 * rstd * gc1); o.y = pk2(a2 * rstd * gc2, a3 * rstd * gc3); *pc = o;
        }
        {
            const float a0 = bflo(wv), a1 = bfhi(wv);
            const float rstd = 1.0f / sqrtf(wave_sum(a0 * a0 + a1 * a1) * (1.0f / 128.0f) + EPS);
            *pv = pk2(a0 * rstd * gv0, a1 * rstd * gv1);
        }
    }
}

__device__ __forceinline__ void post2_phase(bf16_t* QB, const bf16_t* KV, const bf16_t* Z, bf16_t* KB, int Smask, const float* gq, const float* gk, int wave, int lane) {
    const int gw = blockIdx.x * NWAVES + wave, NGW = gridDim.x * NWAVES;
    const int sub = lane & 7, h = lane >> 3;
    float gqn[8], gkn[8], gqr[4], gkr[4], invf[2];
#pragma unroll
    for (int e = 0; e < 8; ++e) { gqn[e] = gq[8 * sub + e]; gkn[e] = gk[8 * sub + e]; }
#pragma unroll
    for (int e = 0; e < 2; ++e) { const int i = 2 * sub + e; invf[e] = exp2f(-(float)i * (LOG2_THETA / 16.0f)); gqr[e] = gq[64 + i]; gqr[2 + e] = gq[80 + i]; gkr[e] = gk[64 + i]; gkr[2 + e] = gk[80 + i]; }
    const float qscl = 0.10206207261596577f * LOG2E;
    for (int m = gw; m < GM; m += NGW) {
        bf16_t* q = QB + (size_t)m * 768 + h * 96; const bf16_t* kv = KV + (size_t)m * 1024 + h * 128; bf16_t* kb = KB + (size_t)m * 768 + h * 96;
        const bf16_t* kr = Z + (size_t)m * ZW + 1152;
        const u32x4 wq = *(const u32x4*)(q + 8 * sub); const unsigned wqa = *(const unsigned*)(q + 64 + 2 * sub), wqb = *(const unsigned*)(q + 80 + 2 * sub);
        const u32x4 wk = *(const u32x4*)(kv + 8 * sub); const unsigned wka = *(const unsigned*)(kr + 2 * sub), wkb = *(const unsigned*)(kr + 16 + 2 * sub);
        const float pos = (float)(m & Smask);
        float sn[2], cs[2];
#pragma unroll
        for (int e = 0; e < 2; ++e) sincosf(pos * invf[e], &sn[e], &cs[e]);
        {
            const float n[8] = {bflo(wq.x), bfhi(wq.x), bflo(wq.y), bfhi(wq.y), bflo(wq.z), bfhi(wq.z), bflo(wq.w), bfhi(wq.w)};
            const float r0[2] = {bflo(wqa), bfhi(wqa)}, r1[2] = {bflo(wqb), bfhi(wqb)};
            float ss = r0[0] * r0[0] + r0[1] * r0[1] + r1[0] * r1[0] + r1[1] * r1[1];
#pragma unroll
            for (int e = 0; e < 8; ++e) ss += n[e] * n[e];
            const float rstd = 1.0f / sqrtf(oct_sum(ss) * (1.0f / 96.0f) + EPS) * qscl;
            u32x4 o; o.x = pk2(n[0] * rstd * gqn[0], n[1] * rstd * gqn[1]); o.y = pk2(n[2] * rstd * gqn[2], n[3] * rstd * gqn[3]);
            o.z = pk2(n[4] * rstd * gqn[4], n[5] * rstd * gqn[5]); o.w = pk2(n[6] * rstd * gqn[6], n[7] * rstd * gqn[7]);
            float a[2], b[2];
#pragma unroll
            for (int e = 0; e < 2; ++e) { const float y0 = r0[e] * rstd * gqr[e], y1 = r1[e] * rstd * gqr[2 + e]; a[e] = y0 * cs[e] - y1 * sn[e]; b[e] = y1 * cs[e] + y0 * sn[e]; }
            *(u32x4*)(q + 8 * sub) = o; *(unsigned*)(q + 64 + 2 * sub) = pk2(a[0], a[1]); *(unsigned*)(q + 80 + 2 * sub) = pk2(b[0], b[1]);
        }
        {
            const float n[8] = {bflo(wk.x), bfhi(wk.x), bflo(wk.y), bfhi(wk.y), bflo(wk.z), bfhi(wk.z), bflo(wk.w), bfhi(wk.w)};
            const float r0[2] = {bflo(wka), bfhi(wka)}, r1[2] = {bflo(wkb), bfhi(wkb)};
            float ss = r0[0] * r0[0] + r0[1] * r0[1] + r1[0] * r1[0] + r1[1] * r1[1];
#pragma unroll
            for (int e = 0; e < 8; ++e) ss += n[e] * n[e];
            const float rstd = 1.0f / sqrtf(oct_sum(ss) * (1.0f / 96.0f) + EPS);
            u32x4 o; o.x = pk2(n[0] * rstd * gkn[0], n[1] * rstd * gkn[1]); o.y = pk2(n[2] * rstd * gkn[2], n[3] * rstd * gkn[3]);
            o.z = pk2(n[4] * rstd * gkn[4], n[5] * rstd * gkn[5]); o.w = pk2(n[6] * rstd * gkn[6], n[7] * rstd * gkn[7]);
            float a[2], b[2];
#pragma unroll
            for (int e = 0; e < 2; ++e) { const float y0 = r0[e] * rstd * gkr[e], y1 = r1[e] * rstd * gkr[2 + e]; a[e] = y0 * cs[e] - y1 * sn[e]; b[e] = y1 * cs[e] + y0 * sn[e]; }
            *(u32x4*)(kb + 8 * sub) = o; *(unsigned*)(kb + 64 + 2 * sub) = pk2(a[0], a[1]); *(unsigned*)(kb + 80 + 2 * sub) = pk2(b[0], b[1]);
        }
    }
}

#define XB_TMO      128
#define XB_XCNT(j)  (256  + 64 * (j))
#define XB_XSUB(j)  (1280 + 64 * (j))
#define XB_XGEN(j)  (2304 + 64 * (j))
#define XB_TOP      3328
#define XB_TOPGEN   3392
#define XCD_BAR_WORDS 3456
#define XB_SPIN_CAP (1u << 22)

__device__ __forceinline__ unsigned xb_ld(unsigned* p)              { return __hip_atomic_load(p, __ATOMIC_RELAXED, __HIP_MEMORY_SCOPE_AGENT); }
__device__ __forceinline__ unsigned xb_add(unsigned* p, unsigned v) { return __hip_atomic_fetch_add(p, v, __ATOMIC_RELAXED, __HIP_MEMORY_SCOPE_AGENT); }
__device__ __forceinline__ unsigned xb_xcc_id() { return (unsigned)__builtin_amdgcn_s_getreg((3 << 11) | 20) & 0xFu; }
#define XB_SPIN(cond, bar) do { unsigned _sp = 0; while (cond) { __builtin_amdgcn_s_sleep(1); \
    if ((++_sp & 255u) == 0u) { if (xb_ld(&(bar)[XB_TMO])) break; if (_sp > XB_SPIN_CAP) { atomicAdd(&(bar)[XB_TMO], 1u); break; } } } } while (0)

struct XcdBarrier {
    unsigned* bar; unsigned x;
    volatile LAS unsigned* st;
};

__device__ __forceinline__ XcdBarrier xcd_barrier_post(unsigned* bar, volatile LAS unsigned* st, bool leader) {
    XcdBarrier b; b.bar = bar; b.x = xb_xcc_id(); b.st = st;
    if (leader) (void)xb_add(&bar[XB_XCNT(b.x)], 1u);
    return b;
}
__device__ __forceinline__ void xcd_barrier_complete(unsigned* bar, unsigned x, unsigned& nloc, unsigned& nx) {
    const unsigned G = gridDim.x * gridDim.y * gridDim.z;
    unsigned sum, cnt, mine, sp = 0u;
    for (;;) {
        sum = 0u; cnt = 0u; mine = 0u;
#pragma unroll
        for (unsigned j = 0; j < 16; ++j) { const unsigned c = xb_ld(&bar[XB_XCNT(j)]); sum += c; cnt += (c > 0u) ? 1u : 0u; mine = (j == x) ? c : mine; }
        if (sum == G) break;
        __builtin_amdgcn_s_sleep(1);
        if ((++sp & 255u) == 0u) { if (xb_ld(&bar[XB_TMO])) break; if (sp > XB_SPIN_CAP) { atomicAdd(&bar[XB_TMO], 1u); break; } }
    }
    nloc = mine > 0u ? mine : 1u; nx = cnt > 0u ? cnt : 1u;
}

__device__ __forceinline__ void xcd_barrier(const XcdBarrier& b, bool leader) {
    asm volatile("s_waitcnt vmcnt(0)" ::: "memory");
    __syncthreads();
    if (leader) {
        unsigned* bar = b.bar;
        __builtin_amdgcn_s_waitcnt(0);
        unsigned nloc = b.st[0], nx = b.st[1];
        if (nloc == 0u) { xcd_barrier_complete(bar, b.x, nloc, nx); b.st[0] = nloc; b.st[1] = nx; }
        const unsigned old = xb_add(&bar[XB_XSUB(b.x)], 1u);
        const unsigned gen = old / nloc;
        if (old + 1u == (gen + 1u) * nloc) {
            __builtin_amdgcn_fence(__ATOMIC_RELEASE, "agent");
            asm volatile("s_waitcnt vmcnt(0)" ::: "memory");
            const unsigned og = xb_add(&bar[XB_TOP], 1u);
            const unsigned tg = og / nx;
            if (og + 1u == (tg + 1u) * nx) xb_add(&bar[XB_TOPGEN], 1u);
            else XB_SPIN(xb_ld(&bar[XB_TOPGEN]) == tg, bar);
            __builtin_amdgcn_fence(__ATOMIC_ACQUIRE, "agent");
            xb_add(&bar[XB_XGEN(b.x)], 1u);
            asm volatile("s_waitcnt vmcnt(0)" ::: "memory");
        } else {
            XB_SPIN(xb_ld(&bar[XB_XGEN(b.x)]) == gen, bar);
            __builtin_amdgcn_fence(__ATOMIC_ACQUIRE, "agent");
            asm volatile("s_waitcnt vmcnt(0)" ::: "memory");
        }
    }
    __syncthreads();
}

__device__ __forceinline__ int crow(int r, int hi) { return (r & 3) + 8 * (r >> 2) + 4 * hi; }
#define MFMA32(a, b, c) __builtin_amdgcn_mfma_f32_32x32x16_bf16((a), (b), (c), 0, 0, 0)
constexpr int ATT_VP = 192;
template <int DQ> struct AttnCfg { static constexpr int KP = DQ * 2 + 16, KBUF = 64 * KP, VBUF = 64 * ATT_VP, CPR = DQ / 8, NKCH = 64 * CPR; };

template <int DQ, bool SWA>
__device__ __forceinline__ void attn_unit(const bf16_t* Qp, int ldq, const bf16_t* Kp, int ldk, const bf16_t* Vp, int ldv, bf16_t* Op, int ldo,
                                          int S, int q0, float sink_l2, LAS unsigned char* lds, int tid, int wave, int lane) {
    typedef AttnCfg<DQ> C;
    constexpr int NKS = DQ / 16, NKH = NKS / 2;
    LAS unsigned char* Kb = lds;
    LAS unsigned char* Vb = lds + 2 * C::KBUF;
    LAS float* scr = (LAS float*)(lds + 2 * C::KBUF + 2 * C::VBUF) + wave * 64;
    const int r = lane & 31, h = lane >> 5;
    const int qw = q0 + wave * 32;
    bf16x8 qf[NKS];
#pragma unroll
    for (int ks = 0; ks < NKS; ++ks) qf[ks] = *(const bf16x8*)(Qp + (size_t)(qw + r) * ldq + 16 * ks + 8 * h);
    int t_lo = 0, t_hi = S / 64;
    if (SWA) { const int lo = q0 - 128 < 0 ? 0 : q0 - 128, hi = q0 + 384 > S ? S : q0 + 384; t_lo = lo / 64; t_hi = hi / 64; }
    const int vrow = tid >> 3, vch = tid & 7;
    const int k0row = tid / C::CPR, k0ch = tid % C::CPR;
    const int k1idx = tid + 512; const bool k1on = k1idx < C::NKCH; const int k1row = k1idx / C::CPR, k1ch = k1idx % C::CPR;
    u32x4 rv, rk0, rk1 = (u32x4){0u, 0u, 0u, 0u};
    const unsigned vofs = (unsigned)(vrow * ldv + vch * 8), k0ofs = (unsigned)(k0row * ldk + k0ch * 8), k1ofs = (unsigned)(k1row * ldk + k1ch * 8);
#define ATT_GLOAD_V(t) do { rv = *(const u32x4*)(Vp + (size_t)(t) * 64 * ldv + vofs); } while (0)
#define ATT_GLOAD_K(t) do { const bf16_t* Kt_ = Kp + (size_t)(t) * 64 * ldk; rk0 = *(const u32x4*)(Kt_ + k0ofs); if (k1on) rk1 = *(const u32x4*)(Kt_ + k1ofs); } while (0)
#define ATT_LSTORE_V(b) do { *(LAS u32x4*)(Vb + (b) * C::VBUF + vrow * ATT_VP + vch * 16) = rv; } while (0)
#define ATT_LSTORE_K(b) do { *(LAS u32x4*)(Kb + (b) * C::KBUF + k0row * C::KP + k0ch * 16) = rk0; \
        if (k1on) *(LAS u32x4*)(Kb + (b) * C::KBUF + k1row * C::KP + k1ch * 16) = rk1; } while (0)
#define ATT_NEED(t) (!SWA || ((64 * (t) + 63 >= qw - 128) && (64 * (t) <= qw + 31 + 128)))
    float mref = SWA ? sink_l2 : 0.0f;
    f32x16 o0, o1, o2, negm;
#pragma unroll
    for (int i = 0; i < 16; ++i) { o0[i] = 0.f; o1[i] = 0.f; o2[i] = 0.f; negm[i] = -mref; }
    const bf16x8 ones = (bf16x8){0x3F80, 0x3F80, 0x3F80, 0x3F80, 0x3F80, 0x3F80, 0x3F80, 0x3F80};
    const int koff = r * C::KP + 16 * h;
    const int voff = (4 * h + ((lane & 15) >> 2)) * ATT_VP + ((lane >> 4) & 1) * 32 + (lane & 3) * 8;
    auto qk = [&](f32x16& P0, f32x16& P1, const int kbuf) __attribute__((always_inline)) {
        const LAS unsigned char* kb = Kb + kbuf * C::KBUF + koff;
        bf16x8 ka[NKH], kc[NKH];
#pragma unroll
        for (int ks = 0; ks < NKH; ++ks) { ka[ks] = *(const LAS bf16x8*)(kb + ks * 32); kc[ks] = *(const LAS bf16x8*)(kb + 32 * C::KP + ks * 32); }
        __builtin_amdgcn_sched_barrier(0);
        P0 = MFMA32(ka[0], qf[0], negm); P1 = MFMA32(kc[0], qf[0], negm);
#pragma unroll
        for (int ks = 1; ks < NKH; ++ks) { P0 = MFMA32(ka[ks], qf[ks], P0); P1 = MFMA32(kc[ks], qf[ks], P1); }
        bf16x8 kd[NKH], ke[NKH];
#pragma unroll
        for (int ks = 0; ks < NKH; ++ks) { kd[ks] = *(const LAS bf16x8*)(kb + (NKH + ks) * 32); ke[ks] = *(const LAS bf16x8*)(kb + 32 * C::KP + (NKH + ks) * 32); }
        __builtin_amdgcn_sched_barrier(0);
#pragma unroll
        for (int ks = 0; ks < NKH; ++ks) { P0 = MFMA32(kd[ks], qf[NKH + ks], P0); P1 = MFMA32(ke[ks], qf[NKH + ks], P1); }
        __builtin_amdgcn_sched_barrier(0);
    };
    ATT_GLOAD_K(t_lo); ATT_GLOAD_V(t_lo); ATT_LSTORE_K(0); ATT_LSTORE_V(0);
    if (t_lo + 1 < t_hi) { ATT_GLOAD_K(t_lo + 1); ATT_LSTORE_K(1); ATT_GLOAD_V(t_lo + 1); }
    if (t_lo + 2 < t_hi) ATT_GLOAD_K(t_lo + 2);
    __syncthreads();
    f32x16 pA, pA1, pB, pB1;
#pragma unroll
    for (int i = 0; i < 16; ++i) { pA[i] = 0.f; pA1[i] = 0.f; pB[i] = 0.f; pB1[i] = 0.f; }
    if (ATT_NEED(t_lo)) qk(pA, pA1, 0);
    __syncthreads();
    auto step = [&](const int t, const int kcur, f32x16& p0, f32x16& p1, f32x16& n0, f32x16& n1) __attribute__((always_inline)) {
        const bool more1 = (t + 1 < t_hi), more2 = (t + 2 < t_hi), more3 = (t + 3 < t_hi);
        const bool need = ATT_NEED(t), needn = more1 && ATT_NEED(t + 1);
        if (needn) qk(n0, n1, kcur ^ 1);
        if (need) {
            if (SWA) {
                const int qpos = qw + r, kb0 = 64 * t + 4 * h;
#pragma unroll
                for (int i = 0; i < 16; ++i) { const int kp = kb0 + (i & 3) + 8 * (i >> 2); const int d0_ = kp - qpos, d1_ = d0_ + 32;
                    if (d0_ > 128 || d0_ < -128) p0[i] = -1e30f; if (d1_ > 128 || d1_ < -128) p1[i] = -1e30f; }
            }
            int im = 0;
#pragma unroll
            for (int i = 0; i < 16; ++i) { const int a_ = __builtin_bit_cast(int, p0[i]), b_ = __builtin_bit_cast(int, p1[i]); im = max(im, max(a_, b_)); }
            { float lo_, hi_; xhalf_pair(__builtin_bit_cast(float, im), lo_, hi_); im = max(__builtin_bit_cast(int, lo_), __builtin_bit_cast(int, hi_)); }
            const float mx = __builtin_bit_cast(float, im);
            if (__any(mx > 8.0f)) {
                const float dl = mx, alpha = __builtin_amdgcn_exp2f(-dl);
                mref += dl;
#pragma unroll
                for (int i = 0; i < 16; ++i) { p0[i] -= dl; p1[i] -= dl; negm[i] = -mref; }
                if (needn) {
#pragma unroll
                    for (int i = 0; i < 16; ++i) { n0[i] -= dl; n1[i] -= dl; }
                }
                if (h == 0) scr[r] = alpha;
                asm volatile("s_waitcnt lgkmcnt(0)" ::: "memory");
#pragma unroll
                for (int g = 0; g < 4; ++g) { const f32x4 av = *(const LAS f32x4*)(scr + 8 * g + 4 * h);
#pragma unroll
                    for (int j = 0; j < 4; ++j) { o0[4 * g + j] *= av[j]; o1[4 * g + j] *= av[j]; o2[4 * g + j] *= av[j]; } }
                asm volatile("s_waitcnt lgkmcnt(0)" ::: "memory");
            }
#pragma unroll
            for (int i = 0; i < 16; ++i) { p0[i] = __builtin_amdgcn_exp2f(p0[i]); p1[i] = __builtin_amdgcn_exp2f(p1[i]); }
            bf16x8 pf[4];
#pragma unroll
            for (int s2 = 0; s2 < 2; ++s2) {
                u32x4 w0, w1;
                w0.x = pk2(p0[8 * s2 + 0], p0[8 * s2 + 1]); w0.y = pk2(p0[8 * s2 + 2], p0[8 * s2 + 3]); w0.z = pk2(p0[8 * s2 + 4], p0[8 * s2 + 5]); w0.w = pk2(p0[8 * s2 + 6], p0[8 * s2 + 7]);
                w1.x = pk2(p1[8 * s2 + 0], p1[8 * s2 + 1]); w1.y = pk2(p1[8 * s2 + 2], p1[8 * s2 + 3]); w1.z = pk2(p1[8 * s2 + 4], p1[8 * s2 + 5]); w1.w = pk2(p1[8 * s2 + 6], p1[8 * s2 + 7]);
                pf[s2] = __builtin_bit_cast(bf16x8, w0); pf[2 + s2] = __builtin_bit_cast(bf16x8, w1);
            }
            const LAS unsigned char* vb = Vb + kcur * C::VBUF + voff;
#pragma unroll
            for (int sh = 0; sh < 2; ++sh) {
                v4i16_t vl0[2], vh0[2], vl1[2], vh1[2];
#pragma unroll
                for (int s = 0; s < 2; ++s) { const int sa = 2 * sh + s;
                    vl0[s] = __builtin_amdgcn_ds_read_tr16_b64_v4i16((LAS v4i16_t*)(vb + (16 * sa) * ATT_VP));
                    vh0[s] = __builtin_amdgcn_ds_read_tr16_b64_v4i16((LAS v4i16_t*)(vb + (16 * sa + 8) * ATT_VP));
                    vl1[s] = __builtin_amdgcn_ds_read_tr16_b64_v4i16((LAS v4i16_t*)(vb + (16 * sa) * ATT_VP + 64));
                    vh1[s] = __builtin_amdgcn_ds_read_tr16_b64_v4i16((LAS v4i16_t*)(vb + (16 * sa + 8) * ATT_VP + 64)); }
#pragma unroll
                for (int s = 0; s < 2; ++s) { const int sa = 2 * sh + s;
                    const bf16x8 v0 = (bf16x8){vl0[s][0], vl0[s][1], vl0[s][2], vl0[s][3], vh0[s][0], vh0[s][1], vh0[s][2], vh0[s][3]};
                    const bf16x8 v1 = (bf16x8){vl1[s][0], vl1[s][1], vl1[s][2], vl1[s][3], vh1[s][0], vh1[s][1], vh1[s][2], vh1[s][3]};
                    o0 = MFMA32(pf[sa], v0, o0); o1 = MFMA32(pf[sa], v1, o1); o2 = MFMA32(pf[sa], ones, o2); }
            }
        }
        if (more2) ATT_LSTORE_K(kcur);
        if (more1) ATT_LSTORE_V(kcur ^ 1);
        if (more3) ATT_GLOAD_K(t + 3);
        if (more2) ATT_GLOAD_V(t + 2);
        __syncthreads();
    };
    for (int t = t_lo; t < t_hi; t += 2) { step(t, 0, pA, pA1, pB, pB1); step(t + 1, 1, pB, pB1, pA, pA1); }
    if (SWA) { if (h == 0) scr[r] = __builtin_amdgcn_exp2f(sink_l2 - mref); asm volatile("s_waitcnt lgkmcnt(0)" ::: "memory"); }
#pragma unroll
    for (int g = 0; g < 4; ++g) { f32x4 sv = (f32x4){0.f, 0.f, 0.f, 0.f}; if (SWA) sv = *(const LAS f32x4*)(scr + 8 * g + 4 * h);
#pragma unroll
        for (int j = 0; j < 4; ++j) { const int q = qw + 8 * g + 4 * h + j; bf16_t* op = Op + (size_t)q * ldo + r; const float rl = 1.0f / (o2[4 * g + j] + sv[j]);
            op[0] = (bf16_t)f2bf(o0[4 * g + j] * rl); op[32] = (bf16_t)f2bf(o1[4 * g + j] * rl); } }
    asm volatile("s_waitcnt lgkmcnt(0)" ::: "memory");
#undef ATT_GLOAD_V
#undef ATT_GLOAD_K
#undef ATT_LSTORE_V
#undef ATT_LSTORE_K
#undef ATT_NEED
}

template <class Epi>
__device__ __forceinline__ void run_gemm(LAS unsigned char* lds, const bf16_t* A, int lda, const bf16_t* Bt, int N, int K, const Epi& E, int tid) {
    int bx = (int)blockIdx.x; asm volatile("" : "+s"(bx), "+s"(A), "+s"(Bt));
    pg8::Gemm g{A, Bt, GM, N, K, lda}; pg8::StaticOrder S; S.init(GM, N, (int)gridDim.x, bx);
    pg8::gemm_phase<Epi, pg8::StaticOrder, true, true>(lds, g, S, E, tid);
}

typedef const Args __attribute__((address_space(4)))* KArgs;
#define PHASE_BEGIN() KArgs ap = (KArgs)__builtin_amdgcn_kernarg_segment_ptr(); asm volatile("" : "+s"(ap)); \
    unsigned char* ws = ap->ws; (void)ws; \
    int lane; asm volatile("v_mbcnt_lo_u32_b32 %0, -1, 0\n\tv_mbcnt_hi_u32_b32 %0, -1, %0" : "=v"(lane)); const int wave = wave_s, tid = wave_s * 64 + lane; (void)tid; \
    const float* xin = ap->in[g]; (void)xin; float* out = ap->out + (size_t)g * GM * D; (void)out; \
    const float* mod = (const float*)(ws + WS_MOD) + (size_t)(g ? 4 : 0) * MODW; (void)mod; \
    const int S = g ? 4096 : 8192, seq_shift = g ? 12 : 13, nseq = g ? 8 : 4; (void)S; (void)seq_shift; (void)nseq
#define WSP(off) ((bf16_t*)(ws + (off)))

__global__ void __launch_bounds__(NT, 2) fwd_kernel(Args a) {
    extern __shared__ __attribute__((aligned(16))) unsigned char lds_raw[];
    cg::grid_group grid = cg::this_grid();
    LAS unsigned char* lds = (LAS unsigned char*)lds_raw;
    const int wave_s = __builtin_amdgcn_readfirstlane((int)threadIdx.x >> 6);
    volatile LAS unsigned* bar_st = (volatile LAS unsigned*)(lds + 131072);
    if (threadIdx.x < 2) bar_st[threadIdx.x] = 0u;
    __syncthreads();
    { const int g = 0; PHASE_BEGIN(); (void)xcd_barrier_post((unsigned*)(ws + WS_BAR), bar_st, tid == 0); phase0(ap, lds, tid, wave, lane); }
    grid.sync();
#define SEAM() do { const int g = 0; PHASE_BEGIN(); XcdBarrier b_; b_.bar = (unsigned*)(ws + WS_BAR); b_.x = xb_xcc_id(); b_.st = bar_st; xcd_barrier(b_, tid == 0); } while (0)

    for (int g = 0; g < 2; ++g) {
        { PHASE_BEGIN(); norm_mod_phase(xin, ap->in[6], mod, 0, seq_shift, WSP(WS_H), wave, lane); }
        SEAM();
        { PHASE_BEGIN(); run_gemm(lds, WSP(WS_H), D, WSP(WS_WGU1), 2 * FF, D, pg8::EpiSwiGLU{WSP(WS_ACT), FF}, tid); }
        SEAM();
        { PHASE_BEGIN(); run_gemm(lds, WSP(WS_ACT), FF, WSP(WS_WD1), D, FF, pg8::EpiResid<true>{xin, WSP(WS_XB), mod + 2 * D, seq_shift, 0.5f}, tid); }
        SEAM();
        { PHASE_BEGIN(); norm_mod_phase((const bf16_t*)WSP(WS_XB), ap->in[10], mod, 3 * D, seq_shift, WSP(WS_H), wave, lane); }
        SEAM();
        { PHASE_BEGIN(); run_gemm(lds, WSP(WS_H), D, WSP(WS_WIN), ZW, D, pg8::EpiPlain{WSP(WS_Z), ZW}, tid); }
        SEAM();
        { PHASE_BEGIN(); post1_phase(WSP(WS_Z), S - 1, ap->in[12], ap->in[13], ap->in[15], ap->in[17], wave, lane); }
        SEAM();
        { PHASE_BEGIN(); run_gemm(lds, WSP(WS_Z) + 768, ZW, WSP(WS_WUQ), 768, 256, pg8::EpiPlain{WSP(WS_QB), 768}, tid); }
        { PHASE_BEGIN(); run_gemm(lds, WSP(WS_Z) + 1024, ZW, WSP(WS_WUKV), 1024, 256, pg8::EpiPlain{WSP(WS_KV), 1024}, tid); }
        SEAM();
        { PHASE_BEGIN(); post2_phase(WSP(WS_QB), WSP(WS_KV), WSP(WS_Z), WSP(WS_KB), S - 1, ap->in[19], ap->in[20], wave, lane); }
        SEAM();
        {
            PHASE_BEGIN();
            bf16_t* H = WSP(WS_H); bf16_t* Z = WSP(WS_Z); bf16_t* QB = WSP(WS_QB); bf16_t* KV = WSP(WS_KV); bf16_t* KB = WSP(WS_KB);
            const int nqb = S / 256, nunits = nseq * 8 * nqb;
            const int G = (int)gridDim.x, bx = (int)blockIdx.x;
            const int vcu = (G % 8 == 0) ? (bx % 8) * (G / 8) + bx / 8 : bx;
            for (int u = vcu; u < 2 * nunits; u += G) {
                const bool dense = u < nunits; const int uu = dense ? u : u - nunits;
                const int qb = uu % nqb, hd = (uu / nqb) & 7, s = uu / (nqb * 8);
                const size_t r0 = (size_t)s * S;
                if (dense)
                    attn_unit<96, false>(QB + r0 * 768 + hd * 96, 768, KB + r0 * 768 + hd * 96, 768, KV + r0 * 1024 + hd * 128 + 64, 1024,
                                         H + r0 * 1024 + 512 + hd * 64, 1024, S, qb * 256, 0.f, lds, tid, wave, lane);
                else
                    attn_unit<64, true>(Z + r0 * ZW + hd * 64, ZW, Z + r0 * ZW + 512 + (hd >> 2) * 64, ZW, Z + r0 * ZW + 640 + (hd >> 2) * 64, ZW,
                                        H + r0 * 1024 + hd * 64, 1024, S, qb * 256, ap->in[14][hd] * LOG2E, lds, tid, wave, lane);
            }
        }
        SEAM();
        { PHASE_BEGIN(); run_gemm(lds, WSP(WS_H), D, WSP(WS_WOUT), D, D, pg8::EpiResid<false>{WSP(WS_XB), WSP(WS_XB), mod + 5 * D, seq_shift, 1.0f}, tid); }
        SEAM();
        { PHASE_BEGIN(); norm_mod_phase((const bf16_t*)WSP(WS_XB), ap->in[22], mod, 6 * D, seq_shift, WSP(WS_H), wave, lane); }
        SEAM();
        { PHASE_BEGIN(); run_gemm(lds, WSP(WS_H), D, WSP(WS_WGU2), 2 * FF, D, pg8::EpiSwiGLU{WSP(WS_ACT), FF}, tid); }
        SEAM();
        { PHASE_BEGIN(); run_gemm(lds, WSP(WS_ACT), FF, WSP(WS_WD2), D, FF, pg8::EpiResid<false>{WSP(WS_XB), WSP(WS_XB), mod + 8 * D, seq_shift, 0.5f}, tid); }
        SEAM();
        { PHASE_BEGIN(); final_norm_phase((const bf16_t*)WSP(WS_XB), out, ap->in[26], wave, lane); }
    }
}

extern "C" void kernel_launch(void* const* d_in, const int* in_sizes, int n_in, void* d_out, int out_size, void* d_ws, size_t ws_size, hipStream_t stream) {
    static int grid = 0;
    if (grid == 0) {
        int dev = 0, cus = 0, per_cu = 0;
        hipGetDevice(&dev);
        hipDeviceGetAttribute(&cus, hipDeviceAttributeMultiprocessorCount, dev);
        hipFuncSetAttribute((const void*)fwd_kernel, hipFuncAttributeMaxDynamicSharedMemorySize, LDS_BYTES);
        hipOccupancyMaxActiveBlocksPerMultiprocessor(&per_cu, (const void*)fwd_kernel, NT, LDS_BYTES);
        if (per_cu < 1) per_cu = 1;
        if (per_cu > 1) per_cu = 1;
        grid = cus * per_cu;
        if (n_in != 27 || ws_size < WS_END) fprintf(stderr, "kernel_launch: unexpected n_in %d or ws_size %zu\n", n_in, ws_size);
    }
    hipMemsetAsync((char*)d_ws, 0, CTL_ZERO_BYTES, stream);
    Args a{};
    for (int i = 0; i < 27; ++i) a.in[i] = (const float*)d_in[i];
    a.out = (float*)d_out; a.ws = (unsigned char*)d_ws;
    void* args[] = {&a};
    hipError_t e = hipLaunchCooperativeKernel((const void*)fwd_kernel, dim3(grid), dim3(NT), args, LDS_BYTES, stream);
    if (e != hipSuccess) fprintf(stderr, "cooperative launch failed: %s (grid %d)\n", hipGetErrorString(e), grid);
}
```
